# Optimizing an MI355X kernel written in HIP

```python
import math
import jax, jax.numpy as jnp
from jax import lax
import numpy as np

D_MODEL = 1024
BATCH = 4
SEQ = 8192
DEPTH = 2

D_MIX = D_MODEL
GROUP_W = D_MIX // 4
CONV_K = 31
NSA_HEADS = 4
NSA_HD = GROUP_W // NSA_HEADS
CMP_LEN = 32
CMP_STRIDE = 16
CMP_HIDDEN = 2 * NSA_HD
SLC_LEN = 64
N_SELECT = 16
WINDOW = 512
MLA_HEADS = 4
MLA_NOPE = 64
MLA_ROPE = 32
MLA_V = GROUP_W // MLA_HEADS
Q_LORA = 256
KV_LORA = 128
ROPE_THETA = 10000.0
POOL_WINDOWS = (2, 4, 8, 16)
POOL_GW = GROUP_W // len(POOL_WINDOWS)
D_FF = 4 * D_MODEL
N_BUCKETS = 32
MAX_DIST = 128
Q_BLOCK = 128
EPS = 1e-6
NEG_INF = -1e30
FORCE_SCORE = 1e9
IN_SPLITS = (2 * GROUP_W, NSA_HEADS * NSA_HD, 6 * NSA_HD, 3 * NSA_HEADS, Q_LORA, KV_LORA, MLA_ROPE, GROUP_W)
D_IN = sum(IN_SPLITS)
SPLIT_AT = tuple(sum(IN_SPLITS[:i + 1]) for i in range(len(IN_SPLITS) - 1))

kernel_name = 'hybrid_parallel_mixers'


def rmsnorm(x, g):
    xf = x.astype(jnp.float32)
    y = xf * lax.rsqrt(jnp.mean(xf * xf, axis=-1, keepdims=True) + EPS)
    return (y * g.astype(jnp.float32)).astype(x.dtype)


def layernorm(x, g, b):
    xf = x.astype(jnp.float32)
    mu = jnp.mean(xf, axis=-1, keepdims=True)
    var = jnp.mean(jnp.square(xf - mu), axis=-1, keepdims=True)
    y = (xf - mu) * lax.rsqrt(var + EPS) * g.astype(jnp.float32) + b.astype(jnp.float32)
    return y.astype(x.dtype)


def masked_softmax(logits, mask):
    lf = jnp.where(mask, logits.astype(jnp.float32), NEG_INF)
    p = jax.nn.softmax(lf, axis=-1)
    return jnp.where(mask, p, 0.0)


def rel_bucket(dist):
    n = jnp.maximum(dist, 0)
    max_exact = N_BUCKETS // 2
    nf = jnp.maximum(n, 1).astype(jnp.float32)
    large = max_exact + (jnp.log(nf / max_exact) / math.log(MAX_DIST / max_exact)
                         * (N_BUCKETS - max_exact)).astype(jnp.int32)
    large = jnp.minimum(large, N_BUCKETS - 1)
    return jnp.where(n < max_exact, n, large)


def rel_bias(dist, table):
    return table[rel_bucket(dist)]


def apply_rope(x, cos, sin):
    x1, x2 = jnp.split(x, 2, axis=-1)
    return jnp.concatenate([x1 * cos - x2 * sin, x1 * sin + x2 * cos], axis=-1).astype(x.dtype)


def conv_module(u, dw, dw_b, ln_g, ln_b, pw):
    a, g = jnp.split(u, 2, axis=-1)
    h = a * jax.nn.sigmoid(g)
    h = lax.conv_general_dilated(h, dw[:, None, :], (1,), [(CONV_K - 1, 0)],
                                 dimension_numbers=('NWC', 'WIO', 'NWC'),
                                 feature_group_count=GROUP_W) + dw_b
    h = jax.nn.silu(layernorm(h, ln_g, ln_b))
    return h @ pw


def pool_mixer(u, w_grp, scale):
    B_, S_, _ = u.shape
    uf = u.astype(jnp.float32)
    c = jnp.pad(jnp.cumsum(uf, axis=1), ((0, 0), (1, 0), (0, 0)))
    t = jnp.arange(S_)
    outs = []
    for gi, w in enumerate(POOL_WINDOWS):
        cg = c[..., gi * POOL_GW:(gi + 1) * POOL_GW]
        lo = jnp.maximum(t + 1 - w, 0)
        cnt = (t + 1 - lo).astype(jnp.float32)
        mean = (cg[:, 1:] - jnp.take(cg, lo, axis=1)) / cnt[None, :, None]
        outs.append(mean - uf[..., gi * POOL_GW:(gi + 1) * POOL_GW])
    d = jnp.stack(outs, axis=2).astype(u.dtype)
    y = jnp.einsum('bsgc,gcd->bsgd', d, w_grp).reshape(B_, S_, GROUP_W)
    return y * scale


def nsa_mixer(q, kv, gates, cmp_pos, cmp_w1, cmp_w2, rel_table):
    B_, S_ = q.shape[0], q.shape[1]
    k_c, v_c, k_s, v_s, k_w, v_w = jnp.split(kv, 6, axis=-1)
    n_cmp = (S_ - CMP_LEN) // CMP_STRIDE + 1
    blk_idx = jnp.arange(n_cmp)[:, None] * CMP_STRIDE + jnp.arange(CMP_LEN)[None, :]

    def compress(k, i):
        kb = k[:, blk_idx] + cmp_pos[i]
        hdn = jax.nn.silu(kb.reshape(B_, n_cmp, CMP_LEN * NSA_HD) @ cmp_w1[i])
        return hdn @ cmp_w2[i]

    Kc = compress(k_c, 0)
    Vc = compress(v_c, 1)
    cmp_end = jnp.arange(n_cmp) * CMP_STRIDE + CMP_LEN - 1
    n_slc = S_ // SLC_LEN
    c_lo = jnp.arange(n_cmp)[:, None] * CMP_STRIDE
    s_lo = jnp.arange(n_slc)[None, :] * SLC_LEN
    overlap = jnp.clip(jnp.minimum(c_lo + CMP_LEN, s_lo + SLC_LEN) - jnp.maximum(c_lo, s_lo),
                       0, None).astype(jnp.float32) / CMP_LEN
    n_top = min(N_SELECT, n_slc)
    k_w_pad = jnp.pad(k_w, ((0, 0), (WINDOW, 0), (0, 0)))
    v_w_pad = jnp.pad(v_w, ((0, 0), (WINDOW, 0), (0, 0)))
    n_qb = S_ // Q_BLOCK
    q_blocks = (q * NSA_HD ** -0.5).reshape(B_, n_qb, Q_BLOCK, NSA_HEADS, NSA_HD).transpose(1, 0, 3, 2, 4)
    g_blocks = gates.reshape(B_, n_qb, Q_BLOCK, NSA_HEADS, 3).transpose(1, 0, 3, 2, 4)
    j_slc = jnp.arange(n_slc)
    off = jnp.arange(SLC_LEN)
    band = jnp.arange(WINDOW + Q_BLOCK)
    gather_rows = jax.vmap(lambda a, i: a[i])

    def block(args):
        qb, qblk, gblk = args
        t = qb * Q_BLOCK + jnp.arange(Q_BLOCK)
        lc = jnp.einsum('bhqd,bcd->bhqc', qblk, Kc) + jnp.moveaxis(
            rel_bias(t[:, None] - cmp_end[None, :], rel_table), -1, 0)
        pc = masked_softmax(lc, cmp_end[None, :] <= t[:, None])
        o_c = jnp.einsum('bhqc,bcd->bhqd', pc.astype(Vc.dtype), Vc)
        imp = jnp.einsum('bhqc,cj->bqj', pc, overlap)
        jc = (t // SLC_LEN)[:, None]
        forced = (j_slc[None, :] == 0) | (j_slc[None, :] == jc) | (j_slc[None, :] == jc - 1)
        imp = jnp.where(forced, FORCE_SCORE, imp)
        imp = jnp.where(j_slc[None, :] <= jc, imp, NEG_INF)
        top_v, top_i = lax.top_k(imp, n_top)
        blk_ok = top_v > 0.5 * NEG_INF
        pos = (top_i[..., None] * SLC_LEN + off).reshape(B_, Q_BLOCK, n_top * SLC_LEN)
        pos_flat = pos.reshape(B_, Q_BLOCK * n_top * SLC_LEN)
        Ks = gather_rows(k_s, pos_flat).reshape(B_, Q_BLOCK, n_top * SLC_LEN, NSA_HD)
        Vs = gather_rows(v_s, pos_flat).reshape(B_, Q_BLOCK, n_top * SLC_LEN, NSA_HD)
        ms = (pos <= t[None, :, None]) & jnp.repeat(blk_ok, SLC_LEN, axis=-1)
        ls = jnp.einsum('bhqd,bqkd->bhqk', qblk, Ks) + jnp.moveaxis(
            rel_bias(t[None, :, None] - pos, rel_table), -1, 1)
        ps = masked_softmax(ls, ms[:, None])
        o_s = jnp.einsum('bhqk,bqkd->bhqd', ps.astype(Vs.dtype), Vs)
        start = qb * Q_BLOCK
        Kw = lax.dynamic_slice_in_dim(k_w_pad, start, WINDOW + Q_BLOCK, axis=1)
        Vw = lax.dynamic_slice_in_dim(v_w_pad, start, WINDOW + Q_BLOCK, axis=1)
        s_pos = start - WINDOW + band
        dist = t[:, None] - s_pos[None, :]
        mw = (dist >= 0) & (dist < WINDOW) & (s_pos[None, :] >= 0)
        lw = jnp.einsum('bhqd,bkd->bhqk', qblk, Kw) + jnp.moveaxis(rel_bias(dist, rel_table), -1, 0)
        pw = masked_softmax(lw, mw)
        o_w = jnp.einsum('bhqk,bkd->bhqd', pw.astype(Vw.dtype), Vw)
        return gblk[..., 0:1] * o_c + gblk[..., 1:2] * o_s + gblk[..., 2:3] * o_w

    out = lax.map(block, (jnp.arange(n_qb), q_blocks, g_blocks))
    return out.transpose(1, 0, 3, 2, 4).reshape(B_, S_, NSA_HEADS * NSA_HD)


def mla_mixer(c_q, c_kv, k_r, q_norm_g, w_uq, kv_norm_g, w_ukv, cos, sin):
    B_, S_ = c_q.shape[0], c_q.shape[1]
    q = (rmsnorm(c_q, q_norm_g) @ w_uq).reshape(B_, S_, MLA_HEADS, MLA_NOPE + MLA_ROPE)
    q_nope, q_rope = jnp.split(q, [MLA_NOPE], axis=-1)
    q_rope = apply_rope(q_rope, cos[:, None, :], sin[:, None, :])
    kv = (rmsnorm(c_kv, kv_norm_g) @ w_ukv).reshape(B_, S_, MLA_HEADS, MLA_NOPE + MLA_V)
    k_nope, v = jnp.split(kv, [MLA_NOPE], axis=-1)
    k_rope = apply_rope(k_r, cos, sin)
    scale = (MLA_NOPE + MLA_ROPE) ** -0.5
    n_qb = S_ // Q_BLOCK
    qn = (q_nope * scale).reshape(B_, n_qb, Q_BLOCK, MLA_HEADS, MLA_NOPE).transpose(1, 0, 2, 3, 4)
    qr = (q_rope * scale).reshape(B_, n_qb, Q_BLOCK, MLA_HEADS, MLA_ROPE).transpose(1, 0, 2, 3, 4)
    kpos = jnp.arange(S_)

    def block(args):
        qb, qn_b, qr_b = args
        t = qb * Q_BLOCK + jnp.arange(Q_BLOCK)
        lg = (jnp.einsum('bqhd,bkhd->bhqk', qn_b, k_nope)
              + jnp.einsum('bqhr,bkr->bhqk', qr_b, k_rope))
        p = masked_softmax(lg, kpos[None, :] <= t[:, None])
        return jnp.einsum('bhqk,bkhd->bqhd', p.astype(v.dtype), v)

    out = lax.map(block, (jnp.arange(n_qb), qn, qr))
    return out.transpose(1, 0, 2, 3, 4).reshape(B_, S_, MLA_HEADS * MLA_V)


def setup_inputs(seed: int = 0) -> dict:
    key = jax.random.key(seed)
    ks = jax.random.split(key, 23)
    f32 = jnp.float32

    def nrm(k, shape, scale):
        return jax.random.normal(k, shape, f32) * scale

    def gain(k, shape):
        return 1.0 + 0.02 * jax.random.normal(k, shape, f32)

    return {
        'x': nrm(ks[0], (BATCH, SEQ, D_MODEL), 1.0),
        'w_in': nrm(ks[1], (DEPTH, D_MODEL, D_IN), D_MODEL ** -0.5),
        'w_out': nrm(ks[2], (DEPTH, D_MIX, D_MODEL), D_MIX ** -0.5),
        'ln_mix_g': gain(ks[3], (DEPTH, D_MODEL)),
        'ln_mlp_g': gain(ks[4], (DEPTH, D_MODEL)),
        'conv_dw': nrm(ks[5], (DEPTH, CONV_K, GROUP_W), CONV_K ** -0.5),
        'conv_dw_b': nrm(ks[6], (DEPTH, GROUP_W), 0.02),
        'conv_ln_g': gain(ks[7], (DEPTH, GROUP_W)),
        'conv_ln_b': nrm(ks[8], (DEPTH, GROUP_W), 0.02),
        'conv_pw': nrm(ks[9], (DEPTH, GROUP_W, GROUP_W), GROUP_W ** -0.5),
        'nsa_cmp_pos': nrm(ks[10], (DEPTH, 2, CMP_LEN, NSA_HD), 0.1),
        'nsa_cmp_w1': nrm(ks[11], (DEPTH, 2, CMP_LEN * NSA_HD, CMP_HIDDEN), (CMP_LEN * NSA_HD) ** -0.5),
        'nsa_cmp_w2': nrm(ks[12], (DEPTH, 2, CMP_HIDDEN, NSA_HD), CMP_HIDDEN ** -0.5),
        'mla_q_norm_g': gain(ks[13], (DEPTH, Q_LORA)),
        'mla_w_uq': nrm(ks[14], (DEPTH, Q_LORA, MLA_HEADS * (MLA_NOPE + MLA_ROPE)), Q_LORA ** -0.5),
        'mla_kv_norm_g': gain(ks[15], (DEPTH, KV_LORA)),
        'mla_w_ukv': nrm(ks[16], (DEPTH, KV_LORA, MLA_HEADS * (MLA_NOPE + MLA_V)), KV_LORA ** -0.5),
        'pool_w': nrm(ks[17], (DEPTH, len(POOL_WINDOWS), POOL_GW, POOL_GW), POOL_GW ** -0.5),
        'pool_scale': gain(ks[18], (DEPTH, GROUP_W)),
        'mlp_w1': nrm(ks[19], (DEPTH, D_MODEL, D_FF), D_MODEL ** -0.5),
        'mlp_w2': nrm(ks[20], (DEPTH, D_FF, D_MODEL), D_FF ** -0.5),
        'rel_bias_table': nrm(ks[21], (N_BUCKETS, NSA_HEADS), 0.2),
        'final_norm_g': gain(ks[22], (D_MODEL,)),
    }


def reference(x, w_in, w_out, ln_mix_g, ln_mlp_g, conv_dw, conv_dw_b, conv_ln_g, conv_ln_b,
              conv_pw, nsa_cmp_pos, nsa_cmp_w1, nsa_cmp_w2, mla_q_norm_g, mla_w_uq,
              mla_kv_norm_g, mla_w_ukv, pool_w, pool_scale, mlp_w1, mlp_w2,
              rel_bias_table, final_norm_g):
    B_, S_ = x.shape[0], x.shape[1]
    pos = jnp.arange(S_, dtype=jnp.float32)
    inv_freq = ROPE_THETA ** (-jnp.arange(0, MLA_ROPE, 2, dtype=jnp.float32) / MLA_ROPE)
    ang = pos[:, None] * inv_freq[None, :]
    cos, sin = jnp.cos(ang), jnp.sin(ang)
    h = x
    for l in range(DEPTH):
        u = rmsnorm(h, ln_mix_g[l]) @ w_in[l]
        u_conv, u_q, u_kv, u_g, u_cq, u_ckv, u_kr, u_pool = jnp.split(u, SPLIT_AT, axis=-1)
        y_conv = conv_module(u_conv, conv_dw[l], conv_dw_b[l], conv_ln_g[l], conv_ln_b[l], conv_pw[l])
        y_nsa = nsa_mixer(u_q.reshape(B_, S_, NSA_HEADS, NSA_HD), u_kv,
                          jax.nn.sigmoid(u_g).reshape(B_, S_, NSA_HEADS, 3),
                          nsa_cmp_pos[l], nsa_cmp_w1[l], nsa_cmp_w2[l], rel_bias_table)
        y_mla = mla_mixer(u_cq, u_ckv, u_kr, mla_q_norm_g[l], mla_w_uq[l],
                          mla_kv_norm_g[l], mla_w_ukv[l], cos, sin)
        y_pool = pool_mixer(u_pool, pool_w[l], pool_scale[l])
        h = h + jnp.concatenate([y_conv, y_nsa, y_mla, y_pool], axis=-1) @ w_out[l]
        z = rmsnorm(h, ln_mlp_g[l]) @ mlp_w1[l]
        h = h + jnp.square(jax.nn.relu(z)) @ mlp_w2[l]
    return rmsnorm(h, final_norm_g)
```

```cpp
#include <hip/hip_runtime.h>
#include <hip/hip_cooperative_groups.h>
#include <cstdio>
#include <cstdint>
namespace cg = cooperative_groups;
namespace pg8 {
#define PG8_LAS __attribute__((address_space(3)))
typedef unsigned short bf16_t;
typedef short bf16x8 __attribute__((ext_vector_type(8)));
typedef float f32x4 __attribute__((ext_vector_type(4)));
typedef unsigned u32x4 __attribute__((ext_vector_type(4)));
typedef unsigned u32x2 __attribute__((ext_vector_type(2)));
constexpr int BM = 256, BK = 64, HALF = 128, HTB = HALF * BK * 2  , STAGE_BYTES = 8 * HTB, NXCD = 8, WGM = 8;

__host__ __device__ __forceinline__ int lds_byte(int r, int c) { const int st = (r >> 4) * 2 + (c >> 5), rr = r & 15, cc = c & 31, ob = rr * 64 + cc * 2; return st * 1024 + (ob ^ (((ob >> 9) & 1) << 5)); }
__host__ __device__ __forceinline__ void stage_rc(int b, int& R, int& C) { const int st = b / 1024, sb = b % 1024, swz = sb ^ (((sb >> 9) & 1) << 5); R = (st >> 1) * 16 + swz / 64; C = (st & 1) * 32 + (swz % 64) / 2; }
__host__ __device__ __forceinline__ int perm32(int rho) { const int n = rho >> 4, i = rho & 15; return 8 * (i >> 2) + 4 * n + (i & 3); }

struct Unit { int pm, pn, ui; };
struct Gemm { const bf16_t* A; const bf16_t* Bt; int M, N, K; };

struct StaticOrder {
    int nM, nN, nwg, G, c;
    __host__ __device__ void init(int M, int N, int G_, int c_) { nM = M / BM; nN = N / BM; nwg = nM * nN; G = G_; c = c_; }
    __host__ __device__ bool next(int i, Unit& u) const {
        const long L = (long)i * G + c; if (L >= nwg) return false;
        int wgid = (int)L; { const int q = nwg / NXCD, r = nwg % NXCD, xcd = wgid % NXCD, off = wgid / NXCD; wgid = (xcd < r ? xcd * (q + 1) : r * (q + 1) + (xcd - r) * q) + off; }
        const int nig = WGM * nN, gid = wgid / nig, fm = gid * WGM, gsz = (nM - fm) < WGM ? (nM - fm) : WGM;
        u.pm = fm + ((wgid % nig) % gsz); u.pn = (wgid % nig) / gsz; u.ui = i; return true;
    }
    __device__ __forceinline__ void a_ready(const Unit&) const {}
    __device__ __forceinline__ void done(const Unit&) const {}
};

typedef float f32x2 __attribute__((ext_vector_type(2)));
typedef __bf16 bf16x2_t __attribute__((ext_vector_type(2)));
__device__ __forceinline__ unsigned cvt_pk_bf16(float lo, float hi) { f32x2 v = {lo, hi}; bf16x2_t b = __builtin_convertvector(v, bf16x2_t); return __builtin_bit_cast(unsigned, b); }

template <int ACT> struct EpiRowScale {
    static constexpr bool PERM = true, AFTER_DRAIN = false;
    bf16_t* O; int ldc; const PG8_LAS float* rs;
    __device__ __forceinline__ void operator()(const f32x4 (&acc)[2][2][4][2], const Unit& u, int wr, int wc, int fr, int fq) const {
        const int rl0 = wr * 64 + fr, col0 = u.pn * BM + wc * 32 + 8 * fq;
#pragma unroll
        for (int ai = 0; ai < 2; ++ai)
#pragma unroll
            for (int m = 0; m < 4; ++m) { const int rl = rl0 + ai * HALF + m * 16; const float s = rs[u.ui * 256 + rl];
                bf16_t* rowp = O + (size_t)(u.pm * BM + rl) * ldc + col0;
#pragma unroll
                for (int bj = 0; bj < 2; ++bj) { f32x4 v0 = acc[ai][bj][m][0] * s, v1 = acc[ai][bj][m][1] * s;
                    if (ACT == 1) {
#pragma unroll
                        for (int e = 0; e < 4; ++e) { float a = fmaxf(v0[e], 0.f), b = fmaxf(v1[e], 0.f); v0[e] = a * a; v1[e] = b * b; } }
                    u32x4 w; w.x = cvt_pk_bf16(v0[0], v0[1]); w.y = cvt_pk_bf16(v0[2], v0[3]); w.z = cvt_pk_bf16(v1[0], v1[1]); w.w = cvt_pk_bf16(v1[2], v1[3]);
                    *(u32x4*)(rowp + bj * HALF) = w; } }
    }
};
struct EpiResidual {
    static constexpr bool PERM = false, AFTER_DRAIN = false;
    const float* base; float* out; bf16_t* hb; float* ss;
    __device__ __forceinline__ void operator()(const f32x4 (&acc)[2][2][4][2], const Unit& u, int wr, int wc, int fr, int fq) const {
        const int col0 = u.pn * BM + wc * 32 + 4 * fq;
#pragma unroll
        for (int ai = 0; ai < 2; ++ai)
#pragma unroll
            for (int m = 0; m < 4; ++m) { const int row = u.pm * BM + wr * 64 + fr + ai * HALF + m * 16; const size_t off = (size_t)row * 1024 + col0; float q = 0.f;
#pragma unroll
                for (int bj = 0; bj < 2; ++bj)
#pragma unroll
                    for (int n = 0; n < 2; ++n) { const size_t o2 = off + bj * HALF + n * 16; const f32x4 b = *(const f32x4*)(base + o2); const f32x4 o = b + acc[ai][bj][m][n];
                        *(f32x4*)(out + o2) = o; q += (o[0] * o[0] + o[1] * o[1]) + (o[2] * o[2] + o[3] * o[3]);
                        u32x2 w; w.x = cvt_pk_bf16(o[0], o[1]); w.y = cvt_pk_bf16(o[2], o[3]); *(u32x2*)(hb + o2) = w; }
                q += __shfl_xor(q, 16); q += __shfl_xor(q, 32);
                if (fq == 0) ss[(size_t)row * 16 + u.pn * 4 + wc] = q; }
    }
};

template <class Epi, class Sched, bool ALIGN_EPI = false, bool SP2 = false>
__device__ __forceinline__ void gemm_phase(PG8_LAS unsigned char* lds, const Gemm g, const Sched& S, const Epi& E) {
    const int tid = threadIdx.x, wid = __builtin_amdgcn_readfirstlane(tid >> 6), lane = tid & 63, wr = wid >> 2, wc = wid & 3, fr = lane & 15, fq = lane >> 4;
    const int K = g.K, nt = K / BK;
    unsigned voffA[2], voffB[2];
#pragma unroll
    for (int i = 0; i < 2; ++i) { int R, C; stage_rc(tid * 16 + i * 8192, R, C); const int Rb = Epi::PERM ? ((R & ~31) + perm32(R & 31)) : R;
        voffA[i] = (unsigned)(R * K + C) * 2u; voffB[i] = (unsigned)(Rb * K + C) * 2u; }
    const size_t kstep = (size_t)(BK * 2);
    const size_t hstep = (size_t)HALF * K * 2;
    const size_t tstep = 2 * hstep;
    const unsigned ldsw = (unsigned)wid * 1024u;
    const int aoff = lds_byte(wr * 64 + fr, fq * 8), boff = lds_byte(wc * 32 + fr, fq * 8);
#define PG8_SA(b, h) (((b) * 2 + (h)) * HTB)
#define PG8_SB(b, h) ((4 + (b) * 2 + (h)) * HTB)
#define PG8_STAGE(bufoff, gbase, voff) do { _Pragma("unroll") for (int _i = 0; _i < 2; ++_i) \
        __builtin_amdgcn_global_load_lds((const unsigned*)((const char*)(gbase) + (voff)[_i]), (PG8_LAS unsigned*)(lds + (bufoff) + ldsw + _i * 8192), 16, 0, 0); } while (0)
#define PG8_LDA(dst, b, h) do { _Pragma("unroll") for (int m = 0; m < 4; ++m) _Pragma("unroll") for (int k = 0; k < 2; ++k) dst[m][k] = *(const PG8_LAS bf16x8*)(lds + PG8_SA(b, h) + aoff + m * 2048 + k * 1024); } while (0)
#define PG8_LDB(dst, b, h) do { _Pragma("unroll") for (int n = 0; n < 2; ++n) _Pragma("unroll") for (int k = 0; k < 2; ++k) dst[n][k] = *(const PG8_LAS bf16x8*)(lds + PG8_SB(b, h) + boff + n * 2048 + k * 1024); } while (0)
#define PG8_MMA(ai, bj, At, Bt) do { __builtin_amdgcn_s_setprio(1); _Pragma("unroll") for (int m = 0; m < 4; ++m) _Pragma("unroll") for (int n = 0; n < 2; ++n) _Pragma("unroll") for (int k = 0; k < 2; ++k) \
        acc[ai][bj][m][n] = __builtin_amdgcn_mfma_f32_16x16x32_bf16(Bt[n][k], At[m][k], acc[ai][bj][m][n], 0, 0, 0); __builtin_amdgcn_s_setprio(0); } while (0)
#define PG8_WAIT_V(n) asm volatile("s_waitcnt vmcnt(" #n ")" ::: "memory")
#define PG8_WAIT_L(n) asm volatile("s_waitcnt lgkmcnt(" #n ")" ::: "memory")
#define PG8_BAR __builtin_amdgcn_s_barrier()
#define PG8_SCHED __builtin_amdgcn_sched_barrier(0)
    Unit cur, nxt; int ui = 0;
    if (!S.next(0, cur)) return;
    f32x4 acc[2][2][4][2];
#pragma unroll
    for (int a = 0; a < 2; ++a)
#pragma unroll
        for (int b = 0; b < 2; ++b)
#pragma unroll
            for (int m = 0; m < 4; ++m)
#pragma unroll
                for (int n = 0; n < 2; ++n) acc[a][b][m][n] = (f32x4){0.f, 0.f, 0.f, 0.f};
    bf16x8 At[4][2], B0[2][2], B1[2][2];
    const char* cA = (const char*)g.A + (size_t)cur.pm * tstep; const char* cB = (const char*)g.Bt + (size_t)cur.pn * tstep;
    S.a_ready(cur);
    if constexpr (SP2) {
        PG8_STAGE(PG8_SB(0, 0), cB, voffB); PG8_STAGE(PG8_SB(0, 1), cB + hstep, voffB); PG8_STAGE(PG8_SA(0, 0), cA, voffA); PG8_STAGE(PG8_SA(0, 1), cA + hstep, voffA);
        if (wr == 1) PG8_BAR;
        PG8_WAIT_V(2); PG8_BAR;
        PG8_STAGE(PG8_SB(1, 0), cB + kstep, voffB); PG8_STAGE(PG8_SA(1, 0), cA + kstep, voffA); PG8_STAGE(PG8_SB(1, 1), cB + hstep + kstep, voffB);
        PG8_WAIT_V(6); PG8_BAR;
    } else {
        PG8_STAGE(PG8_SB(0, 0), cB, voffB); PG8_STAGE(PG8_SA(0, 0), cA, voffA); PG8_STAGE(PG8_SB(0, 1), cB + hstep, voffB); PG8_STAGE(PG8_SA(0, 1), cA + hstep, voffA);
        if (wr == 1) PG8_BAR;
        PG8_WAIT_V(4); PG8_BAR;
        PG8_STAGE(PG8_SB(1, 0), cB + kstep, voffB); PG8_STAGE(PG8_SA(1, 0), cA + kstep, voffA); PG8_STAGE(PG8_SB(1, 1), cB + hstep + kstep, voffB);
        PG8_WAIT_V(6); PG8_BAR;
    }
    for (;;) {
        const bool has_next = S.next(ui + 1, nxt);
        const char* nA = has_next ? (const char*)g.A + (size_t)nxt.pm * tstep : cA; const char* nB = has_next ? (const char*)g.Bt + (size_t)nxt.pn * tstep : cB;
        for (int t = 0; t < nt; t += 2) {
            const bool last = (t == nt - 2);
            const char* a1 = cA + (size_t)(t + 1) * kstep;
            const char* a2 = last ? nA : cA + (size_t)(t + 2) * kstep; const char* b2 = last ? nB : cB + (size_t)(t + 2) * kstep;
            const char* a3 = a2 + kstep; const char* b3 = b2 + kstep;
            if (last && has_next) S.a_ready(nxt);
            if constexpr (SP2) {
            PG8_LDB(B0, 0, 0); PG8_LDB(B1, 0, 1); PG8_SCHED; PG8_LDA(At, 0, 0); PG8_STAGE(PG8_SA(1, 1), a1 + hstep, voffA);
            PG8_WAIT_V(8); PG8_WAIT_L(0); PG8_BAR; PG8_MMA(0, 0, At, B0); PG8_MMA(0, 1, At, B1); PG8_BAR; PG8_SCHED;
            PG8_LDA(At, 0, 1); PG8_STAGE(PG8_SB(0, 0), b2, voffB); PG8_STAGE(PG8_SB(0, 1), b2 + hstep, voffB); PG8_STAGE(PG8_SA(0, 0), a2, voffA);
            PG8_WAIT_V(8); PG8_WAIT_L(0); PG8_BAR; PG8_MMA(1, 0, At, B0); PG8_MMA(1, 1, At, B1); PG8_BAR; PG8_SCHED;
            PG8_LDB(B0, 1, 0); PG8_LDB(B1, 1, 1); PG8_SCHED; PG8_LDA(At, 1, 0); PG8_STAGE(PG8_SA(0, 1), a2 + hstep, voffA);
            PG8_WAIT_V(8); PG8_WAIT_L(0); PG8_BAR; PG8_MMA(0, 0, At, B0); PG8_MMA(0, 1, At, B1); PG8_BAR; PG8_SCHED;
            PG8_LDA(At, 1, 1); PG8_STAGE(PG8_SB(1, 0), b3, voffB); PG8_STAGE(PG8_SB(1, 1), b3 + hstep, voffB); PG8_STAGE(PG8_SA(1, 0), a3, voffA);
            PG8_WAIT_V(8); PG8_WAIT_L(0); PG8_BAR; PG8_MMA(1, 0, At, B0); PG8_MMA(1, 1, At, B1); PG8_BAR; PG8_SCHED;
            } else {
            PG8_LDB(B0, 0, 0); PG8_SCHED; PG8_LDA(At, 0, 0); PG8_STAGE(PG8_SA(1, 1), a1 + hstep, voffA);
            PG8_WAIT_L(8); PG8_BAR; PG8_WAIT_L(0); PG8_MMA(0, 0, At, B0); PG8_BAR; PG8_SCHED;
            PG8_LDB(B1, 0, 1); PG8_STAGE(PG8_SB(0, 0), b2, voffB);
            PG8_BAR; PG8_WAIT_L(0); PG8_MMA(0, 1, At, B1); PG8_BAR;
            PG8_LDA(At, 0, 1); PG8_STAGE(PG8_SA(0, 0), a2, voffA);
            PG8_BAR; PG8_WAIT_L(0); PG8_MMA(1, 0, At, B0); PG8_BAR; PG8_SCHED;
            PG8_STAGE(PG8_SB(0, 1), b2 + hstep, voffB);
            PG8_WAIT_V(6); PG8_BAR; PG8_MMA(1, 1, At, B1); PG8_BAR;
            PG8_LDB(B0, 1, 0); PG8_SCHED; PG8_LDA(At, 1, 0); PG8_STAGE(PG8_SA(0, 1), a2 + hstep, voffA);
            PG8_WAIT_L(8); PG8_BAR; PG8_WAIT_L(0); PG8_MMA(0, 0, At, B0); PG8_BAR; PG8_SCHED;
            PG8_LDB(B1, 1, 1); PG8_STAGE(PG8_SB(1, 0), b3, voffB);
            PG8_BAR; PG8_WAIT_L(0); PG8_MMA(0, 1, At, B1); PG8_BAR;
            PG8_LDA(At, 1, 1); PG8_STAGE(PG8_SA(1, 0), a3, voffA);
            PG8_BAR; PG8_WAIT_L(0); PG8_MMA(1, 0, At, B0); PG8_BAR; PG8_SCHED;
            PG8_STAGE(PG8_SB(1, 1), b3 + hstep, voffB);
            PG8_WAIT_V(6); PG8_BAR; PG8_MMA(1, 1, At, B1); PG8_BAR;
            }
        }
        if constexpr (ALIGN_EPI) { if (wr == 0) PG8_BAR; }
        if constexpr (!Epi::AFTER_DRAIN) { E(acc, cur, wr, wc, fr, fq); S.done(cur); }
        if (!has_next) break;
#pragma unroll
        for (int a = 0; a < 2; ++a)
#pragma unroll
            for (int b = 0; b < 2; ++b)
#pragma unroll
                for (int m = 0; m < 4; ++m)
#pragma unroll
                    for (int n = 0; n < 2; ++n) acc[a][b][m][n] = (f32x4){0.f, 0.f, 0.f, 0.f};
        cur = nxt; cA = nA; cB = nB; ++ui;
        if constexpr (ALIGN_EPI) { if (wr == 1) PG8_BAR; }
    }
    PG8_WAIT_V(0);
    if constexpr (!ALIGN_EPI) { if (wr == 0) PG8_BAR; }
    PG8_BAR;
#undef PG8_SA
#undef PG8_SB
#undef PG8_STAGE
#undef PG8_LDA
#undef PG8_LDB
#undef PG8_MMA
#undef PG8_WAIT_V
#undef PG8_WAIT_L
#undef PG8_BAR
#undef PG8_SCHED
}
}
#define LAS __attribute__((address_space(3)))
using pg8::bf16_t; using pg8::bf16x8; using pg8::f32x4; using pg8::u32x4; using pg8::u32x2; using pg8::cvt_pk_bf16;
typedef float f32x16 __attribute__((ext_vector_type(16)));
typedef short s16x4 __attribute__((ext_vector_type(4)));

constexpr int NB = 4, SEQ = 8192, MTOK = NB * SEQ, DMODEL = 1024, DIN = 1836, NU = 2048, DFF = 4096, NLAYER = 2;
constexpr float EPS = 1e-6f, LOG2E = 1.4426950408889634f;
constexpr float NSA_QSCALE = 0.125f * LOG2E;
constexpr float MLA_QSCALE = 0.10206207261596575f * LOG2E;
constexpr int UC_A = 0, UC_G = 256, UC_Q = 512, UC_KV = 768, UC_CQ = 1152, UC_CKV = 1408, UC_POOL = 1536, UC_KR = 1792, UC_GATE = 1824;
constexpr int CC_CONV = 0, CC_NSA = 256, CC_MLA = 512, CC_POOL = 768;

constexpr size_t MiB = 1u << 20;
constexpr size_t WS_W = 1 * MiB, W_LAYER = 24 * MiB;
constexpr size_t WO_WIN = 0, WO_WOUT = 4 * MiB, WO_W1 = 6 * MiB, WO_W2 = 14 * MiB, WO_SMALL = 22 * MiB;
constexpr size_t WO_PW = WO_SMALL, WO_UQ = WO_SMALL + 131072, WO_UKV = WO_SMALL + 327680, WO_C1 = WO_SMALL + 458752, WO_C2 = WO_SMALL + 1507328, WO_POOL = WO_SMALL + 1540096;
constexpr size_t WS_TAB = 4096, WS_ROPE = 50 * MiB, WS_CB1 = 51 * MiB, WS_SS = 52 * MiB, WS_HB = 56 * MiB, WS_KC = 120 * MiB;
constexpr size_t WS_U = 128 * MiB, WS_CAT = 256 * MiB, WS_QM = 320 * MiB, WS_KM = 344 * MiB, WS_VM = 368 * MiB, WS_Z = 128 * MiB, WS_END = 384 * MiB;

constexpr int LDS_BYTES = 163840;
constexpr int LDS_RS = 131072;

__device__ const unsigned char BUCKET[129] = {0,1,2,3,4,5,6,7,8,9,10,11,12,13,14,15,16,16,16,17,17,18,18,18,19,19,19,20,20,20,20,21,21,21,21,22,22,22,22,22,23,23,23,23,23,23,24,24,24,24,24,24,25,25,25,25,25,25,25,26,26,26,26,26,26,26,26,27,27,27,27,27,27,27,27,27,27,28,28,28,28,28,28,28,28,28,28,29,29,29,29,29,29,29,29,29,29,29,29,30,30,30,30,30,30,30,30,30,30,30,30,30,30,31,31,31,31,31,31,31,31,31,31,31,31,31,31,31,31};

__device__ __forceinline__ float bf2f(unsigned short x) { return __uint_as_float((unsigned)x << 16); }
__device__ __forceinline__ unsigned short f2bf(float f) { return (unsigned short)(cvt_pk_bf16(f, 0.f) & 0xffffu); }
__device__ __forceinline__ float wave_sum(float v) {
#pragma unroll
    for (int o = 1; o < 64; o <<= 1) v += __shfl_xor(v, o);
    return v;
}
__device__ __forceinline__ float sigmoidf_(float x) { return 1.0f / (1.0f + __expf(-x)); }
__device__ __forceinline__ int crow(int r, int hi) { return (r & 3) + 8 * (r >> 2) + 4 * hi; }

struct Args { const float* in[23]; float* out; unsigned char* ws; int pad0, pad1; };

struct Frame {
    LAS unsigned char* lds;
    int tid, lane, wave, G, bid, vcu;
    unsigned char* ws;
};

#define LAUNDER(F) do { unsigned long long _w = (unsigned long long)(F).ws; asm volatile("" : "+s"(_w)); (F).ws = (unsigned char*)_w; \
    unsigned _l = (unsigned)(size_t)(F).lds; asm volatile("" : "+s"(_l)); (F).lds = (LAS unsigned char*)(size_t)_l; \
    asm volatile("" : "+v"((F).tid)); (F).lane = (F).tid & 63; (F).wave = __builtin_amdgcn_readfirstlane((F).tid >> 6); } while (0)

__device__ __forceinline__ const float* IN(const Frame& F, int k) { return ((const float* const*)(F.ws + WS_TAB))[k]; }

template <int K> __device__ __forceinline__ f32x16 small_mm(const LAS unsigned char* A, int lda_b, const bf16_t* BT, int lane) {
    const int r32 = lane & 31, hi = lane >> 5; f32x16 acc = {};
    const LAS unsigned char* ap = A + r32 * lda_b + hi * 16; const bf16_t* bp = BT + (size_t)r32 * K + hi * 8;
#pragma unroll 4
    for (int ks = 0; ks < K / 16; ++ks) {
        const bf16x8 a = *(const LAS bf16x8*)(ap + ks * 32); const bf16x8 b = *(const bf16x8*)(bp + ks * 16);
        acc = __builtin_amdgcn_mfma_f32_32x32x16_bf16(a, b, acc, 0, 0, 0);
    }
    return acc;
}
__device__ __forceinline__ int win_src(int n) {
    if (n < 1152) return n;
    if (n < 1408) return n - 1152 + 1164;
    if (n < 1536) return n - 1408 + 1420;
    if (n < 1792) return n - 1536 + 1580;
    if (n < 1824) return n - 1792 + 1548;
    if (n < 1836) return n - 1824 + 1152;
    return -1;
}
template <int MODE> __device__ __forceinline__ void transpose_item(const float* W, int K, int ldn, bf16_t* WT, const float* ks, float cs0, LAS float* scr, int item, int nblk, int lane) {
    const int kb = item / nblk, nb = item % nblk, k0 = 64 * kb, n0 = 32 * nb;
    const int nn = n0 + (lane & 31);
    int sc = nn; float cs = cs0;
    if (MODE == 1) { sc = win_src(nn); cs = (nn >= UC_Q && nn < UC_KV) ? NSA_QSCALE : 1.0f; }
#pragma unroll 8
    for (int i = 0; i < 32; ++i) { const int kk = 2 * i + (lane >> 5); float v = 0.f;
        if (sc >= 0) v = W[(size_t)(k0 + kk) * ldn + sc];
        if (ks) v *= ks[k0 + kk];
        scr[kk * 33 + (lane & 31)] = v * cs; }
    asm volatile("s_waitcnt lgkmcnt(0)" ::: "memory");
    const int c = lane & 7;
#pragma unroll
    for (int j = 0; j < 4; ++j) { const int n = (lane >> 3) + 8 * j; const LAS float* s = scr + (8 * c) * 33 + n;
        u32x4 o; o.x = cvt_pk_bf16(s[0 * 33], s[1 * 33]); o.y = cvt_pk_bf16(s[2 * 33], s[3 * 33]); o.z = cvt_pk_bf16(s[4 * 33], s[5 * 33]); o.w = cvt_pk_bf16(s[6 * 33], s[7 * 33]);
        *(u32x4*)(WT + (size_t)(n0 + n) * K + k0 + 8 * c) = o; }
    asm volatile("s_waitcnt lgkmcnt(0)" ::: "memory");
}

__device__ __forceinline__ void prologue(const Args& a, Frame F) {
    LAUNDER(F);
    if (F.bid == 0 && F.tid == 0) { const float** tab = (const float**)(F.ws + WS_TAB);
#pragma unroll
        for (int k = 0; k < 23; ++k) tab[k] = a.in[k];
        tab[23] = a.out; }
    LAS float* scr = (LAS float*)(F.lds + F.wave * 16384);
    const int gw = F.bid * 8 + F.wave, NGW = F.G * 8;
    constexpr int I_WIN = 16 * 64, I_WOUT = 16 * 32, I_W1 = 16 * 128, I_W2 = 64 * 32, I_PW = 4 * 8, I_UQ = 4 * 12, I_UKV = 2 * 16, I_C1 = 32 * 4, I_C2 = 2 * 2, I_PL = 1 * 2;
    constexpr int I_LAYER = I_WIN + I_WOUT + I_W1 + I_W2 + I_PW + I_UQ + I_UKV + 2 * I_C1 + 2 * I_C2 + 4 * I_PL;
    for (int it = gw; it < NLAYER * I_LAYER; it += NGW) {
        const int l = it / I_LAYER; int r = it % I_LAYER;
        unsigned char* wl = F.ws + WS_W + (size_t)l * W_LAYER;
        if (r < I_WIN) { transpose_item<1>(a.in[1] + (size_t)l * DMODEL * DIN, DMODEL, DIN, (bf16_t*)(wl + WO_WIN), a.in[3] + l * DMODEL, 1.f, scr, r, 64, F.lane); continue; } r -= I_WIN;
        if (r < I_WOUT) { transpose_item<0>(a.in[2] + (size_t)l * DMODEL * DMODEL, DMODEL, DMODEL, (bf16_t*)(wl + WO_WOUT), nullptr, 1.f, scr, r, 32, F.lane); continue; } r -= I_WOUT;
        if (r < I_W1) { transpose_item<0>(a.in[19] + (size_t)l * DMODEL * DFF, DMODEL, DFF, (bf16_t*)(wl + WO_W1), a.in[4] + l * DMODEL, 1.f, scr, r, 128, F.lane); continue; } r -= I_W1;
        if (r < I_W2) { transpose_item<0>(a.in[20] + (size_t)l * DFF * DMODEL, DFF, DMODEL, (bf16_t*)(wl + WO_W2), nullptr, 1.f, scr, r, 32, F.lane); continue; } r -= I_W2;
        if (r < I_PW) { transpose_item<0>(a.in[9] + (size_t)l * 256 * 256, 256, 256, (bf16_t*)(wl + WO_PW), nullptr, 1.f, scr, r, 8, F.lane); continue; } r -= I_PW;
        if (r < I_UQ) { transpose_item<0>(a.in[14] + (size_t)l * 256 * 384, 256, 384, (bf16_t*)(wl + WO_UQ), a.in[13] + l * 256, MLA_QSCALE, scr, r, 12, F.lane); continue; } r -= I_UQ;
        if (r < I_UKV) { transpose_item<0>(a.in[16] + (size_t)l * 128 * 512, 128, 512, (bf16_t*)(wl + WO_UKV), a.in[15] + l * 128, 1.f, scr, r, 16, F.lane); continue; } r -= I_UKV;
        if (r < 2 * I_C1) { const int i = r / I_C1; transpose_item<0>(a.in[11] + (size_t)(l * 2 + i) * 2048 * 128, 2048, 128, (bf16_t*)(wl + WO_C1) + (size_t)i * 128 * 2048, nullptr, 1.f, scr, r % I_C1, 4, F.lane); continue; } r -= 2 * I_C1;
        if (r < 2 * I_C2) { const int i = r / I_C2; transpose_item<0>(a.in[12] + (size_t)(l * 2 + i) * 128 * 64, 128, 64, (bf16_t*)(wl + WO_C2) + (size_t)i * 64 * 128, nullptr, 1.f, scr, r % I_C2, 2, F.lane); continue; } r -= 2 * I_C2;
        { const int g = r / I_PL; transpose_item<0>(a.in[17] + (size_t)(l * 4 + g) * 64 * 64, 64, 64, (bf16_t*)(wl + WO_POOL) + (size_t)g * 64 * 64, nullptr, 1.f, scr, r % I_PL, 2, F.lane); }
    }
    {
        const float* x = a.in[0]; bf16_t* hb = (bf16_t*)(F.ws + WS_HB); float* ss = (float*)(F.ws + WS_SS);
        for (int m = gw; m < MTOK; m += NGW) {
            const f32x4* xr = (const f32x4*)(x + (size_t)m * DMODEL) + F.lane; u32x2* hr = (u32x2*)(hb + (size_t)m * DMODEL) + F.lane; float s = 0.f;
#pragma unroll
            for (int j = 0; j < 4; ++j) { const f32x4 v = xr[64 * j]; s += (v[0] * v[0] + v[1] * v[1]) + (v[2] * v[2] + v[3] * v[3]); u32x2 w; w.x = cvt_pk_bf16(v[0], v[1]); w.y = cvt_pk_bf16(v[2], v[3]); hr[64 * j] = w; }
            s = wave_sum(s);
            if (F.lane < 16) ss[(size_t)m * 16 + F.lane] = (F.lane == 0) ? s : 0.f;
        }
    }
    {
        float* rope = (float*)(F.ws + WS_ROPE);
        for (int idx = F.bid * 512 + F.tid; idx < SEQ * 16; idx += F.G * 512) {
            const int pos = idx >> 4, f = idx & 15;
            const float inv_freq = powf(10000.0f, -(float)(2 * f) / 32.0f);
            const float ang = (float)pos * inv_freq;
            const double ad = (double)ang; const double kq = rint(ad * 0.15915494309189535);
            const float rr = (float)(ad - kq * 6.283185307179586);
            rope[pos * 32 + f] = cosf(rr); rope[pos * 32 + 16 + f] = sinf(rr);
        }
    }
    if (F.bid < 4) {
        const int li = F.bid; const float* pos = a.in[10] + (size_t)li * 2048; const float* w1 = a.in[11] + (size_t)li * 2048 * 128;
        const int n = F.tid & 127, kq = F.tid >> 7; float s = 0.f;
        for (int k = kq * 512; k < kq * 512 + 512; ++k) s += pos[k] * w1[(size_t)k * 128 + n];
        LAS float* red = (LAS float*)(F.lds + 8 * 16384);
        red[F.tid] = s; __syncthreads();
        if (F.tid < 128) ((float*)(F.ws + WS_CB1))[li * 128 + F.tid] = (red[F.tid] + red[128 + F.tid]) + (red[256 + F.tid] + red[384 + F.tid]);
        __syncthreads();
    }
    if (F.bid == 4) { bf16_t* kc = (bf16_t*)(F.ws + WS_KC); for (int i = F.tid; i < 8 * 64; i += 512) kc[((size_t)(i >> 6) * 512 + 511) * 64 + (i & 63)] = 0; }
}
constexpr int ASTR = 528;
constexpr int ASTR2 = 272;

__device__ __forceinline__ void conv_tile(Frame& F, int l, int tile) {
    const int T0 = tile * 64, tb = T0 & (SEQ - 1);
    const bf16_t* U = (const bf16_t*)(F.ws + WS_U); bf16_t* CAT = (bf16_t*)(F.ws + WS_CAT);
    LAS bf16_t* glu = (LAS bf16_t*)F.lds;
    LAS float* cv = (LAS float*)(F.lds + 49152);
    LAS unsigned char* At = F.lds;
    for (int p = F.tid; p < 94 * 32; p += 512) {
        const int r = p >> 5, c8 = (p & 31) * 8; u32x4 o = {0u, 0u, 0u, 0u};
        if (tb - 30 + r >= 0) {
            const bf16_t* up = U + (size_t)(T0 - 30 + r) * NU + c8;
            const u32x4 av = *(const u32x4*)(up + UC_A), gv = *(const u32x4*)(up + UC_G);
#pragma unroll
            for (int e = 0; e < 4; ++e) {
                const float a0 = __uint_as_float(av[e] << 16), a1 = __uint_as_float(av[e] & 0xffff0000u), g0 = __uint_as_float(gv[e] << 16), g1 = __uint_as_float(gv[e] & 0xffff0000u);
                o[e] = cvt_pk_bf16(a0 * sigmoidf_(g0), a1 * sigmoidf_(g1)); }
        }
        *(LAS u32x4*)(glu + r * 256 + c8) = o;
    }
    __syncthreads();
    {
        const int c = F.tid & 255, half = F.tid >> 8; float w[31];
        const float* dw = IN(F, 5) + (size_t)l * 31 * 256 + c;
#pragma unroll
        for (int k = 0; k < 31; ++k) w[k] = dw[k * 256];
        const float bias = IN(F, 6)[l * 256 + c];
#pragma unroll 1
        for (int i = 0; i < 32; ++i) {
            const LAS bf16_t* gp = glu + (32 * half + i) * 256 + c; float acc = bias;
#pragma unroll
            for (int k = 0; k < 31; ++k) acc += w[k] * bf2f(gp[k * 256]);
            cv[(32 * half + i) * 256 + c] = acc;
        }
    }
    __syncthreads();
    {
        const f32x4 g4 = *((const f32x4*)(IN(F, 7) + l * 256) + F.lane), b4 = *((const f32x4*)(IN(F, 8) + l * 256) + F.lane);
        for (int tt = 0; tt < 8; ++tt) {
            const int row = 8 * F.wave + tt; const f32x4 x = *((const LAS f32x4*)(cv + row * 256) + F.lane);
            const float mean = wave_sum((x[0] + x[1]) + (x[2] + x[3])) * (1.f / 256.f); const f32x4 d = x - mean;
            const float var = wave_sum((d[0] * d[0] + d[1] * d[1]) + (d[2] * d[2] + d[3] * d[3])) * (1.f / 256.f); const float rstd = 1.0f / sqrtf(var + EPS);
            f32x4 y = d * rstd * g4 + b4;
#pragma unroll
            for (int e = 0; e < 4; ++e) y[e] = y[e] * sigmoidf_(y[e]);
            u32x2 wv; wv.x = cvt_pk_bf16(y[0], y[1]); wv.y = cvt_pk_bf16(y[2], y[3]);
            *(LAS u32x2*)(At + row * ASTR + F.lane * 8) = wv;
        }
    }
    __syncthreads();
    {
        const bf16_t* pwT = (const bf16_t*)(F.ws + WS_W + (size_t)l * W_LAYER + WO_PW); const int r32 = F.lane & 31, hi = F.lane >> 5;
        for (int j = 0; j < 2; ++j) {
            const int task = F.wave + 8 * j, rb = task & 1, cb = task >> 1;
            const f32x16 acc = small_mm<256>(At + rb * 32 * ASTR, ASTR, pwT + (size_t)cb * 32 * 256, F.lane);
#pragma unroll
            for (int r = 0; r < 16; ++r) CAT[(size_t)(T0 + rb * 32 + crow(r, hi)) * DMODEL + CC_CONV + cb * 32 + r32] = f2bf(acc[r]);
        }
    }
    __syncthreads();
}

__device__ __forceinline__ void pool_tile(Frame& F, int l, int tile) {
    const int T0 = tile * 64, tb = T0 & (SEQ - 1);
    const bf16_t* U = (const bf16_t*)(F.ws + WS_U); bf16_t* CAT = (bf16_t*)(F.ws + WS_CAT);
    LAS float* P = (LAS float*)F.lds;
    LAS unsigned char* At = F.lds + 81920;
    for (int p = F.tid; p < 79 * 32; p += 512) {
        const int r = p >> 5, c8 = (p & 31) * 8; f32x4 lo = {0.f, 0.f, 0.f, 0.f}, hi4 = lo;
        if (tb - 15 + r >= 0) { const u32x4 v = *(const u32x4*)(U + (size_t)(T0 - 15 + r) * NU + UC_POOL + c8);
            lo = (f32x4){__uint_as_float(v[0] << 16), __uint_as_float(v[0] & 0xffff0000u), __uint_as_float(v[1] << 16), __uint_as_float(v[1] & 0xffff0000u)};
            hi4 = (f32x4){__uint_as_float(v[2] << 16), __uint_as_float(v[2] & 0xffff0000u), __uint_as_float(v[3] << 16), __uint_as_float(v[3] & 0xffff0000u)}; }
        *(LAS f32x4*)(P + r * 256 + c8) = lo; *(LAS f32x4*)(P + r * 256 + c8 + 4) = hi4;
    }
    __syncthreads();
    {
        const int c = F.tid & 255, half = F.tid >> 8, w = 2 << (c >> 6);
        for (int i = 0; i < 32; ++i) {
            const int row = 32 * half + i, tpos = tb + row; const int cnt = (tpos + 1 < w) ? tpos + 1 : w; float s = 0.f;
            for (int j = 0; j < w; ++j) s += P[(15 + row - j) * 256 + c];
            const float d = s / (float)cnt - P[(15 + row) * 256 + c];
            *(LAS bf16_t*)(At + row * ASTR + c * 2) = f2bf(d);
        }
    }
    __syncthreads();
    {
        const bf16_t* plT = (const bf16_t*)(F.ws + WS_W + (size_t)l * W_LAYER + WO_POOL); const int r32 = F.lane & 31, hi = F.lane >> 5;
        for (int j = 0; j < 2; ++j) {
            const int task = F.wave + 8 * j, rb = task & 1, g = (task >> 1) & 3, cbl = task >> 3;
            const f32x16 acc = small_mm<64>(At + rb * 32 * ASTR + g * 128, ASTR, plT + (size_t)g * 4096 + (size_t)cbl * 32 * 64, F.lane);
            const int col = g * 64 + cbl * 32 + r32; const float sc = IN(F, 18)[l * 256 + col];
#pragma unroll
            for (int r = 0; r < 16; ++r) CAT[(size_t)(T0 + rb * 32 + crow(r, hi)) * DMODEL + CC_POOL + col] = f2bf(acc[r] * sc);
        }
    }
    __syncthreads();
}

__device__ __forceinline__ void mla_tile(Frame& F, int l, int tile) {
    const int T0 = tile * 64, tb = T0 & (SEQ - 1), b = T0 >> 13;
    const bf16_t* U = (const bf16_t*)(F.ws + WS_U); const float* rope = (const float*)(F.ws + WS_ROPE);
    bf16_t* QM = (bf16_t*)(F.ws + WS_QM); bf16_t* KM = (bf16_t*)(F.ws + WS_KM); bf16_t* VM = (bf16_t*)(F.ws + WS_VM);
    LAS unsigned char* Aq = F.lds; LAS unsigned char* Akv = F.lds + 33792;
    for (int tt = 0; tt < 8; ++tt) {
        const int row = 8 * F.wave + tt; const bf16_t* up = U + (size_t)(T0 + row) * NU;
        { const u32x2 v = *((const u32x2*)(up + UC_CQ) + F.lane);
          const float x0 = __uint_as_float(v.x << 16), x1 = __uint_as_float(v.x & 0xffff0000u), x2 = __uint_as_float(v.y << 16), x3 = __uint_as_float(v.y & 0xffff0000u);
          const float rs = 1.0f / sqrtf(wave_sum((x0 * x0 + x1 * x1) + (x2 * x2 + x3 * x3)) * (1.f / 256.f) + EPS);
          u32x2 w; w.x = cvt_pk_bf16(x0 * rs, x1 * rs); w.y = cvt_pk_bf16(x2 * rs, x3 * rs); *(LAS u32x2*)(Aq + row * ASTR + F.lane * 8) = w; }
        { const unsigned v = *((const unsigned*)(up + UC_CKV) + F.lane);
          const float x0 = __uint_as_float(v << 16), x1 = __uint_as_float(v & 0xffff0000u);
          const float rs = 1.0f / sqrtf(wave_sum(x0 * x0 + x1 * x1) * (1.f / 128.f) + EPS);
          *(LAS unsigned*)(Akv + row * ASTR2 + F.lane * 4) = cvt_pk_bf16(x0 * rs, x1 * rs); }
    }
    for (int j = 0; j < 2; ++j) {
        const int idx = F.tid + 512 * j, tok = idx >> 4, i = idx & 15, pos = tb + tok; const bf16_t* up = U + (size_t)(T0 + tok) * NU + UC_KR;
        const float x1 = bf2f(up[i]), x2 = bf2f(up[16 + i]), cs = rope[pos * 32 + i], sn = rope[pos * 32 + 16 + i];
        const unsigned short o1 = f2bf(x1 * cs - x2 * sn), o2 = f2bf(x1 * sn + x2 * cs);
#pragma unroll
        for (int h = 0; h < 4; ++h) { bf16_t* kp = KM + ((size_t)(b * 4 + h) * SEQ + pos) * 96 + 64; kp[i] = o1; kp[16 + i] = o2; }
    }
    __syncthreads();
    const int r32 = F.lane & 31, hi = F.lane >> 5;
    {
        const bf16_t* uqT = (const bf16_t*)(F.ws + WS_W + (size_t)l * W_LAYER + WO_UQ);
        for (int j = 0; j < 3; ++j) {
            const int task = F.wave + 8 * j, rb = task & 1, cb = task >> 1, head = cb / 3, part = cb % 3;
            const f32x16 acc = small_mm<256>(Aq + rb * 32 * ASTR, ASTR, uqT + (size_t)cb * 32 * 256, F.lane);
#pragma unroll
            for (int r = 0; r < 16; ++r) {
                const int pos = tb + rb * 32 + crow(r, hi); bf16_t* qp = QM + ((size_t)(b * 4 + head) * SEQ + pos) * 96;
                if (part < 2) qp[part * 32 + r32] = f2bf(acc[r]);
                else { const float other = __shfl_xor(acc[r], 16); const int i = r32 & 15; const float cs = rope[pos * 32 + i], sn = rope[pos * 32 + 16 + i];
                       const float o = (r32 < 16) ? (acc[r] * cs - other * sn) : (other * sn + acc[r] * cs); qp[64 + r32] = f2bf(o); }
            }
        }
    }
    {
        const bf16_t* ukvT = (const bf16_t*)(F.ws + WS_W + (size_t)l * W_LAYER + WO_UKV);
        for (int j = 0; j < 4; ++j) {
            const int task = F.wave + 8 * j, rb = task & 1, cb = task >> 1, head = cb >> 2, part = cb & 3;
            const f32x16 acc = small_mm<128>(Akv + rb * 32 * ASTR2, ASTR2, ukvT + (size_t)cb * 32 * 128, F.lane);
#pragma unroll
            for (int r = 0; r < 16; ++r) {
                const int pos = tb + rb * 32 + crow(r, hi); const size_t rowi = (size_t)(b * 4 + head) * SEQ + pos;
                if (part < 2) KM[rowi * 96 + part * 32 + r32] = f2bf(acc[r]); else VM[rowi * 64 + (part - 2) * 32 + r32] = f2bf(acc[r]);
            }
        }
    }
    __syncthreads();
}

__device__ __forceinline__ void compress_item(Frame& F, int l, int item) {
    const int i = item >> 6, b = (item >> 4) & 3, gq = item & 15, c0 = 32 * gq, tok0 = 16 * c0;
    const bf16_t* U = (const bf16_t*)(F.ws + WS_U); bf16_t* KC = (bf16_t*)(F.ws + WS_KC);
    LAS unsigned char* Tk = F.lds;
    LAS float* part = (LAS float*)(F.lds + 67584);
    LAS unsigned char* A2 = F.lds + 83968;
    for (int p = F.tid; p < 528 * 8; p += 512) {
        const int r = p >> 3, ch = p & 7; u32x4 v = {0u, 0u, 0u, 0u};
        if (tok0 + r < SEQ) v = *(const u32x4*)(U + (size_t)(b * SEQ + tok0 + r) * NU + UC_KV + i * 64 + ch * 8);
        *(LAS u32x4*)(Tk + r * 128 + ((ch ^ ((r >> 4) & 7)) * 16)) = v;
    }
    __syncthreads();
    const int r32 = F.lane & 31, hi = F.lane >> 5, cb = F.wave & 3, kh = F.wave >> 2;
    const unsigned char* wl = F.ws + WS_W + (size_t)l * W_LAYER;
    f32x16 acc = {};
    {
        const bf16_t* bp = (const bf16_t*)(wl + WO_C1) + (size_t)i * 128 * 2048 + (size_t)(cb * 32 + r32) * 2048 + hi * 8;
#pragma unroll 4
        for (int ks = kh * 64; ks < kh * 64 + 64; ++ks) {
            const int ll = ks >> 2, dq = ks & 3, token = 16 * r32 + ll, chunk = dq * 2 + hi;
            const bf16x8 av = *(const LAS bf16x8*)(Tk + token * 128 + ((chunk ^ ((token >> 4) & 7)) * 16));
            const bf16x8 bv = *(const bf16x8*)(bp + ks * 16);
            acc = __builtin_amdgcn_mfma_f32_32x32x16_bf16(av, bv, acc, 0, 0, 0);
        }
    }
    if (kh == 1) {
#pragma unroll
        for (int r = 0; r < 16; ++r) part[cb * 1024 + r * 64 + F.lane] = acc[r];
    }
    __syncthreads();
    if (kh == 0) {
        const float bias = ((const float*)(F.ws + WS_CB1))[(l * 2 + i) * 128 + cb * 32 + r32];
#pragma unroll
        for (int r = 0; r < 16; ++r) { float h = acc[r] + part[cb * 1024 + r * 64 + F.lane] + bias; h = h * sigmoidf_(h);
            *(LAS bf16_t*)(A2 + crow(r, hi) * ASTR2 + (cb * 32 + r32) * 2) = f2bf(h); }
    }
    __syncthreads();
    if (F.wave < 2) {
        const f32x16 o = small_mm<128>(A2, ASTR2, (const bf16_t*)(wl + WO_C2) + (size_t)i * 64 * 128 + (size_t)F.wave * 32 * 128, F.lane);
#pragma unroll
        for (int r = 0; r < 16; ++r) { const int row = c0 + crow(r, hi); KC[((size_t)(i * 4 + b) * 512 + row) * 64 + F.wave * 32 + r32] = (row < 511) ? f2bf(o[r]) : (bf16_t)0; }
    }
    __syncthreads();
}

__device__ __forceinline__ void phaseB(Frame F, int l) {
    LAUNDER(F);
#ifndef SKIP_B1
    for (int t = F.bid; t < MTOK / 64; t += F.G) conv_tile(F, l, t);
#endif
#ifndef SKIP_B2
    for (int t = F.bid; t < MTOK / 64; t += F.G) pool_tile(F, l, t);
#endif
#ifndef SKIP_B3
    for (int t = F.bid; t < MTOK / 64; t += F.G) mla_tile(F, l, t);
#endif
#ifndef SKIP_B4
    for (int t = F.G - 1 - F.bid; t < 128; t += F.G) compress_item(F, l, t);
#endif
}
namespace att {
constexpr int KSLOT = 12288, VSLOT = 8192;
constexpr int L_K = 0, L_V = 2 * KSLOT, L_WS = L_V + 2 * VSLOT, L_BT = L_WS + 2048, L_IMP = L_BT + 2304, L_SEL = L_IMP + 32768, L_GATE = L_SEL + 1024, L_OACC = L_GATE + 3072, L_END = L_OACC + 65536;
static_assert(L_END <= LDS_BYTES, "attention LDS");
constexpr float NEG_INF = -__builtin_inff();

struct TileSrc { const bf16_t* K; int kpitch; const bf16_t* V; int vpitch; };
struct Stage { u32x4 k0, k1, v; };

template <int DQK> __device__ __forceinline__ void stage_load(Stage& s, const TileSrc& T, int kv0, int wid, int lane) {
    const bf16_t* kp = T.K + (size_t)(kv0 + lane) * T.kpitch;
    s.k0 = *(const u32x4*)(kp + wid * 8);
    if (DQK == 96) { if (wid < 4) s.k1 = *(const u32x4*)(kp + (wid + 8) * 8); }
    s.v = *(const u32x4*)(T.V + (size_t)(kv0 + 16 * (wid & 3) + (lane >> 2)) * T.vpitch + (wid >> 2) * 32 + (lane & 3) * 8);
}
template <int DQK> __device__ __forceinline__ void stage_write(const Stage& s, LAS unsigned char* lds, int slot, int wid, int lane) {
    *(LAS u32x4*)(lds + L_K + slot * KSLOT + wid * 1024 + lane * 16) = s.k0;
    if (DQK == 96) { if (wid < 4) *(LAS u32x4*)(lds + L_K + slot * KSLOT + (wid + 8) * 1024 + lane * 16) = s.k1; }
    *(LAS u32x4*)(lds + L_V + slot * VSLOT + wid * 1024 + lane * 16) = s.v;
}
template <int DQK> __device__ __forceinline__ void qk(f32x16& p0, f32x16& p1, const LAS unsigned char* kslot, const bf16x8* qf, float cinit, int r32, int hi) {
#pragma unroll
    for (int r = 0; r < 16; ++r) { p0[r] = cinit; p1[r] = cinit; }
    const LAS unsigned char* kb = kslot + hi * 1024 + r32 * 16;
#pragma unroll
    for (int d0 = 0; d0 < DQK / 16; ++d0) {
        const bf16x8 b0 = *(const LAS bf16x8*)(kb + d0 * 2048), b1 = *(const LAS bf16x8*)(kb + d0 * 2048 + 512);
        p0 = __builtin_amdgcn_mfma_f32_32x32x16_bf16(b0, qf[d0], p0, 0, 0, 0);
        p1 = __builtin_amdgcn_mfma_f32_32x32x16_bf16(b1, qf[d0], p1, 0, 0, 0);
    }
}
__device__ __forceinline__ float half_swap_max(float v) { auto rr = __builtin_amdgcn_permlane32_swap(__float_as_uint(v), __float_as_uint(v), false, false); return fmaxf(__uint_as_float(rr[0]), __uint_as_float(rr[1])); }
__device__ __forceinline__ float half_swap_sum(float v) { auto rr = __builtin_amdgcn_permlane32_swap(__float_as_uint(v), __float_as_uint(v), false, false); return __uint_as_float(rr[0]) + __uint_as_float(rr[1]); }
__device__ __forceinline__ float rowmax(const f32x16& p0, const f32x16& p1) {
    float a = fmaxf(p0[0], p1[0]);
#pragma unroll
    for (int r = 1; r < 16; ++r) a = fmaxf(a, fmaxf(p0[r], p1[r]));
    return half_swap_max(a);
}
__device__ __forceinline__ s16x4 vtr(const LAS unsigned char* p) { return __builtin_bit_cast(s16x4, __builtin_amdgcn_ds_read_tr16_b64_v4i16((LAS s16x4*)p)); }
__device__ __forceinline__ void pv(f32x16 (&o)[2], const f32x16& p0, const f32x16& p1, const LAS unsigned char* vslot, int lane) {
    u32x4 pw[4];
#pragma unroll
    for (int e = 0; e < 4; ++e) { pw[0][e] = cvt_pk_bf16(p0[2 * e], p0[2 * e + 1]); pw[1][e] = cvt_pk_bf16(p0[8 + 2 * e], p0[9 + 2 * e]);
                                  pw[2][e] = cvt_pk_bf16(p1[2 * e], p1[2 * e + 1]); pw[3][e] = cvt_pk_bf16(p1[8 + 2 * e], p1[9 + 2 * e]); }
    const int hi = lane >> 5;
    const LAS unsigned char* vb = vslot + ((lane >> 4) & 1) * 32 + (lane & 3) * 8 + (4 * hi + ((lane & 15) >> 2)) * 64;
#pragma unroll
    for (int d0 = 0; d0 < 2; ++d0)
#pragma unroll
        for (int ks = 0; ks < 4; ++ks) {
            const s16x4 lo = vtr(vb + d0 * 4096 + ks * 1024), hh = vtr(vb + d0 * 4096 + ks * 1024 + 512);
            const bf16x8 vf = (bf16x8){lo[0], lo[1], lo[2], lo[3], hh[0], hh[1], hh[2], hh[3]};
            o[d0] = __builtin_amdgcn_mfma_f32_32x32x16_bf16(__builtin_bit_cast(bf16x8, pw[ks]), vf, o[d0], 0, 0, 0);
        }
}
__device__ __forceinline__ void softmax_pv(f32x16& p0, f32x16& p1, float& m, float& l, f32x16 (&o)[2], const LAS unsigned char* vslot, LAS float* wsf, int lane) {
    const int r32 = lane & 31, hi = lane >> 5;
    const float rm = rowmax(p0, p1), mn = fmaxf(m, rm), ms = (mn == NEG_INF) ? 0.f : mn;
    const float alpha = __builtin_amdgcn_exp2f(m - ms);
    const bool need = __any(mn > m) != 0;
    m = mn;
    float sum = 0.f;
#pragma unroll
    for (int r = 0; r < 16; ++r) { p0[r] = __builtin_amdgcn_exp2f(p0[r] - ms); p1[r] = __builtin_amdgcn_exp2f(p1[r] - ms); sum += p0[r] + p1[r]; }
    l = l * alpha + sum;
    if (need) {
        if (hi == 0) wsf[r32] = alpha;
        __builtin_amdgcn_fence(__ATOMIC_RELEASE, "wavefront"); __builtin_amdgcn_wave_barrier();
#pragma unroll
        for (int r = 0; r < 16; ++r) { const float f = wsf[crow(r, hi)]; o[0][r] *= f; o[1][r] *= f; }
    }
    pv(o, p0, p1, vslot, lane);
}
__device__ __forceinline__ void scaled_add(LAS float* oacc, const f32x16 (&o)[2], float f, LAS float* wsf, int lane, bool assign) {
    const int r32 = lane & 31, hi = lane >> 5;
    if (hi == 0) wsf[32 + r32] = f;
    __builtin_amdgcn_fence(__ATOMIC_RELEASE, "wavefront"); __builtin_amdgcn_wave_barrier();
#pragma unroll
    for (int r = 0; r < 16; ++r) { const float g = wsf[32 + crow(r, hi)];
        if (assign) { oacc[r * 64 + lane] = o[0][r] * g; oacc[(16 + r) * 64 + lane] = o[1][r] * g; } else { oacc[r * 64 + lane] += o[0][r] * g; oacc[(16 + r) * 64 + lane] += o[1][r] * g; } }
}
__device__ __forceinline__ void store_oacc(const LAS float* oacc, bf16_t* dst, int pitch, int lane) {
    const int r32 = lane & 31, hi = lane >> 5;
#pragma unroll
    for (int r = 0; r < 16; ++r) { bf16_t* rp = dst + (size_t)crow(r, hi) * pitch; rp[r32] = f2bf(oacc[r * 64 + lane]); rp[32 + r32] = f2bf(oacc[(16 + r) * 64 + lane]); }
}
__device__ __forceinline__ void mla_unit(Frame F, int b, int h, int qb) {
    LAUNDER(F);
    LAS unsigned char* lds = F.lds; LAS float* wsf = (LAS float*)(lds + L_WS) + F.wave * 64;
    const int wid = F.wave, lane = F.lane, r32 = lane & 31, hi = lane >> 5;
    const size_t hrow = (size_t)(b * 4 + h) * SEQ;
    const bf16_t* QM = (const bf16_t*)(F.ws + WS_QM) + hrow * 96;
    TileSrc T; T.K = (const bf16_t*)(F.ws + WS_KM) + hrow * 96; T.kpitch = 96; T.V = (const bf16_t*)(F.ws + WS_VM) + hrow * 64; T.vpitch = 64;
    const int q0 = qb * 256, qw0 = q0 + 32 * wid, qrow = qw0 + r32;
    bf16x8 qf[6];
#pragma unroll
    for (int d0 = 0; d0 < 6; ++d0) qf[d0] = *(const bf16x8*)(QM + (size_t)qrow * 96 + d0 * 16 + hi * 8);
    float m = NEG_INF, l = 0.f; f32x16 o[2]; o[0] = f32x16{}; o[1] = f32x16{};
    const int NT = (q0 + 256) / 64;
    Stage st; stage_load<96>(st, T, 0, wid, lane); stage_write<96>(st, lds, 0, wid, lane); __syncthreads();
    for (int t = 0; t < NT; ++t) {
        if (t + 1 < NT) stage_load<96>(st, T, 64 * (t + 1), wid, lane);
        const int kv0 = 64 * t;
        if (kv0 <= qw0 + 31) {
            f32x16 p0, p1; qk<96>(p0, p1, lds + L_K + (t & 1) * KSLOT, qf, 0.f, r32, hi);
            if (kv0 + 63 > qw0) {
#pragma unroll
                for (int r = 0; r < 16; ++r) { const int kv = kv0 + crow(r, hi); if (kv > qrow) p0[r] = NEG_INF; if (kv + 32 > qrow) p1[r] = NEG_INF; }
            }
            softmax_pv(p0, p1, m, l, o, lds + L_V + (t & 1) * VSLOT, wsf, lane);
        }
        if (t + 1 < NT) stage_write<96>(st, lds, (t + 1) & 1, wid, lane);
        __syncthreads();
    }
    const float lt = half_swap_sum(l); const float inv = lt > 0.f ? 1.0f / lt : 0.f;
    LAS float* oacc = (LAS float*)(lds + L_OACC) + F.wave * 2048;
    scaled_add(oacc, o, inv, wsf, lane, true);
    store_oacc(oacc, (bf16_t*)(F.ws + WS_CAT) + (size_t)(b * SEQ + qw0) * DMODEL + CC_MLA + h * 64, DMODEL, lane);
}

__device__ __forceinline__ void nsa_unit(Frame F, int b, int qt) {
    LAUNDER(F);
    LAS unsigned char* lds = F.lds; LAS float* wsf = (LAS float*)(lds + L_WS) + F.wave * 64;
    LAS float* bt = (LAS float*)(lds + L_BT); LAS float* imp = (LAS float*)(lds + L_IMP); LAS unsigned* sel = (LAS unsigned*)(lds + L_SEL); LAS float* gate = (LAS float*)(lds + L_GATE);
    const int wid = F.wave, lane = F.lane, tid = F.tid, r32 = lane & 31, hi = lane >> 5, h = wid & 3, qh = wid >> 2;
    const int t0 = 64 * qt, qi = 32 * qh + r32, t = t0 + qi;
    const bf16_t* U = (const bf16_t*)(F.ws + WS_U) + (size_t)b * SEQ * NU;
    bf16x8 qf[4];
#pragma unroll
    for (int d0 = 0; d0 < 4; ++d0) qf[d0] = *(const bf16x8*)(U + (size_t)t * NU + UC_Q + h * 64 + d0 * 16 + hi * 8);
    for (int idx = tid; idx < 64 * 12; idx += 512) { const int q = idx / 12, k = idx - q * 12; gate[idx] = sigmoidf_(bf2f(U[(size_t)(t0 + q) * NU + UC_GATE + k])); }
    for (int idx = tid; idx < 64 * 128; idx += 512) imp[idx] = 0.f;
    __syncthreads();
    const LAS float* bth = bt + h * 132;
    LAS float* outacc = (LAS float*)(lds + L_OACC) + F.wave * 2048;
#ifndef SKIP_N1
    {
        const bf16_t* KC = (const bf16_t*)(F.ws + WS_KC);
        TileSrc T; T.K = KC + (size_t)(0 * 4 + b) * 512 * 64; T.kpitch = 64; T.V = KC + (size_t)(1 * 4 + b) * 512 * 64; T.vpitch = 64;
        const int NTc = (((t0 + 32) >> 4) >> 6) + 1;
        float m = NEG_INF, l = 0.f; Stage st;
        stage_load<64>(st, T, 0, wid, lane); stage_write<64>(st, lds, 0, wid, lane); __syncthreads();
        for (int ct = 0; ct < NTc; ++ct) {
            if (ct + 1 < NTc) stage_load<64>(st, T, 64 * (ct + 1), wid, lane);
            f32x16 p0, p1; qk<64>(p0, p1, lds + L_K + (ct & 1) * KSLOT, qf, 0.f, r32, hi);
#pragma unroll
            for (int r = 0; r < 16; ++r) { const int c = 64 * ct + crow(r, hi); const int d0 = t - (16 * c + 31), d1 = d0 - 512;
                p0[r] = (d0 >= 0) ? p0[r] + bth[d0 < 128 ? d0 : 128] : NEG_INF; p1[r] = (d1 >= 0) ? p1[r] + bth[d1 < 128 ? d1 : 128] : NEG_INF; }
            const float rm = rowmax(p0, p1), mn = fmaxf(m, rm), ms = (mn == NEG_INF) ? 0.f : mn; const float alpha = __builtin_amdgcn_exp2f(m - ms); m = mn; float sum = 0.f;
#pragma unroll
            for (int r = 0; r < 16; ++r) sum += __builtin_amdgcn_exp2f(p0[r] - ms) + __builtin_amdgcn_exp2f(p1[r] - ms);
            l = l * alpha + sum;
            if (ct + 1 < NTc) stage_write<64>(st, lds, (ct + 1) & 1, wid, lane);
            __syncthreads();
        }
        const float lt = half_swap_sum(l), inv = lt > 0.f ? 1.0f / lt : 0.f, ms = (m == NEG_INF) ? 0.f : m;
        f32x16 o[2]; o[0] = f32x16{}; o[1] = f32x16{};
        stage_load<64>(st, T, 0, wid, lane); stage_write<64>(st, lds, 0, wid, lane); __syncthreads();
        for (int ct = 0; ct < NTc; ++ct) {
            if (ct + 1 < NTc) stage_load<64>(st, T, 64 * (ct + 1), wid, lane);
            f32x16 p0, p1; qk<64>(p0, p1, lds + L_K + (ct & 1) * KSLOT, qf, 0.f, r32, hi);
#pragma unroll
            for (int r = 0; r < 16; ++r) { const int c = 64 * ct + crow(r, hi); const int d0 = t - (16 * c + 31), d1 = d0 - 512;
                p0[r] = (d0 >= 0) ? __builtin_amdgcn_exp2f(p0[r] + bth[d0 < 128 ? d0 : 128] - ms) * inv : 0.f;
                p1[r] = (d1 >= 0) ? __builtin_amdgcn_exp2f(p1[r] + bth[d1 < 128 ? d1 : 128] - ms) * inv : 0.f; }
            LAS float* ip = imp + qi * 128 + 16 * ct + hi;
#pragma unroll
            for (int g = 0; g < 4; ++g) {
                const float a0 = (p0[4 * g] + p0[4 * g + 1]) + (p0[4 * g + 2] + 0.5f * p0[4 * g + 3]), b0 = 0.5f * p0[4 * g + 3];
                const float a1 = (p1[4 * g] + p1[4 * g + 1]) + (p1[4 * g + 2] + 0.5f * p1[4 * g + 3]), b1 = 0.5f * p1[4 * g + 3];
                const int j0 = 2 * g, j1 = 8 + 2 * g;
                atomicAdd((float*)(ip + j0), a0); atomicAdd((float*)(ip + j1), a1);
                if (16 * ct + hi + j0 + 1 < 128) atomicAdd((float*)(ip + j0 + 1), b0);
                if (16 * ct + hi + j1 + 1 < 128) atomicAdd((float*)(ip + j1 + 1), b1);
            }
            pv(o, p0, p1, lds + L_V + (ct & 1) * VSLOT, lane);
            if (ct + 1 < NTc) stage_write<64>(st, lds, (ct + 1) & 1, wid, lane);
            __syncthreads();
        }
        scaled_add(outacc, o, gate[qi * 12 + h * 3 + 0], wsf, lane, true);
    }
#else
    for (int i = 0; i < 32; ++i) outacc[i * 64 + lane] = 0.f;
#endif
#ifndef SKIP_N2
    {
        const int jc = qt;
        for (int qq = 0; qq < 8; ++qq) {
            const int q = 8 * wid + qq; unsigned long long m0, m1;
            if (jc + 1 <= 16) { m0 = (jc >= 63) ? ~0ull : ((1ull << (jc + 1)) - 1ull); m1 = 0ull; }
            else {
                const int ja = lane, jb2 = lane + 64;
                const float v0 = imp[q * 128 + ja], v1 = imp[q * 128 + jb2];
                const bool c0 = (ja >= 1 && ja <= jc - 2), c1 = (jb2 <= jc - 2);
                const unsigned u0 = c0 ? (__float_as_uint(v0) + 1u) : 0u, u1 = c1 ? (__float_as_uint(v1) + 1u) : 0u;
                unsigned thr = 0u;
                for (int bit = 31; bit >= 0; --bit) { const unsigned tr = thr | (1u << bit);
                    const int cnt = __popcll(__ballot(u0 >= tr)) + __popcll(__ballot(u1 >= tr)); if (cnt >= 13) thr = tr; }
                const unsigned long long g0 = __ballot(u0 > thr), g1 = __ballot(u1 > thr), e0 = __ballot(u0 == thr), e1 = __ballot(u1 == thr);
                int need = 13 - (__popcll(g0) + __popcll(g1));
                const unsigned long long lt_mask = (1ull << lane) - 1ull;
                const int rk0 = __popcll(e0 & lt_mask), rk1 = __popcll(e0) + __popcll(e1 & lt_mask);
                const bool s0 = (u0 > thr) || (u0 == thr && rk0 < need) || ja == 0 || ja == jc || ja == jc - 1;
                const bool s1 = (u1 > thr) || (u1 == thr && rk1 < need) || jb2 == jc || jb2 == jc - 1;
                m0 = __ballot(s0); m1 = __ballot(s1);
            }
            if (lane == 0) { sel[q * 4 + 0] = (unsigned)m0; sel[q * 4 + 1] = (unsigned)(m0 >> 32); sel[q * 4 + 2] = (unsigned)m1; sel[q * 4 + 3] = (unsigned)(m1 >> 32); }
        }
    }
    __syncthreads();
#endif
#ifndef SKIP_N3
    {
        TileSrc T; T.K = U + UC_KV + 128; T.kpitch = NU; T.V = U + UC_KV + 192; T.vpitch = NU;
        const int NT = qt + 1; const float cfar = bth[128];
        float m = NEG_INF, l = 0.f; f32x16 o[2]; o[0] = f32x16{}; o[1] = f32x16{}; Stage st;
        stage_load<64>(st, T, 0, wid, lane); stage_write<64>(st, lds, 0, wid, lane); __syncthreads();
        for (int jt = 0; jt < NT; ++jt) {
            if (jt + 1 < NT) stage_load<64>(st, T, 64 * (jt + 1), wid, lane);
            const bool selb = ((sel[qi * 4 + (jt >> 5)] >> (jt & 31)) & 1u) != 0u;
            if (__any(selb)) {
                const bool near = (jt >= qt - 2);
                f32x16 p0, p1; qk<64>(p0, p1, lds + L_K + (jt & 1) * KSLOT, qf, near ? 0.f : cfar, r32, hi);
                if (near) {
#pragma unroll
                    for (int r = 0; r < 16; ++r) { const int d0 = t - (64 * jt + crow(r, hi)), d1 = d0 - 32;
                        p0[r] = (selb && d0 >= 0) ? p0[r] + bth[d0 < 128 ? d0 : 128] : NEG_INF; p1[r] = (selb && d1 >= 0) ? p1[r] + bth[d1 < 128 ? d1 : 128] : NEG_INF; }
                } else if (!selb) {
#pragma unroll
                    for (int r = 0; r < 16; ++r) { p0[r] = NEG_INF; p1[r] = NEG_INF; }
                }
                softmax_pv(p0, p1, m, l, o, lds + L_V + (jt & 1) * VSLOT, wsf, lane);
            }
            if (jt + 1 < NT) stage_write<64>(st, lds, (jt + 1) & 1, wid, lane);
            __syncthreads();
        }
        const float lt = half_swap_sum(l);
        scaled_add(outacc, o, lt > 0.f ? gate[qi * 12 + h * 3 + 1] / lt : 0.f, wsf, lane, false);
    }
#endif
#ifndef SKIP_N4
    {
        TileSrc T; T.K = U + UC_KV + 256; T.kpitch = NU; T.V = U + UC_KV + 320; T.vpitch = NU;
        const int j_lo = qt >= 8 ? qt - 8 : 0; const float cfar = bth[128];
        float m = NEG_INF, l = 0.f; f32x16 o[2]; o[0] = f32x16{}; o[1] = f32x16{}; Stage st;
        stage_load<64>(st, T, 64 * j_lo, wid, lane); stage_write<64>(st, lds, 0, wid, lane); __syncthreads();
        for (int jt = j_lo; jt <= qt; ++jt) {
            const int it = jt - j_lo;
            if (jt < qt) stage_load<64>(st, T, 64 * (jt + 1), wid, lane);
            const bool edge = (jt >= qt - 2) || (jt == qt - 8);
            f32x16 p0, p1; qk<64>(p0, p1, lds + L_K + (it & 1) * KSLOT, qf, edge ? 0.f : cfar, r32, hi);
            if (edge) {
#pragma unroll
                for (int r = 0; r < 16; ++r) { const int d0 = t - (64 * jt + crow(r, hi)), d1 = d0 - 32;
                    p0[r] = (d0 >= 0 && d0 < 512) ? p0[r] + bth[d0 < 128 ? d0 : 128] : NEG_INF; p1[r] = (d1 >= 0 && d1 < 512) ? p1[r] + bth[d1 < 128 ? d1 : 128] : NEG_INF; }
            }
            softmax_pv(p0, p1, m, l, o, lds + L_V + (it & 1) * VSLOT, wsf, lane);
            if (jt < qt) stage_write<64>(st, lds, (it + 1) & 1, wid, lane);
            __syncthreads();
        }
        const float lt = half_swap_sum(l);
        scaled_add(outacc, o, lt > 0.f ? gate[qi * 12 + h * 3 + 2] / lt : 0.f, wsf, lane, false);
    }
#endif
    store_oacc(outacc, (bf16_t*)(F.ws + WS_CAT) + (size_t)(b * SEQ + t0 + 32 * qh) * DMODEL + CC_NSA + h * 64, DMODEL, lane);
    __syncthreads();
}

__device__ __forceinline__ void phaseC(Frame F) {
    LAUNDER(F);
    { LAS float* bt = (LAS float*)(F.lds + L_BT);
      for (int idx = F.tid; idx < 4 * 132; idx += 512) { const int h = idx / 132, d = idx - h * 132; bt[idx] = (d <= 128) ? IN(F, 21)[BUCKET[d] * 4 + h] * LOG2E : 0.f; }
      __syncthreads(); }
    for (int p = F.vcu; p < 256; p += F.G) {
#ifndef SKIP_C1
        { const int bh = p >> 4, s = p & 15; mla_unit(F, bh >> 2, bh & 3, 31 - s); mla_unit(F, bh >> 2, bh & 3, s); }
#endif
#ifndef SKIP_C2
        { const int b = p >> 6, s = p & 63; nsa_unit(F, b, 127 - s); nsa_unit(F, b, s); }
#endif
    }
}
}
constexpr int NTHREADS = 512;

template <class Sched> __device__ __forceinline__ void build_rs(Frame& F, const Sched& S) {
    LAS float* rs = (LAS float*)(F.lds + LDS_RS); const float* ss = (const float*)(F.ws + WS_SS); pg8::Unit u;
    for (int i = 0; S.next(i, u); ++i) {
        if (F.tid < 256) { const int row = u.pm * 256 + F.tid; const f32x4* p = (const f32x4*)(ss + (size_t)row * 16); const f32x4 v0 = p[0], v1 = p[1], v2 = p[2], v3 = p[3];
            const float s = (((v0[0] + v0[1]) + (v0[2] + v0[3])) + ((v1[0] + v1[1]) + (v1[2] + v1[3]))) + (((v2[0] + v2[1]) + (v2[2] + v2[3])) + ((v3[0] + v3[1]) + (v3[2] + v3[3])));
            rs[i * 256 + F.tid] = 1.0f / sqrtf(s * (1.f / DMODEL) + EPS); }
    }
    __syncthreads();
}

__device__ __forceinline__ void phaseA(Frame F, int l) {
    LAUNDER(F);
    pg8::Gemm g{(const bf16_t*)(F.ws + WS_HB), (const bf16_t*)(F.ws + WS_W + (size_t)l * W_LAYER + WO_WIN), MTOK, NU, DMODEL};
    pg8::StaticOrder S; S.init(MTOK, NU, F.G, F.bid);
    build_rs(F, S);
    pg8::EpiRowScale<0> E{(bf16_t*)(F.ws + WS_U), NU, (const LAS float*)(F.lds + LDS_RS)};
    pg8::gemm_phase<pg8::EpiRowScale<0>, pg8::StaticOrder, true, true>(F.lds, g, S, E);
}
__device__ __forceinline__ void phaseRes(Frame F, size_t a_off, size_t b_off, int K, bool first) {
    LAUNDER(F);
    float* out = (float*)IN(F, 23); const float* base = first ? IN(F, 0) : out;
    const bf16_t* A = (const bf16_t*)(F.ws + a_off); const bf16_t* Bt = (const bf16_t*)(F.ws + b_off);
    pg8::Gemm g{A, Bt, MTOK, DMODEL, K};
    pg8::StaticOrder S; S.init(MTOK, DMODEL, F.G, F.bid);
    pg8::EpiResidual E{base, out, (bf16_t*)(F.ws + WS_HB), (float*)(F.ws + WS_SS)};
    pg8::gemm_phase<pg8::EpiResidual, pg8::StaticOrder, true, true>(F.lds, g, S, E);
}
__device__ __forceinline__ void phaseE(Frame F, int l) {
    LAUNDER(F);
    pg8::Gemm g{(const bf16_t*)(F.ws + WS_HB), (const bf16_t*)(F.ws + WS_W + (size_t)l * W_LAYER + WO_W1), MTOK, DFF, DMODEL};
    pg8::StaticOrder S; S.init(MTOK, DFF, F.G, F.bid);
    build_rs(F, S);
    pg8::EpiRowScale<1> E{(bf16_t*)(F.ws + WS_Z), DFF, (const LAS float*)(F.lds + LDS_RS)};
    pg8::gemm_phase<pg8::EpiRowScale<1>, pg8::StaticOrder, true, true>(F.lds, g, S, E);
}
__device__ __forceinline__ void phaseG(Frame F) {
    LAUNDER(F);
    const float* ss = (const float*)(F.ws + WS_SS); const int gw = F.bid * 8 + F.wave, NGW = F.G * 8;
    const f32x4* gp = (const f32x4*)IN(F, 22) + F.lane; float* outp = (float*)IN(F, 23);
    for (int m = gw; m < MTOK; m += NGW) {
        float s = (F.lane < 16) ? ss[(size_t)m * 16 + F.lane] : 0.f; s = wave_sum(s);
        const float r = 1.0f / sqrtf(s * (1.f / DMODEL) + EPS);
        f32x4* hr = (f32x4*)(outp + (size_t)m * DMODEL) + F.lane;
#pragma unroll
        for (int j = 0; j < 4; ++j) { const f32x4 v = hr[64 * j]; hr[64 * j] = v * r * gp[64 * j]; }
    }
}

__global__ void __launch_bounds__(NTHREADS, 2) mega_fwd(Args a) {
    extern __shared__ __attribute__((aligned(16))) unsigned char lds_raw[];
    cg::grid_group grid = cg::this_grid();
    Frame F;
    F.lds = (LAS unsigned char*)lds_raw; F.tid = threadIdx.x; F.lane = F.tid & 63; F.wave = __builtin_amdgcn_readfirstlane(F.tid >> 6);
    F.G = gridDim.x; F.bid = blockIdx.x; F.vcu = (F.G % 8 == 0) ? (F.bid % 8) * (F.G / 8) + F.bid / 8 : F.bid; F.ws = a.ws;
#ifndef SKIP_P0
    prologue(a, F);
#endif
    grid.sync();
    for (int l = 0; l < NLAYER; ++l) {
#ifndef SKIP_PA
        phaseA(F, l);
#endif
        grid.sync();
#ifndef SKIP_PB
        phaseB(F, l);
#endif
        grid.sync();
#ifndef SKIP_PC
        att::phaseC(F);
#endif
        grid.sync();
#ifndef SKIP_PD
        phaseRes(F, WS_CAT, WS_W + (size_t)l * W_LAYER + WO_WOUT, DMODEL, l == 0);
#endif
        grid.sync();
#ifndef SKIP_PE
        phaseE(F, l);
#endif
        grid.sync();
#ifndef SKIP_PF
        phaseRes(F, WS_Z, WS_W + (size_t)l * W_LAYER + WO_W2, DFF, false);
#endif
        grid.sync();
    }
    phaseG(F);
}

extern "C" void kernel_launch(void* const* d_in, const int* in_sizes, int n_in, void* d_out, int out_size, void* d_ws, size_t ws_size, hipStream_t stream) {
    static int grid = 0;
    if (grid == 0) {
        if (n_in != 23 || out_size != MTOK * DMODEL || ws_size < WS_END) { fprintf(stderr, "kernel_launch: unexpected shapes: n_in %d out %d ws %zu (need >= %zu)\n", n_in, out_size, ws_size, (size_t)WS_END); grid = -1; return; }
        int dev = 0, cus = 0, per_cu = 0;
        if (hipGetDevice(&dev) != hipSuccess || hipDeviceGetAttribute(&cus, hipDeviceAttributeMultiprocessorCount, dev) != hipSuccess) { grid = -1; return; }
        if (hipFuncSetAttribute((const void*)mega_fwd, hipFuncAttributeMaxDynamicSharedMemorySize, LDS_BYTES) != hipSuccess) { fprintf(stderr, "kernel_launch: hipFuncSetAttribute failed\n"); grid = -1; return; }
        if (hipOccupancyMaxActiveBlocksPerMultiprocessor(&per_cu, (const void*)mega_fwd, NTHREADS, LDS_BYTES) != hipSuccess || per_cu < 1) { fprintf(stderr, "kernel_launch: occupancy query says %d blocks/CU\n", per_cu); grid = -1; return; }
        grid = cus;
        if (grid != 256) fprintf(stderr, "kernel_launch: note: %d CUs (built for 256)\n", grid);
    }
    if (grid < 0) return;
    Args a{};
    for (int i = 0; i < 23; ++i) a.in[i] = (const float*)d_in[i];
    a.out = (float*)d_out; a.ws = (unsigned char*)d_ws;
    void* args[] = {&a};
    const hipError_t e = hipLaunchCooperativeKernel((const void*)mega_fwd, dim3(grid), dim3(NTHREADS), args, LDS_BYTES, stream);
    if (e != hipSuccess) fprintf(stderr, "kernel_launch: cooperative launch failed: %s (grid %d)\n", hipGetErrorString(e), grid);
}
```

```cpp
#include <hip/hip_runtime.h>
#include <hip/hip_cooperative_groups.h>
#include <cstdio>
#include <cstdint>
namespace cg = cooperative_groups;
namespace pg8 {
#define PG8_LAS __attribute__((address_space(3)))
typedef unsigned short bf16_t;
typedef short bf16x8 __attribute__((ext_vector_type(8)));
typedef float f32x4 __attribute__((ext_vector_type(4)));
typedef unsigned u32x4 __attribute__((ext_vector_type(4)));
typedef unsigned u32x2 __attribute__((ext_vector_type(2)));
constexpr int BM = 256, BK = 64, HALF = 128, HTB = HALF * BK * 2  , STAGE_BYTES = 8 * HTB, NXCD = 8, WGM = 8;

__host__ __device__ __forceinline__ int lds_byte(int r, int c) { const int st = (r >> 4) * 2 + (c >> 5), rr = r & 15, cc = c & 31, ob = rr * 64 + cc * 2; return st * 1024 + (ob ^ (((ob >> 9) & 1) << 5)); }
__host__ __device__ __forceinline__ void stage_rc(int b, int& R, int& C) { const int st = b / 1024, sb = b % 1024, swz = sb ^ (((sb >> 9) & 1) << 5); R = (st >> 1) * 16 + swz / 64; C = (st & 1) * 32 + (swz % 64) / 2; }
__host__ __device__ __forceinline__ int perm32(int rho) { const int n = rho >> 4, i = rho & 15; return 8 * (i >> 2) + 4 * n + (i & 3); }

struct Unit { int pm, pn, ui; };
struct Gemm { const bf16_t* A; const bf16_t* Bt; int M, N, K; };

struct StaticOrder {
    int nM, nN, nwg, G, c;
    __host__ __device__ void init(int M, int N, int G_, int c_) { nM = M / BM; nN = N / BM; nwg = nM * nN; G = G_; c = c_; }
    __host__ __device__ bool next(int i, Unit& u) const {
        const long L = (long)i * G + c; if (L >= nwg) return false;
        int wgid = (int)L; { const int q = nwg / NXCD, r = nwg % NXCD, xcd = wgid % NXCD, off = wgid / NXCD; wgid = (xcd < r ? xcd * (q + 1) : r * (q + 1) + (xcd - r) * q) + off; }
        const int nig = WGM * nN, gid = wgid / nig, fm = gid * WGM, gsz = (nM - fm) < WGM ? (nM - fm) : WGM;
        u.pm = fm + ((wgid % nig) % gsz); u.pn = (wgid % nig) / gsz; u.ui = i; return true;
    }
    __device__ __forceinline__ void a_ready(const Unit&) const {}
    __device__ __forceinline__ void done(const Unit&) const {}
};

typedef float f32x2 __attribute__((ext_vector_type(2)));
typedef __bf16 bf16x2_t __attribute__((ext_vector_type(2)));
__device__ __forceinline__ unsigned cvt_pk_bf16(float lo, float hi) { f32x2 v = {lo, hi}; bf16x2_t b = __builtin_convertvector(v, bf16x2_t); return __builtin_bit_cast(unsigned, b); }

template <int ACT> struct EpiRowScale {
    static constexpr bool PERM = true, AFTER_DRAIN = false;
    bf16_t* O; int ldc; const PG8_LAS float* rs;
    __device__ __forceinline__ void operator()(const f32x4 (&acc)[2][2][4][2], const Unit& u, int wr, int wc, int fr, int fq) const {
        const int rl0 = wr * 64 + fr, col0 = u.pn * BM + wc * 32 + 8 * fq;
#pragma unroll
        for (int ai = 0; ai < 2; ++ai)
#pragma unroll
            for (int m = 0; m < 4; ++m) { const int rl = rl0 + ai * HALF + m * 16; const float s = rs[u.ui * 256 + rl];
                bf16_t* rowp = O + (size_t)(u.pm * BM + rl) * ldc + col0;
#pragma unroll
                for (int bj = 0; bj < 2; ++bj) { f32x4 v0 = acc[ai][bj][m][0] * s, v1 = acc[ai][bj][m][1] * s;
                    if (ACT == 1) {
#pragma unroll
                        for (int e = 0; e < 4; ++e) { float a = fmaxf(v0[e], 0.f), b = fmaxf(v1[e], 0.f); v0[e] = a * a; v1[e] = b * b; } }
                    u32x4 w; w.x = cvt_pk_bf16(v0[0], v0[1]); w.y = cvt_pk_bf16(v0[2], v0[3]); w.z = cvt_pk_bf16(v1[0], v1[1]); w.w = cvt_pk_bf16(v1[2], v1[3]);
                    *(u32x4*)(rowp + bj * HALF) = w; } }
    }
};
struct EpiResidual {
    static constexpr bool PERM = false, AFTER_DRAIN = false;
    const float* base; float* out; bf16_t* hb; float* ss;
    __device__ __forceinline__ void operator()(const f32x4 (&acc)[2][2][4][2], const Unit& u, int wr, int wc, int fr, int fq) const {
        const int col0 = u.pn * BM + wc * 32 + 4 * fq;
#pragma unroll
        for (int ai = 0; ai < 2; ++ai)
#pragma unroll
            for (int m = 0; m < 4; ++m) { const int row = u.pm * BM + wr * 64 + fr + ai * HALF + m * 16; const size_t off = (size_t)row * 1024 + col0; float q = 0.f;
#pragma unroll
                for (int bj = 0; bj < 2; ++bj)
#pragma unroll
                    for (int n = 0; n < 2; ++n) { const size_t o2 = off + bj * HALF + n * 16; const f32x4 b = *(const f32x4*)(base + o2); const f32x4 o = b + acc[ai][bj][m][n];
                        *(f32x4*)(out + o2) = o; q += (o[0] * o[0] + o[1] * o[1]) + (o[2] * o[2] + o[3] * o[3]);
                        u32x2 w; w.x = cvt_pk_bf16(o[0], o[1]); w.y = cvt_pk_bf16(o[2], o[3]); *(u32x2*)(hb + o2) = w; }
                q += __shfl_xor(q, 16); q += __shfl_xor(q, 32);
                if (fq == 0) ss[(size_t)row * 16 + u.pn * 4 + wc] = q; }
    }
};

template <class Epi, class Sched, bool ALIGN_EPI = false, bool SP2 = false>
__device__ __forceinline__ void gemm_phase(PG8_LAS unsigned char* lds, const Gemm g, const Sched& S, const Epi& E) {
    const int tid = threadIdx.x, wid = __builtin_amdgcn_readfirstlane(tid >> 6), lane = tid & 63, wr = wid >> 2, wc = wid & 3, fr = lane & 15, fq = lane >> 4;
    const int K = g.K, nt = K / BK;
    unsigned voffA[2], voffB[2];
#pragma unroll
    for (int i = 0; i < 2; ++i) { int R, C; stage_rc(tid * 16 + i * 8192, R, C); const int Rb = Epi::PERM ? ((R & ~31) + perm32(R & 31)) : R;
        voffA[i] = (unsigned)(R * K + C) * 2u; voffB[i] = (unsigned)(Rb * K + C) * 2u; }
    const size_t kstep = (size_t)(BK * 2);
    const size_t hstep = (size_t)HALF * K * 2;
    const size_t tstep = 2 * hstep;
    const unsigned ldsw = (unsigned)wid * 1024u;
    const int aoff = lds_byte(wr * 64 + fr, fq * 8), boff = lds_byte(wc * 32 + fr, fq * 8);
#define PG8_SA(b, h) (((b) * 2 + (h)) * HTB)
#define PG8_SB(b, h) ((4 + (b) * 2 + (h)) * HTB)
#define PG8_STAGE(bufoff, gbase, voff) do { _Pragma("unroll") for (int _i = 0; _i < 2; ++_i) \
        __builtin_amdgcn_global_load_lds((const unsigned*)((const char*)(gbase) + (voff)[_i]), (PG8_LAS unsigned*)(lds + (bufoff) + ldsw + _i * 8192), 16, 0, 0); } while (0)
#define PG8_LDA(dst, b, h) do { _Pragma("unroll") for (int m = 0; m < 4; ++m) _Pragma("unroll") for (int k = 0; k < 2; ++k) dst[m][k] = *(const PG8_LAS bf16x8*)(lds + PG8_SA(b, h) + aoff + m * 2048 + k * 1024); } while (0)
#define PG8_LDB(dst, b, h) do { _Pragma("unroll") for (int n = 0; n < 2; ++n) _Pragma("unroll") for (int k = 0; k < 2; ++k) dst[n][k] = *(const PG8_LAS bf16x8*)(lds + PG8_SB(b, h) + boff + n * 2048 + k * 1024); } while (0)
#define PG8_MMA(ai, bj, At, Bt) do { __builtin_amdgcn_s_setprio(1); _Pragma("unroll") for (int m = 0; m < 4; ++m) _Pragma("unroll") for (int n = 0; n < 2; ++n) _Pragma("unroll") for (int k = 0; k < 2; ++k) \
        acc[ai][bj][m][n] = __builtin_amdgcn_mfma_f32_16x16x32_bf16(Bt[n][k], At[m][k], acc[ai][bj][m][n], 0, 0, 0); __builtin_amdgcn_s_setprio(0); } while (0)
#define PG8_WAIT_V(n) asm volatile("s_waitcnt vmcnt(" #n ")" ::: "memory")
#define PG8_WAIT_L(n) asm volatile("s_waitcnt lgkmcnt(" #n ")" ::: "memory")
#define PG8_BAR __builtin_amdgcn_s_barrier()
#define PG8_SCHED __builtin_amdgcn_sched_barrier(0)
    Unit cur, nxt; int ui = 0;
    if (!S.next(0, cur)) return;
    f32x4 acc[2][2][4][2];
#pragma unroll
    for (int a = 0; a < 2; ++a)
#pragma unroll
        for (int b = 0; b < 2; ++b)
#pragma unroll
            for (int m = 0; m < 4; ++m)
#pragma unroll
                for (int n = 0; n < 2; ++n) acc[a][b][m][n] = (f32x4){0.f, 0.f, 0.f, 0.f};
    bf16x8 At[4][2], B0[2][2], B1[2][2];
    const char* cA = (const char*)g.A + (size_t)cur.pm * tstep; const char* cB = (const char*)g.Bt + (size_t)cur.pn * tstep;
    S.a_ready(cur);
    if constexpr (SP2) {
        PG8_STAGE(PG8_SB(0, 0), cB, voffB); PG8_STAGE(PG8_SB(0, 1), cB + hstep, voffB); PG8_STAGE(PG8_SA(0, 0), cA, voffA); PG8_STAGE(PG8_SA(0, 1), cA + hstep, voffA);
        if (wr == 1) PG8_BAR;
        PG8_WAIT_V(2); PG8_BAR;
        PG8_STAGE(PG8_SB(1, 0), cB + kstep, voffB); PG8_STAGE(PG8_SA(1, 0), cA + kstep, voffA); PG8_STAGE(PG8_SB(1, 1), cB + hstep + kstep, voffB);
        PG8_WAIT_V(6); PG8_BAR;
    } else {
        PG8_STAGE(PG8_SB(0, 0), cB, voffB); PG8_STAGE(PG8_SA(0, 0), cA, voffA); PG8_STAGE(PG8_SB(0, 1), cB + hstep, voffB); PG8_STAGE(PG8_SA(0, 1), cA + hstep, voffA);
        if (wr == 1) PG8_BAR;
        PG8_WAIT_V(4); PG8_BAR;
        PG8_STAGE(PG8_SB(1, 0), cB + kstep, voffB); PG8_STAGE(PG8_SA(1, 0), cA + kstep, voffA); PG8_STAGE(PG8_SB(1, 1), cB + hstep + kstep, voffB);
        PG8_WAIT_V(6); PG8_BAR;
    }
    for (;;) {
        const bool has_next = S.next(ui + 1, nxt);
        const char* nA = has_next ? (const char*)g.A + (size_t)nxt.pm * tstep : cA; const char* nB = has_next ? (const char*)g.Bt + (size_t)nxt.pn * tstep : cB;
        for (int t = 0; t < nt; t += 2) {
            const bool last = (t == nt - 2);
            const char* a1 = cA + (size_t)(t + 1) * kstep;
            const char* a2 = last ? nA : cA + (size_t)(t + 2) * kstep; const char* b2 = last ? nB : cB + (size_t)(t + 2) * kstep;
            const char* a3 = a2 + kstep; const char* b3 = b2 + kstep;
            if (last && has_next) S.a_ready(nxt);
            if constexpr (SP2) {
            PG8_LDB(B0, 0, 0); PG8_LDB(B1, 0, 1); PG8_SCHED; PG8_LDA(At, 0, 0); PG8_STAGE(PG8_SA(1, 1), a1 + hstep, voffA);
            PG8_WAIT_V(8); PG8_WAIT_L(0); PG8_BAR; PG8_MMA(0, 0, At, B0); PG8_MMA(0, 1, At, B1); PG8_BAR; PG8_SCHED;
            PG8_LDA(At, 0, 1); PG8_STAGE(PG8_SB(0, 0), b2, voffB); PG8_STAGE(PG8_SB(0, 1), b2 + hstep, voffB); PG8_STAGE(PG8_SA(0, 0), a2, voffA);
            PG8_WAIT_V(8); PG8_WAIT_L(0); PG8_BAR; PG8_MMA(1, 0, At, B0); PG8_MMA(1, 1, At, B1); PG8_BAR; PG8_SCHED;
            PG8_LDB(B0, 1, 0); PG8_LDB(B1, 1, 1); PG8_SCHED; PG8_LDA(At, 1, 0); PG8_STAGE(PG8_SA(0, 1), a2 + hstep, voffA);
            PG8_WAIT_V(8); PG8_WAIT_L(0); PG8_BAR; PG8_MMA(0, 0, At, B0); PG8_MMA(0, 1, At, B1); PG8_BAR; PG8_SCHED;
            PG8_LDA(At, 1, 1); PG8_STAGE(PG8_SB(1, 0), b3, voffB); PG8_STAGE(PG8_SB(1, 1), b3 + hstep, voffB); PG8_STAGE(PG8_SA(1, 0), a3, voffA);
            PG8_WAIT_V(8); PG8_WAIT_L(0); PG8_BAR; PG8_MMA(1, 0, At, B0); PG8_MMA(1, 1, At, B1); PG8_BAR; PG8_SCHED;
            } else {
            PG8_LDB(B0, 0, 0); PG8_SCHED; PG8_LDA(At, 0, 0); PG8_STAGE(PG8_SA(1, 1), a1 + hstep, voffA);
            PG8_WAIT_L(8); PG8_BAR; PG8_WAIT_L(0); PG8_MMA(0, 0, At, B0); PG8_BAR; PG8_SCHED;
            PG8_LDB(B1, 0, 1); PG8_STAGE(PG8_SB(0, 0), b2, voffB);
            PG8_BAR; PG8_WAIT_L(0); PG8_MMA(0, 1, At, B1); PG8_BAR;
            PG8_LDA(At, 0, 1); PG8_STAGE(PG8_SA(0, 0), a2, voffA);
            PG8_BAR; PG8_WAIT_L(0); PG8_MMA(1, 0, At, B0); PG8_BAR; PG8_SCHED;
            PG8_STAGE(PG8_SB(0, 1), b2 + hstep, voffB);
            PG8_WAIT_V(6); PG8_BAR; PG8_MMA(1, 1, At, B1); PG8_BAR;
            PG8_LDB(B0, 1, 0); PG8_SCHED; PG8_LDA(At, 1, 0); PG8_STAGE(PG8_SA(0, 1), a2 + hstep, voffA);
            PG8_WAIT_L(8); PG8_BAR; PG8_WAIT_L(0); PG8_MMA(0, 0, At, B0); PG8_BAR; PG8_SCHED;
            PG8_LDB(B1, 1, 1); PG8_STAGE(PG8_SB(1, 0), b3, voffB);
            PG8_BAR; PG8_WAIT_L(0); PG8_MMA(0, 1, At, B1); PG8_BAR;
            PG8_LDA(At, 1, 1); PG8_STAGE(PG8_SA(1, 0), a3, voffA);
            PG8_BAR; PG8_WAIT_L(0); PG8_MMA(1, 0, At, B0); PG8_BAR; PG8_SCHED;
            PG8_STAGE(PG8_SB(1, 1), b3 + hstep, voffB);
            PG8_WAIT_V(6); PG8_BAR; PG8_MMA(1, 1, At, B1); PG8_BAR;
            }
        }
        if constexpr (ALIGN_EPI) { if (wr == 0) PG8_BAR; }
        if constexpr (!Epi::AFTER_DRAIN) { E(acc, cur, wr, wc, fr, fq); S.done(cur); }
        if (!has_next) break;
#pragma unroll
        for (int a = 0; a < 2; ++a)
#pragma unroll
            for (int b = 0; b < 2; ++b)
#pragma unroll
                for (int m = 0; m < 4; ++m)
#pragma unroll
                    for (int n = 0; n < 2; ++n) acc[a][b][m][n] = (f32x4){0.f, 0.f, 0.f, 0.f};
        cur = nxt; cA = nA; cB = nB; ++ui;
        if constexpr (ALIGN_EPI) { if (wr == 1) PG8_BAR; }
    }
    PG8_WAIT_V(0);
    if constexpr (!ALIGN_EPI) { if (wr == 0) PG8_BAR; }
    PG8_BAR;
#undef PG8_SA
#undef PG8_SB
#undef PG8_STAGE
#undef PG8_LDA
#undef PG8_LDB
#undef PG8_MMA
#undef PG8_WAIT_V
#undef PG8_WAIT_L
#undef PG8_BAR
#undef PG8_SCHED
}
}
#define LAS __attribute__((address_space(3)))
using pg8::bf16_t; using pg8::bf16x8; using pg8::f32x4; using pg8::u32x4; using pg8::u32x2; using pg8::cvt_pk_bf16;
typedef float f32x16 __attribute__((ext_vector_type(16)));
typedef short s16x4 __attribute__((ext_vector_type(4)));

constexpr int NB = 4, SEQ = 8192, MTOK = NB * SEQ, DMODEL = 1024, DIN = 1836, NU = 2048, DFF = 4096, NLAYER = 2;
constexpr float EPS = 1e-6f, LOG2E = 1.4426950408889634f;
constexpr float NSA_QSCALE = 0.125f * LOG2E;
constexpr float MLA_QSCALE = 0.10206207261596575f * LOG2E;
constexpr int UC_A = 0, UC_G = 256, UC_Q = 512, UC_KV = 768, UC_CQ = 1152, UC_CKV = 1408, UC_POOL = 1536, UC_KR = 1792, UC_GATE = 1824;
constexpr int CC_CONV = 0, CC_NSA = 256, CC_MLA = 512, CC_POOL = 768;

constexpr size_t MiB = 1u << 20;
constexpr size_t WS_W = 1 * MiB, W_LAYER = 24 * MiB;
constexpr size_t WO_WIN = 0, WO_WOUT = 4 * MiB, WO_W1 = 6 * MiB, WO_W2 = 14 * MiB, WO_SMALL = 22 * MiB;
constexpr size_t WO_PW = WO_SMALL, WO_UQ = WO_SMALL + 131072, WO_UKV = WO_SMALL + 327680, WO_C1 = WO_SMALL + 458752, WO_C2 = WO_SMALL + 1507328, WO_POOL = WO_SMALL + 1540096;
constexpr size_t WS_TAB = 4096, WS_ROPE = 50 * MiB, WS_CB1 = 51 * MiB  , WS_SS = 52 * MiB, WS_HB = 56 * MiB, WS_KC = 120 * MiB;
constexpr size_t WS_U = 128 * MiB, WS_CAT = 256 * MiB, WS_QM = 320 * MiB, WS_KM = 344 * MiB, WS_VM = 368 * MiB, WS_Z = 128 * MiB, WS_END = 384 * MiB;

constexpr int LDS_BYTES = 163840;
constexpr int LDS_RS = 131072;

__device__ const unsigned char BUCKET[129] = {0,1,2,3,4,5,6,7,8,9,10,11,12,13,14,15,16,16,16,17,17,18,18,18,19,19,19,20,20,20,20,21,21,21,21,22,22,22,22,22,23,23,23,23,23,23,24,24,24,24,24,24,25,25,25,25,25,25,25,26,26,26,26,26,26,26,26,27,27,27,27,27,27,27,27,27,27,28,28,28,28,28,28,28,28,28,28,29,29,29,29,29,29,29,29,29,29,29,29,30,30,30,30,30,30,30,30,30,30,30,30,30,30,31,31,31,31,31,31,31,31,31,31,31,31,31,31,31,31};

__device__ __forceinline__ float bf2f(unsigned short x) { return __uint_as_float((unsigned)x << 16); }
__device__ __forceinline__ unsigned short f2bf(float f) { return (unsigned short)(cvt_pk_bf16(f, 0.f) & 0xffffu); }
__device__ __forceinline__ float wave_sum(float v) {
#pragma unroll
    for (int o = 1; o < 64; o <<= 1) v += __shfl_xor(v, o);
    return v;
}
__device__ __forceinline__ float sigmoidf_(float x) { return 1.0f / (1.0f + __expf(-x)); }
__device__ __forceinline__ int crow(int r, int hi) { return (r & 3) + 8 * (r >> 2) + 4 * hi; }

struct Args { const float* in[23]; float* out; unsigned char* ws; int pad0, pad1; };

struct Frame {
    LAS unsigned char* lds;
    int tid, lane, wave, G, bid, vcu;
    unsigned char* ws;
};

#define LAUNDER(F) do { unsigned long long _w = (unsigned long long)(F).ws; asm volatile("" : "+s"(_w)); (F).ws = (unsigned char*)_w; \
    unsigned _l = (unsigned)(size_t)(F).lds; asm volatile("" : "+s"(_l)); (F).lds = (LAS unsigned char*)(size_t)_l; \
    asm volatile("" : "+v"((F).tid)); (F).lane = (F).tid & 63; (F).wave = __builtin_amdgcn_readfirstlane((F).tid >> 6); } while (0)

__device__ __forceinline__ const float* IN(const Frame& F, int k) { return ((const float* const*)(F.ws + WS_TAB))[k]; }

template <int K> __device__ __forceinline__ f32x16 small_mm(const LAS unsigned char* A, int lda_b, const bf16_t* BT, int lane) {
    const int r32 = lane & 31, hi = lane >> 5; f32x16 acc = {};
    const LAS unsigned char* ap = A + r32 * lda_b + hi * 16; const bf16_t* bp = BT + (size_t)r32 * K + hi * 8;
    bf16x8 bv[K / 16];
#pragma unroll
    for (int ks = 0; ks < K / 16; ++ks) bv[ks] = *(const bf16x8*)(bp + ks * 16);
#pragma unroll
    for (int ks = 0; ks < K / 16; ++ks) {
        const bf16x8 a = *(const LAS bf16x8*)(ap + ks * 32);
        acc = __builtin_amdgcn_mfma_f32_32x32x16_bf16(a, bv[ks], acc, 0, 0, 0);
    }
    return acc;
}
#define XB_TMO      128
#define XB_XCNT(j)  (256  + 64 * (j))
#define XB_XSUB(j)  (1280 + 64 * (j))
#define XB_XGEN(j)  (2304 + 64 * (j))
#define XB_TOP      3328
#define XB_TOPGEN   3392
#define XCD_BAR_WORDS 3456
#define XB_SPIN_CAP (1u << 18)
constexpr size_t WS_BAR = 65536;
constexpr int LDS_CTL = LDS_BYTES - 512;

__device__ __forceinline__ unsigned xb_ld(unsigned* p)              { return __hip_atomic_load(p, __ATOMIC_RELAXED, __HIP_MEMORY_SCOPE_AGENT); }
__device__ __forceinline__ unsigned xb_add(unsigned* p, unsigned v) { return __hip_atomic_fetch_add(p, v, __ATOMIC_RELAXED, __HIP_MEMORY_SCOPE_AGENT); }
__device__ __forceinline__ unsigned xb_xcc_id() { return (unsigned)__builtin_amdgcn_s_getreg((3 << 11) | 20) & 0xFu; }
#define XB_SPIN(cond, bar) do { unsigned _sp = 0; while (cond) { __builtin_amdgcn_s_sleep(1); \
    if ((++_sp & 255u) == 0u) { if (xb_ld(&(bar)[XB_TMO])) break; if (_sp > XB_SPIN_CAP) { atomicAdd(&(bar)[XB_TMO], 1u); break; } } } } while (0)

struct XcdBarrier { unsigned* bar; unsigned x; volatile LAS unsigned* st; };

__device__ __forceinline__ XcdBarrier xcd_barrier_post(unsigned* bar, volatile LAS unsigned* st) {
    XcdBarrier b; b.bar = bar; b.x = xb_xcc_id(); b.st = st;
    if (threadIdx.x == 0) (void)xb_add(&bar[XB_XCNT(b.x)], 1u);
    return b;
}
__device__ __forceinline__ void xcd_barrier_complete(unsigned* bar, unsigned x, unsigned& nloc, unsigned& nx) {
    const unsigned G = gridDim.x * gridDim.y * gridDim.z;
    unsigned sum, cnt, mine, sp = 0u;
    for (;;) {
        sum = 0u; cnt = 0u; mine = 0u;
#pragma unroll
        for (unsigned j = 0; j < 16; ++j) { const unsigned c = xb_ld(&bar[XB_XCNT(j)]); sum += c; cnt += (c > 0u) ? 1u : 0u; mine = (j == x) ? c : mine; }
        if (sum == G) break;
        __builtin_amdgcn_s_sleep(1);
        if ((++sp & 255u) == 0u) { if (xb_ld(&bar[XB_TMO])) break; if (sp > XB_SPIN_CAP) { atomicAdd(&bar[XB_TMO], 1u); break; } }
    }
    nloc = mine > 0u ? mine : 1u; nx = cnt > 0u ? cnt : 1u;
}
__device__ __forceinline__ void xcd_barrier(const XcdBarrier& b) {
    asm volatile("s_waitcnt vmcnt(0)" ::: "memory");
    __syncthreads();
    if (threadIdx.x == 0) {
        unsigned* bar = b.bar;
        __builtin_amdgcn_s_waitcnt(0);
        unsigned nloc = b.st[0], nx = b.st[1];
        if (nloc == 0u) { xcd_barrier_complete(bar, b.x, nloc, nx); b.st[0] = nloc; b.st[1] = nx; }
        const unsigned old = xb_add(&bar[XB_XSUB(b.x)], 1u);
        const unsigned gen = old / nloc;
        if (old + 1u == (gen + 1u) * nloc) {
            __builtin_amdgcn_fence(__ATOMIC_RELEASE, "agent");
            asm volatile("s_waitcnt vmcnt(0)" ::: "memory");
            const unsigned og = xb_add(&bar[XB_TOP], 1u);
            const unsigned tg = og / nx;
            if (og + 1u == (tg + 1u) * nx) xb_add(&bar[XB_TOPGEN], 1u);
            else XB_SPIN(xb_ld(&bar[XB_TOPGEN]) == tg, bar);
            __builtin_amdgcn_fence(__ATOMIC_ACQUIRE, "agent");
            xb_add(&bar[XB_XGEN(b.x)], 1u);
            asm volatile("s_waitcnt vmcnt(0)" ::: "memory");
        } else {
            XB_SPIN(xb_ld(&bar[XB_XGEN(b.x)]) == gen, bar);
            __builtin_amdgcn_fence(__ATOMIC_ACQUIRE, "agent");
            asm volatile("s_waitcnt vmcnt(0)" ::: "memory");
        }
    }
    __syncthreads();
}
__device__ __forceinline__ int win_src(int n) {
    if (n < 1152) return n;
    if (n < 1408) return n - 1152 + 1164;
    if (n < 1536) return n - 1408 + 1420;
    if (n < 1792) return n - 1536 + 1580;
    if (n < 1824) return n - 1792 + 1548;
    if (n < 1836) return n - 1824 + 1152;
    return -1;
}
template <int MODE> __device__ __forceinline__ void transpose_item(const float* W, int K, int ldn, bf16_t* WT, const float* ks, float cs0, LAS float* scr, int item, int nblk, int lane) {
    const int kb = item / nblk, nb = item % nblk, k0 = 64 * kb, n0 = 32 * nb;
    const int nn = n0 + (lane & 31);
    int sc = nn; float cs = cs0;
    if (MODE == 1) { sc = win_src(nn); cs = (nn >= UC_Q && nn < UC_KV) ? NSA_QSCALE : 1.0f; }
#pragma unroll 8
    for (int i = 0; i < 32; ++i) { const int kk = 2 * i + (lane >> 5); float v = 0.f;
        if (sc >= 0) v = W[(size_t)(k0 + kk) * ldn + sc];
        if (ks) v *= ks[k0 + kk];
        scr[kk * 33 + (lane & 31)] = v * cs; }
    asm volatile("s_waitcnt lgkmcnt(0)" ::: "memory");
    const int c = lane & 7;
#pragma unroll
    for (int j = 0; j < 4; ++j) { const int n = (lane >> 3) + 8 * j; const LAS float* s = scr + (8 * c) * 33 + n;
        u32x4 o; o.x = cvt_pk_bf16(s[0 * 33], s[1 * 33]); o.y = cvt_pk_bf16(s[2 * 33], s[3 * 33]); o.z = cvt_pk_bf16(s[4 * 33], s[5 * 33]); o.w = cvt_pk_bf16(s[6 * 33], s[7 * 33]);
        *(u32x4*)(WT + (size_t)(n0 + n) * K + k0 + 8 * c) = o; }
    asm volatile("s_waitcnt lgkmcnt(0)" ::: "memory");
}

__device__ __forceinline__ void prologue(const Args& a, Frame F) {
    LAUNDER(F);
    if (F.bid == 0 && F.tid == 0) { const float** tab = (const float**)(F.ws + WS_TAB);
#pragma unroll
        for (int k = 0; k < 23; ++k) tab[k] = a.in[k];
        tab[23] = a.out; }
    LAS float* scr = (LAS float*)(F.lds + F.wave * 16384);
    const int gw = F.bid * 8 + F.wave, NGW = F.G * 8;
    constexpr int I_WIN = 16 * 64, I_WOUT = 16 * 32, I_W1 = 16 * 128, I_W2 = 64 * 32, I_PW = 4 * 8, I_UQ = 4 * 12, I_UKV = 2 * 16, I_C1 = 32 * 4, I_C2 = 2 * 2, I_PL = 1 * 2;
    constexpr int I_LAYER = I_WIN + I_WOUT + I_W1 + I_W2 + I_PW + I_UQ + I_UKV + 2 * I_C1 + 2 * I_C2 + 4 * I_PL;
    for (int it = gw; it < NLAYER * I_LAYER; it += NGW) {
        const int l = it / I_LAYER; int r = it % I_LAYER;
        unsigned char* wl = F.ws + WS_W + (size_t)l * W_LAYER;
        if (r < I_WIN) { transpose_item<1>(a.in[1] + (size_t)l * DMODEL * DIN, DMODEL, DIN, (bf16_t*)(wl + WO_WIN), a.in[3] + l * DMODEL, 1.f, scr, r, 64, F.lane); continue; } r -= I_WIN;
        if (r < I_WOUT) { transpose_item<0>(a.in[2] + (size_t)l * DMODEL * DMODEL, DMODEL, DMODEL, (bf16_t*)(wl + WO_WOUT), nullptr, 1.f, scr, r, 32, F.lane); continue; } r -= I_WOUT;
        if (r < I_W1) { transpose_item<0>(a.in[19] + (size_t)l * DMODEL * DFF, DMODEL, DFF, (bf16_t*)(wl + WO_W1), a.in[4] + l * DMODEL, 1.f, scr, r, 128, F.lane); continue; } r -= I_W1;
        if (r < I_W2) { transpose_item<0>(a.in[20] + (size_t)l * DFF * DMODEL, DFF, DMODEL, (bf16_t*)(wl + WO_W2), nullptr, 1.f, scr, r, 32, F.lane); continue; } r -= I_W2;
        if (r < I_PW) { transpose_item<0>(a.in[9] + (size_t)l * 256 * 256, 256, 256, (bf16_t*)(wl + WO_PW), nullptr, 1.f, scr, r, 8, F.lane); continue; } r -= I_PW;
        if (r < I_UQ) { transpose_item<0>(a.in[14] + (size_t)l * 256 * 384, 256, 384, (bf16_t*)(wl + WO_UQ), a.in[13] + l * 256, MLA_QSCALE, scr, r, 12, F.lane); continue; } r -= I_UQ;
        if (r < I_UKV) { transpose_item<0>(a.in[16] + (size_t)l * 128 * 512, 128, 512, (bf16_t*)(wl + WO_UKV), a.in[15] + l * 128, 1.f, scr, r, 16, F.lane); continue; } r -= I_UKV;
        if (r < 2 * I_C1) { const int i = r / I_C1; transpose_item<0>(a.in[11] + (size_t)(l * 2 + i) * 2048 * 128, 2048, 128, (bf16_t*)(wl + WO_C1) + (size_t)i * 128 * 2048, nullptr, 1.f, scr, r % I_C1, 4, F.lane); continue; } r -= 2 * I_C1;
        if (r < 2 * I_C2) { const int i = r / I_C2; transpose_item<0>(a.in[12] + (size_t)(l * 2 + i) * 128 * 64, 128, 64, (bf16_t*)(wl + WO_C2) + (size_t)i * 64 * 128, nullptr, 1.f, scr, r % I_C2, 2, F.lane); continue; } r -= 2 * I_C2;
        { const int g = r / I_PL; transpose_item<0>(a.in[17] + (size_t)(l * 4 + g) * 64 * 64, 64, 64, (bf16_t*)(wl + WO_POOL) + (size_t)g * 64 * 64, nullptr, 1.f, scr, r % I_PL, 2, F.lane); }
    }
    {
        const float* x = a.in[0]; bf16_t* hb = (bf16_t*)(F.ws + WS_HB); float* ss = (float*)(F.ws + WS_SS);
        for (int m = gw; m < MTOK; m += NGW) {
            const f32x4* xr = (const f32x4*)(x + (size_t)m * DMODEL) + F.lane; u32x2* hr = (u32x2*)(hb + (size_t)m * DMODEL) + F.lane; float s = 0.f;
#pragma unroll
            for (int j = 0; j < 4; ++j) { const f32x4 v = xr[64 * j]; s += (v[0] * v[0] + v[1] * v[1]) + (v[2] * v[2] + v[3] * v[3]); u32x2 w; w.x = cvt_pk_bf16(v[0], v[1]); w.y = cvt_pk_bf16(v[2], v[3]); hr[64 * j] = w; }
            s = wave_sum(s);
            if (F.lane < 16) ss[(size_t)m * 16 + F.lane] = (F.lane == 0) ? s : 0.f;
        }
    }
    {
        float* rope = (float*)(F.ws + WS_ROPE);
        for (int idx = F.bid * 512 + F.tid; idx < SEQ * 16; idx += F.G * 512) {
            const int pos = idx >> 4, f = idx & 15;
            const float inv_freq = powf(10000.0f, -(float)(2 * f) / 32.0f);
            const float ang = (float)pos * inv_freq;
            const double ad = (double)ang; const double kq = rint(ad * 0.15915494309189535);
            const float rr = (float)(ad - kq * 6.283185307179586);
            rope[pos * 32 + f] = cosf(rr); rope[pos * 32 + 16 + f] = sinf(rr);
        }
    }
    if (F.bid < 64) {
        const int li = F.bid >> 4, kc = F.bid & 15; const float* pos = a.in[10] + (size_t)li * 2048; const float* w1 = a.in[11] + (size_t)li * 2048 * 128;
        const int n = F.tid & 127, kq = F.tid >> 7; float s = 0.f;
#pragma unroll 8
        for (int k = kc * 128 + kq * 32; k < kc * 128 + kq * 32 + 32; ++k) s += pos[k] * w1[(size_t)k * 128 + n];
        LAS float* red = (LAS float*)(F.lds + 8 * 16384);
        red[F.tid] = s; __syncthreads();
        if (F.tid < 128) ((float*)(F.ws + WS_CB1))[(li * 16 + kc) * 128 + F.tid] = (red[F.tid] + red[128 + F.tid]) + (red[256 + F.tid] + red[384 + F.tid]);
        __syncthreads();
    }
    if (F.bid == 4) { bf16_t* kc = (bf16_t*)(F.ws + WS_KC); for (int i = F.tid; i < 8 * 64; i += 512) kc[((size_t)(i >> 6) * 512 + 511) * 64 + (i & 63)] = 0; }
}
constexpr int ASTR = 528;
constexpr int ASTR2 = 272;

__device__ __forceinline__ void conv_tile(Frame& F, int l, int tile) {
    const int T0 = tile * 64, tb = T0 & (SEQ - 1);
    const bf16_t* U = (const bf16_t*)(F.ws + WS_U); bf16_t* CAT = (bf16_t*)(F.ws + WS_CAT);
    LAS bf16_t* glu = (LAS bf16_t*)F.lds;
    LAS float* cv = (LAS float*)(F.lds + 49152);
    LAS unsigned char* At = F.lds;
    for (int p = F.tid; p < 94 * 32; p += 512) {
        const int r = p >> 5, c8 = (p & 31) * 8; u32x4 o = {0u, 0u, 0u, 0u};
        if (tb - 30 + r >= 0) {
            const bf16_t* up = U + (size_t)(T0 - 30 + r) * NU + c8;
            const u32x4 av = *(const u32x4*)(up + UC_A), gv = *(const u32x4*)(up + UC_G);
#pragma unroll
            for (int e = 0; e < 4; ++e) {
                const float a0 = __uint_as_float(av[e] << 16), a1 = __uint_as_float(av[e] & 0xffff0000u), g0 = __uint_as_float(gv[e] << 16), g1 = __uint_as_float(gv[e] & 0xffff0000u);
                o[e] = cvt_pk_bf16(a0 * sigmoidf_(g0), a1 * sigmoidf_(g1)); }
        }
        *(LAS u32x4*)(glu + r * 256 + c8) = o;
    }
    __syncthreads();
    {
        const int c = F.tid & 255, half = F.tid >> 8; float w[31];
        const float* dw = IN(F, 5) + (size_t)l * 31 * 256 + c;
#pragma unroll
        for (int k = 0; k < 31; ++k) w[k] = dw[k * 256];
        const float bias = IN(F, 6)[l * 256 + c];
#pragma unroll 1
        for (int i = 0; i < 32; ++i) {
            const LAS bf16_t* gp = glu + (32 * half + i) * 256 + c; float acc = bias;
#pragma unroll
            for (int k = 0; k < 31; ++k) acc += w[k] * bf2f(gp[k * 256]);
            cv[(32 * half + i) * 256 + c] = acc;
        }
    }
    __syncthreads();
    {
        const f32x4 g4 = *((const f32x4*)(IN(F, 7) + l * 256) + F.lane), b4 = *((const f32x4*)(IN(F, 8) + l * 256) + F.lane);
        for (int tt = 0; tt < 8; ++tt) {
            const int row = 8 * F.wave + tt; const f32x4 x = *((const LAS f32x4*)(cv + row * 256) + F.lane);
            const float mean = wave_sum((x[0] + x[1]) + (x[2] + x[3])) * (1.f / 256.f); const f32x4 d = x - mean;
            const float var = wave_sum((d[0] * d[0] + d[1] * d[1]) + (d[2] * d[2] + d[3] * d[3])) * (1.f / 256.f); const float rstd = 1.0f / sqrtf(var + EPS);
            f32x4 y = d * rstd * g4 + b4;
#pragma unroll
            for (int e = 0; e < 4; ++e) y[e] = y[e] * sigmoidf_(y[e]);
            u32x2 wv; wv.x = cvt_pk_bf16(y[0], y[1]); wv.y = cvt_pk_bf16(y[2], y[3]);
            *(LAS u32x2*)(At + row * ASTR + F.lane * 8) = wv;
        }
    }
    __syncthreads();
    {
        const bf16_t* pwT = (const bf16_t*)(F.ws + WS_W + (size_t)l * W_LAYER + WO_PW); const int r32 = F.lane & 31, hi = F.lane >> 5;
        for (int j = 0; j < 2; ++j) {
            const int task = F.wave + 8 * j, rb = task & 1, cb = task >> 1;
            const f32x16 acc = small_mm<256>(At + rb * 32 * ASTR, ASTR, pwT + (size_t)cb * 32 * 256, F.lane);
#pragma unroll
            for (int r = 0; r < 16; ++r) CAT[(size_t)(T0 + rb * 32 + crow(r, hi)) * DMODEL + CC_CONV + cb * 32 + r32] = f2bf(acc[r]);
        }
    }
    __syncthreads();
}

__device__ __forceinline__ void pool_tile(Frame& F, int l, int tile) {
    const int T0 = tile * 64, tb = T0 & (SEQ - 1);
    const bf16_t* U = (const bf16_t*)(F.ws + WS_U); bf16_t* CAT = (bf16_t*)(F.ws + WS_CAT);
    LAS float* P = (LAS float*)F.lds;
    LAS unsigned char* At = F.lds + 81920;
    for (int p = F.tid; p < 79 * 32; p += 512) {
        const int r = p >> 5, c8 = (p & 31) * 8; f32x4 lo = {0.f, 0.f, 0.f, 0.f}, hi4 = lo;
        if (tb - 15 + r >= 0) { const u32x4 v = *(const u32x4*)(U + (size_t)(T0 - 15 + r) * NU + UC_POOL + c8);
            lo = (f32x4){__uint_as_float(v[0] << 16), __uint_as_float(v[0] & 0xffff0000u), __uint_as_float(v[1] << 16), __uint_as_float(v[1] & 0xffff0000u)};
            hi4 = (f32x4){__uint_as_float(v[2] << 16), __uint_as_float(v[2] & 0xffff0000u), __uint_as_float(v[3] << 16), __uint_as_float(v[3] & 0xffff0000u)}; }
        *(LAS f32x4*)(P + r * 256 + c8) = lo; *(LAS f32x4*)(P + r * 256 + c8 + 4) = hi4;
    }
    __syncthreads();
    {
        const int c = F.tid & 255, half = F.tid >> 8, w = 2 << (c >> 6);
        for (int i = 0; i < 32; ++i) {
            const int row = 32 * half + i, tpos = tb + row; const int cnt = (tpos + 1 < w) ? tpos + 1 : w; float s = 0.f;
            for (int j = 0; j < w; ++j) s += P[(15 + row - j) * 256 + c];
            const float d = s / (float)cnt - P[(15 + row) * 256 + c];
            *(LAS bf16_t*)(At + row * ASTR + c * 2) = f2bf(d);
        }
    }
    __syncthreads();
    {
        const bf16_t* plT = (const bf16_t*)(F.ws + WS_W + (size_t)l * W_LAYER + WO_POOL); const int r32 = F.lane & 31, hi = F.lane >> 5;
        for (int j = 0; j < 2; ++j) {
            const int task = F.wave + 8 * j, rb = task & 1, g = (task >> 1) & 3, cbl = task >> 3;
            const f32x16 acc = small_mm<64>(At + rb * 32 * ASTR + g * 128, ASTR, plT + (size_t)g * 4096 + (size_t)cbl * 32 * 64, F.lane);
            const int col = g * 64 + cbl * 32 + r32; const float sc = IN(F, 18)[l * 256 + col];
#pragma unroll
            for (int r = 0; r < 16; ++r) CAT[(size_t)(T0 + rb * 32 + crow(r, hi)) * DMODEL + CC_POOL + col] = f2bf(acc[r] * sc);
        }
    }
    __syncthreads();
}

__device__ __forceinline__ void mla_tile(Frame& F, int l, int tile) {
    const int T0 = tile * 64, tb = T0 & (SEQ - 1), b = T0 >> 13;
    const bf16_t* U = (const bf16_t*)(F.ws + WS_U); const float* rope = (const float*)(F.ws + WS_ROPE);
    bf16_t* QM = (bf16_t*)(F.ws + WS_QM); bf16_t* KM = (bf16_t*)(F.ws + WS_KM); bf16_t* VM = (bf16_t*)(F.ws + WS_VM);
    LAS unsigned char* Aq = F.lds; LAS unsigned char* Akv = F.lds + 33792;
    for (int tt = 0; tt < 8; ++tt) {
        const int row = 8 * F.wave + tt; const bf16_t* up = U + (size_t)(T0 + row) * NU;
        { const u32x2 v = *((const u32x2*)(up + UC_CQ) + F.lane);
          const float x0 = __uint_as_float(v.x << 16), x1 = __uint_as_float(v.x & 0xffff0000u), x2 = __uint_as_float(v.y << 16), x3 = __uint_as_float(v.y & 0xffff0000u);
          const float rs = 1.0f / sqrtf(wave_sum((x0 * x0 + x1 * x1) + (x2 * x2 + x3 * x3)) * (1.f / 256.f) + EPS);
          u32x2 w; w.x = cvt_pk_bf16(x0 * rs, x1 * rs); w.y = cvt_pk_bf16(x2 * rs, x3 * rs); *(LAS u32x2*)(Aq + row * ASTR + F.lane * 8) = w; }
        { const unsigned v = *((const unsigned*)(up + UC_CKV) + F.lane);
          const float x0 = __uint_as_float(v << 16), x1 = __uint_as_float(v & 0xffff0000u);
          const float rs = 1.0f / sqrtf(wave_sum(x0 * x0 + x1 * x1) * (1.f / 128.f) + EPS);
          *(LAS unsigned*)(Akv + row * ASTR2 + F.lane * 4) = cvt_pk_bf16(x0 * rs, x1 * rs); }
    }
    for (int j = 0; j < 2; ++j) {
        const int idx = F.tid + 512 * j, tok = idx >> 4, i = idx & 15, pos = tb + tok; const bf16_t* up = U + (size_t)(T0 + tok) * NU + UC_KR;
        const float x1 = bf2f(up[i]), x2 = bf2f(up[16 + i]), cs = rope[pos * 32 + i], sn = rope[pos * 32 + 16 + i];
        const unsigned short o1 = f2bf(x1 * cs - x2 * sn), o2 = f2bf(x1 * sn + x2 * cs);
#pragma unroll
        for (int h = 0; h < 4; ++h) { bf16_t* kp = KM + ((size_t)(b * 4 + h) * SEQ + pos) * 96 + 64; kp[i] = o1; kp[16 + i] = o2; }
    }
    __syncthreads();
    const int r32 = F.lane & 31, hi = F.lane >> 5;
    {
        const bf16_t* uqT = (const bf16_t*)(F.ws + WS_W + (size_t)l * W_LAYER + WO_UQ);
        for (int j = 0; j < 3; ++j) {
            const int task = F.wave + 8 * j, rb = task & 1, cb = task >> 1, head = cb / 3, part = cb % 3;
            const f32x16 acc = small_mm<256>(Aq + rb * 32 * ASTR, ASTR, uqT + (size_t)cb * 32 * 256, F.lane);
#pragma unroll
            for (int r = 0; r < 16; ++r) {
                const int pos = tb + rb * 32 + crow(r, hi); bf16_t* qp = QM + ((size_t)(b * 4 + head) * SEQ + pos) * 96;
                if (part < 2) qp[part * 32 + r32] = f2bf(acc[r]);
                else { const float other = __shfl_xor(acc[r], 16); const int i = r32 & 15; const float cs = rope[pos * 32 + i], sn = rope[pos * 32 + 16 + i];
                       const float o = (r32 < 16) ? (acc[r] * cs - other * sn) : (other * sn + acc[r] * cs); qp[64 + r32] = f2bf(o); }
            }
        }
    }
    {
        const bf16_t* ukvT = (const bf16_t*)(F.ws + WS_W + (size_t)l * W_LAYER + WO_UKV);
        for (int j = 0; j < 4; ++j) {
            const int task = F.wave + 8 * j, rb = task & 1, cb = task >> 1, head = cb >> 2, part = cb & 3;
            const f32x16 acc = small_mm<128>(Akv + rb * 32 * ASTR2, ASTR2, ukvT + (size_t)cb * 32 * 128, F.lane);
#pragma unroll
            for (int r = 0; r < 16; ++r) {
                const int pos = tb + rb * 32 + crow(r, hi); const size_t rowi = (size_t)(b * 4 + head) * SEQ + pos;
                if (part < 2) KM[rowi * 96 + part * 32 + r32] = f2bf(acc[r]); else VM[rowi * 64 + (part - 2) * 32 + r32] = f2bf(acc[r]);
            }
        }
    }
    __syncthreads();
}

__device__ __forceinline__ void compress_item(Frame& F, int l, int item) {
    const int i = item >> 6, b = (item >> 4) & 3, gq = item & 15, c0 = 32 * gq, tok0 = 16 * c0;
    const bf16_t* U = (const bf16_t*)(F.ws + WS_U); bf16_t* KC = (bf16_t*)(F.ws + WS_KC);
    LAS unsigned char* Tk = F.lds;
    LAS float* part = (LAS float*)(F.lds + 67584);
    LAS unsigned char* A2 = F.lds + 83968;
    for (int p = F.tid; p < 528 * 8; p += 512) {
        const int r = p >> 3, ch = p & 7; u32x4 v = {0u, 0u, 0u, 0u};
        if (tok0 + r < SEQ) v = *(const u32x4*)(U + (size_t)(b * SEQ + tok0 + r) * NU + UC_KV + i * 64 + ch * 8);
        *(LAS u32x4*)(Tk + r * 128 + ((ch ^ ((r >> 4) & 7)) * 16)) = v;
    }
    __syncthreads();
    const int r32 = F.lane & 31, hi = F.lane >> 5, cb = F.wave & 3, kh = F.wave >> 2;
    const unsigned char* wl = F.ws + WS_W + (size_t)l * W_LAYER;
    f32x16 acc = {};
    {
        const bf16_t* bp = (const bf16_t*)(wl + WO_C1) + (size_t)i * 128 * 2048 + (size_t)(cb * 32 + r32) * 2048 + hi * 8;
#pragma unroll 8
        for (int ks = kh * 64; ks < kh * 64 + 64; ++ks) {
            const int ll = ks >> 2, dq = ks & 3, token = 16 * r32 + ll, chunk = dq * 2 + hi;
            const bf16x8 av = *(const LAS bf16x8*)(Tk + token * 128 + ((chunk ^ ((token >> 4) & 7)) * 16));
            const bf16x8 bv = *(const bf16x8*)(bp + ks * 16);
            acc = __builtin_amdgcn_mfma_f32_32x32x16_bf16(av, bv, acc, 0, 0, 0);
        }
    }
    if (kh == 1) {
#pragma unroll
        for (int r = 0; r < 16; ++r) part[cb * 1024 + r * 64 + F.lane] = acc[r];
    }
    __syncthreads();
    if (kh == 0) {
        float bias = 0.f; { const float* cbp = (const float*)(F.ws + WS_CB1) + (size_t)(l * 2 + i) * 16 * 128 + cb * 32 + r32;
#pragma unroll
            for (int kc = 0; kc < 16; ++kc) bias += cbp[kc * 128]; }
#pragma unroll
        for (int r = 0; r < 16; ++r) { float h = acc[r] + part[cb * 1024 + r * 64 + F.lane] + bias; h = h * sigmoidf_(h);
            *(LAS bf16_t*)(A2 + crow(r, hi) * ASTR2 + (cb * 32 + r32) * 2) = f2bf(h); }
    }
    __syncthreads();
    if (F.wave < 2) {
        const f32x16 o = small_mm<128>(A2, ASTR2, (const bf16_t*)(wl + WO_C2) + (size_t)i * 64 * 128 + (size_t)F.wave * 32 * 128, F.lane);
#pragma unroll
        for (int r = 0; r < 16; ++r) { const int row = c0 + crow(r, hi); KC[((size_t)(i * 4 + b) * 512 + row) * 64 + F.wave * 32 + r32] = (row < 511) ? f2bf(o[r]) : (bf16_t)0; }
    }
    __syncthreads();
}

__device__ __forceinline__ void phaseB(Frame F, int l) {
    LAUNDER(F);
#ifndef SKIP_B1
    for (int t = F.bid; t < MTOK / 64; t += F.G) conv_tile(F, l, t);
#endif
#ifndef SKIP_B2
    for (int t = F.bid; t < MTOK / 64; t += F.G) pool_tile(F, l, t);
#endif
#ifndef SKIP_B3
    for (int t = F.bid; t < MTOK / 64; t += F.G) mla_tile(F, l, t);
#endif
#ifndef SKIP_B4
    for (int t = F.G - 1 - F.bid; t < 128; t += F.G) compress_item(F, l, t);
#endif
}
namespace att {
constexpr int KSLOT = 12288, VSLOT = 8192;
constexpr int L_K = 0, L_V = 2 * KSLOT, L_WS = L_V + 2 * VSLOT, L_BT = L_WS + 2048, L_IMP = L_BT + 2304, L_SEL = L_IMP + 32768, L_GATE = L_SEL + 1024, L_OACC = L_GATE + 3072, L_END = L_OACC + 65536;
static_assert(L_END <= LDS_BYTES, "attention LDS");
constexpr float NEG_INF = -__builtin_inff();

struct TileSrc { const bf16_t* K; int kpitch; const bf16_t* V; int vpitch; };
struct Stage { u32x4 k0, k1, v; };

template <int DQK> __device__ __forceinline__ void stage_load(Stage& s, const TileSrc& T, int kv0, int wid, int lane) {
    const bf16_t* kp = T.K + (size_t)(kv0 + lane) * T.kpitch;
    s.k0 = *(const u32x4*)(kp + wid * 8);
    if (DQK == 96) { if (wid < 4) s.k1 = *(const u32x4*)(kp + (wid + 8) * 8); }
    s.v = *(const u32x4*)(T.V + (size_t)(kv0 + 16 * (wid & 3) + (lane >> 2)) * T.vpitch + (wid >> 2) * 32 + (lane & 3) * 8);
}
template <int DQK> __device__ __forceinline__ void stage_write(const Stage& s, LAS unsigned char* lds, int slot, int wid, int lane) {
    *(LAS u32x4*)(lds + L_K + slot * KSLOT + wid * 1024 + lane * 16) = s.k0;
    if (DQK == 96) { if (wid < 4) *(LAS u32x4*)(lds + L_K + slot * KSLOT + (wid + 8) * 1024 + lane * 16) = s.k1; }
    *(LAS u32x4*)(lds + L_V + slot * VSLOT + wid * 1024 + lane * 16) = s.v;
}
template <int DQK> __device__ __forceinline__ void qk(f32x16& p0, f32x16& p1, const LAS unsigned char* kslot, const bf16x8* qf, float cinit, int r32, int hi) {
#pragma unroll
    for (int r = 0; r < 16; ++r) { p0[r] = cinit; p1[r] = cinit; }
    const LAS unsigned char* kb = kslot + hi * 1024 + r32 * 16;
#pragma unroll
    for (int d0 = 0; d0 < DQK / 16; ++d0) {
        const bf16x8 b0 = *(const LAS bf16x8*)(kb + d0 * 2048), b1 = *(const LAS bf16x8*)(kb + d0 * 2048 + 512);
        p0 = __builtin_amdgcn_mfma_f32_32x32x16_bf16(b0, qf[d0], p0, 0, 0, 0);
        p1 = __builtin_amdgcn_mfma_f32_32x32x16_bf16(b1, qf[d0], p1, 0, 0, 0);
    }
}
__device__ __forceinline__ float half_swap_max(float v) { auto rr = __builtin_amdgcn_permlane32_swap(__float_as_uint(v), __float_as_uint(v), false, false); return fmaxf(__uint_as_float(rr[0]), __uint_as_float(rr[1])); }
__device__ __forceinline__ float half_swap_sum(float v) { auto rr = __builtin_amdgcn_permlane32_swap(__float_as_uint(v), __float_as_uint(v), false, false); return __uint_as_float(rr[0]) + __uint_as_float(rr[1]); }
__device__ __forceinline__ float rowmax(const f32x16& p0, const f32x16& p1) {
    float a = fmaxf(p0[0], p1[0]);
#pragma unroll
    for (int r = 1; r < 16; ++r) a = fmaxf(a, fmaxf(p0[r], p1[r]));
    return half_swap_max(a);
}
__device__ __forceinline__ s16x4 vtr(const LAS unsigned char* p) { return __builtin_bit_cast(s16x4, __builtin_amdgcn_ds_read_tr16_b64_v4i16((LAS s16x4*)p)); }
__device__ __forceinline__ void pv(f32x16 (&o)[2], const f32x16& p0, const f32x16& p1, const LAS unsigned char* vslot, int lane) {
    u32x4 pw[4];
#pragma unroll
    for (int e = 0; e < 4; ++e) { pw[0][e] = cvt_pk_bf16(p0[2 * e], p0[2 * e + 1]); pw[1][e] = cvt_pk_bf16(p0[8 + 2 * e], p0[9 + 2 * e]);
                                  pw[2][e] = cvt_pk_bf16(p1[2 * e], p1[2 * e + 1]); pw[3][e] = cvt_pk_bf16(p1[8 + 2 * e], p1[9 + 2 * e]); }
    const int hi = lane >> 5;
    const LAS unsigned char* vb = vslot + ((lane >> 4) & 1) * 32 + (lane & 3) * 8 + (4 * hi + ((lane & 15) >> 2)) * 64;
#pragma unroll
    for (int d0 = 0; d0 < 2; ++d0)
#pragma unroll
        for (int ks = 0; ks < 4; ++ks) {
            const s16x4 lo = vtr(vb + d0 * 4096 + ks * 1024), hh = vtr(vb + d0 * 4096 + ks * 1024 + 512);
            const bf16x8 vf = (bf16x8){lo[0], lo[1], lo[2], lo[3], hh[0], hh[1], hh[2], hh[3]};
            o[d0] = __builtin_amdgcn_mfma_f32_32x32x16_bf16(__builtin_bit_cast(bf16x8, pw[ks]), vf, o[d0], 0, 0, 0);
        }
}
__device__ __forceinline__ void softmax_pv(f32x16& p0, f32x16& p1, float& m, float& l, f32x16 (&o)[2], const LAS unsigned char* vslot, LAS float* wsf, int lane) {
    const int r32 = lane & 31, hi = lane >> 5;
    const float rm = rowmax(p0, p1), mn = fmaxf(m, rm), ms = (mn == NEG_INF) ? 0.f : mn;
    const float alpha = __builtin_amdgcn_exp2f(m - ms);
    const bool need = __any(mn > m) != 0;
    m = mn;
    float sum = 0.f;
#pragma unroll
    for (int r = 0; r < 16; ++r) { p0[r] = __builtin_amdgcn_exp2f(p0[r] - ms); p1[r] = __builtin_amdgcn_exp2f(p1[r] - ms); sum += p0[r] + p1[r]; }
    l = l * alpha + sum;
    if (need) {
        if (hi == 0) wsf[r32] = alpha;
        __builtin_amdgcn_fence(__ATOMIC_RELEASE, "wavefront"); __builtin_amdgcn_wave_barrier();
#pragma unroll
        for (int r = 0; r < 16; ++r) { const float f = wsf[crow(r, hi)]; o[0][r] *= f; o[1][r] *= f; }
    }
    pv(o, p0, p1, vslot, lane);
}
__device__ __forceinline__ void scaled_add(LAS float* oacc, const f32x16 (&o)[2], float f, LAS float* wsf, int lane, bool assign) {
    const int r32 = lane & 31, hi = lane >> 5;
    if (hi == 0) wsf[32 + r32] = f;
    __builtin_amdgcn_fence(__ATOMIC_RELEASE, "wavefront"); __builtin_amdgcn_wave_barrier();
#pragma unroll
    for (int r = 0; r < 16; ++r) { const float g = wsf[32 + crow(r, hi)];
        if (assign) { oacc[r * 64 + lane] = o[0][r] * g; oacc[(16 + r) * 64 + lane] = o[1][r] * g; } else { oacc[r * 64 + lane] += o[0][r] * g; oacc[(16 + r) * 64 + lane] += o[1][r] * g; } }
}
__device__ __forceinline__ void store_oacc(const LAS float* oacc, bf16_t* dst, int pitch, int lane) {
    const int r32 = lane & 31, hi = lane >> 5;
#pragma unroll
    for (int r = 0; r < 16; ++r) { bf16_t* rp = dst + (size_t)crow(r, hi) * pitch; rp[r32] = f2bf(oacc[r * 64 + lane]); rp[32 + r32] = f2bf(oacc[(16 + r) * 64 + lane]); }
}
__device__ __forceinline__ void mla_unit(Frame F, int b, int h, int qb) {
    LAUNDER(F);
    LAS unsigned char* lds = F.lds; LAS float* wsf = (LAS float*)(lds + L_WS) + F.wave * 64;
    const int wid = F.wave, lane = F.lane, r32 = lane & 31, hi = lane >> 5;
    const size_t hrow = (size_t)(b * 4 + h) * SEQ;
    const bf16_t* QM = (const bf16_t*)(F.ws + WS_QM) + hrow * 96;
    TileSrc T; T.K = (const bf16_t*)(F.ws + WS_KM) + hrow * 96; T.kpitch = 96; T.V = (const bf16_t*)(F.ws + WS_VM) + hrow * 64; T.vpitch = 64;
    const int q0 = qb * 256, qw0 = q0 + 32 * wid, qrow = qw0 + r32;
    bf16x8 qf[6];
#pragma unroll
    for (int d0 = 0; d0 < 6; ++d0) qf[d0] = *(const bf16x8*)(QM + (size_t)qrow * 96 + d0 * 16 + hi * 8);
    float m = NEG_INF, l = 0.f; f32x16 o[2]; o[0] = f32x16{}; o[1] = f32x16{};
    const int NT = (q0 + 256) / 64;
    Stage st; stage_load<96>(st, T, 0, wid, lane); stage_write<96>(st, lds, 0, wid, lane); __syncthreads();
    for (int t = 0; t < NT; ++t) {
        if (t + 1 < NT) stage_load<96>(st, T, 64 * (t + 1), wid, lane);
        const int kv0 = 64 * t;
        if (kv0 <= qw0 + 31) {
            f32x16 p0, p1; qk<96>(p0, p1, lds + L_K + (t & 1) * KSLOT, qf, 0.f, r32, hi);
            if (kv0 + 63 > qw0) {
#pragma unroll
                for (int r = 0; r < 16; ++r) { const int kv = kv0 + crow(r, hi); if (kv > qrow) p0[r] = NEG_INF; if (kv + 32 > qrow) p1[r] = NEG_INF; }
            }
            softmax_pv(p0, p1, m, l, o, lds + L_V + (t & 1) * VSLOT, wsf, lane);
        }
        if (t + 1 < NT) stage_write<96>(st, lds, (t + 1) & 1, wid, lane);
        __syncthreads();
    }
    const float lt = half_swap_sum(l); const float inv = lt > 0.f ? 1.0f / lt : 0.f;
    LAS float* oacc = (LAS float*)(lds + L_OACC) + F.wave * 2048;
    scaled_add(oacc, o, inv, wsf, lane, true);
    store_oacc(oacc, (bf16_t*)(F.ws + WS_CAT) + (size_t)(b * SEQ + qw0) * DMODEL + CC_MLA + h * 64, DMODEL, lane);
}

__device__ __forceinline__ void nsa_unit(Frame F, int b, int qt) {
    LAUNDER(F);
    LAS unsigned char* lds = F.lds; LAS float* wsf = (LAS float*)(lds + L_WS) + F.wave * 64;
    LAS float* bt = (LAS float*)(lds + L_BT); LAS float* imp = (LAS float*)(lds + L_IMP); LAS unsigned* sel = (LAS unsigned*)(lds + L_SEL); LAS float* gate = (LAS float*)(lds + L_GATE);
    const int wid = F.wave, lane = F.lane, tid = F.tid, r32 = lane & 31, hi = lane >> 5, h = wid & 3, qh = wid >> 2;
    const int t0 = 64 * qt, qi = 32 * qh + r32, t = t0 + qi;
    const bf16_t* U = (const bf16_t*)(F.ws + WS_U) + (size_t)b * SEQ * NU;
    bf16x8 qf[4];
#pragma unroll
    for (int d0 = 0; d0 < 4; ++d0) qf[d0] = *(const bf16x8*)(U + (size_t)t * NU + UC_Q + h * 64 + d0 * 16 + hi * 8);
    for (int idx = tid; idx < 64 * 12; idx += 512) { const int q = idx / 12, k = idx - q * 12; gate[idx] = sigmoidf_(bf2f(U[(size_t)(t0 + q) * NU + UC_GATE + k])); }
    for (int idx = tid; idx < 64 * 128; idx += 512) imp[idx] = 0.f;
    __syncthreads();
    const LAS float* bth = bt + h * 132;
    LAS float* outacc = (LAS float*)(lds + L_OACC) + F.wave * 2048;
#ifndef SKIP_N1
    {
        const bf16_t* KC = (const bf16_t*)(F.ws + WS_KC);
        TileSrc T; T.K = KC + (size_t)(0 * 4 + b) * 512 * 64; T.kpitch = 64; T.V = KC + (size_t)(1 * 4 + b) * 512 * 64; T.vpitch = 64;
        const int NTc = (((t0 + 32) >> 4) >> 6) + 1;
        float m = NEG_INF, l = 0.f; Stage st;
        stage_load<64>(st, T, 0, wid, lane); stage_write<64>(st, lds, 0, wid, lane); __syncthreads();
        for (int ct = 0; ct < NTc; ++ct) {
            if (ct + 1 < NTc) stage_load<64>(st, T, 64 * (ct + 1), wid, lane);
            f32x16 p0, p1; qk<64>(p0, p1, lds + L_K + (ct & 1) * KSLOT, qf, 0.f, r32, hi);
#pragma unroll
            for (int r = 0; r < 16; ++r) { const int c = 64 * ct + crow(r, hi); const int d0 = t - (16 * c + 31), d1 = d0 - 512;
                p0[r] = (d0 >= 0) ? p0[r] + bth[d0 < 128 ? d0 : 128] : NEG_INF; p1[r] = (d1 >= 0) ? p1[r] + bth[d1 < 128 ? d1 : 128] : NEG_INF; }
            const float rm = rowmax(p0, p1), mn = fmaxf(m, rm), ms = (mn == NEG_INF) ? 0.f : mn; const float alpha = __builtin_amdgcn_exp2f(m - ms); m = mn; float sum = 0.f;
#pragma unroll
            for (int r = 0; r < 16; ++r) sum += __builtin_amdgcn_exp2f(p0[r] - ms) + __builtin_amdgcn_exp2f(p1[r] - ms);
            l = l * alpha + sum;
            if (ct + 1 < NTc) stage_write<64>(st, lds, (ct + 1) & 1, wid, lane);
            __syncthreads();
        }
        const float lt = half_swap_sum(l), inv = lt > 0.f ? 1.0f / lt : 0.f, ms = (m == NEG_INF) ? 0.f : m;
        f32x16 o[2]; o[0] = f32x16{}; o[1] = f32x16{};
        stage_load<64>(st, T, 0, wid, lane); stage_write<64>(st, lds, 0, wid, lane); __syncthreads();
        for (int ct = 0; ct < NTc; ++ct) {
            if (ct + 1 < NTc) stage_load<64>(st, T, 64 * (ct + 1), wid, lane);
            f32x16 p0, p1; qk<64>(p0, p1, lds + L_K + (ct & 1) * KSLOT, qf, 0.f, r32, hi);
#pragma unroll
            for (int r = 0; r < 16; ++r) { const int c = 64 * ct + crow(r, hi); const int d0 = t - (16 * c + 31), d1 = d0 - 512;
                p0[r] = (d0 >= 0) ? __builtin_amdgcn_exp2f(p0[r] + bth[d0 < 128 ? d0 : 128] - ms) * inv : 0.f;
                p1[r] = (d1 >= 0) ? __builtin_amdgcn_exp2f(p1[r] + bth[d1 < 128 ? d1 : 128] - ms) * inv : 0.f; }
            LAS float* ip = imp + qi * 128 + 16 * ct + hi;
#pragma unroll
            for (int g = 0; g < 4; ++g) {
                const float a0 = (p0[4 * g] + p0[4 * g + 1]) + (p0[4 * g + 2] + 0.5f * p0[4 * g + 3]), b0 = 0.5f * p0[4 * g + 3];
                const float a1 = (p1[4 * g] + p1[4 * g + 1]) + (p1[4 * g + 2] + 0.5f * p1[4 * g + 3]), b1 = 0.5f * p1[4 * g + 3];
                const int j0 = 2 * g, j1 = 8 + 2 * g;
                atomicAdd((float*)(ip + j0), a0); atomicAdd((float*)(ip + j1), a1);
                if (16 * ct + hi + j0 + 1 < 128) atomicAdd((float*)(ip + j0 + 1), b0);
                if (16 * ct + hi + j1 + 1 < 128) atomicAdd((float*)(ip + j1 + 1), b1);
            }
            pv(o, p0, p1, lds + L_V + (ct & 1) * VSLOT, lane);
            if (ct + 1 < NTc) stage_write<64>(st, lds, (ct + 1) & 1, wid, lane);
            __syncthreads();
        }
        scaled_add(outacc, o, gate[qi * 12 + h * 3 + 0], wsf, lane, true);
    }
#else
    for (int i = 0; i < 32; ++i) outacc[i * 64 + lane] = 0.f;
#endif
#ifndef SKIP_N2
    {
        const int jc = qt;
        for (int qq = 0; qq < 8; ++qq) {
            const int q = 8 * wid + qq; unsigned long long m0, m1;
            if (jc + 1 <= 16) { m0 = (jc >= 63) ? ~0ull : ((1ull << (jc + 1)) - 1ull); m1 = 0ull; }
            else {
                const int ja = lane, jb2 = lane + 64;
                const float v0 = imp[q * 128 + ja], v1 = imp[q * 128 + jb2];
                const bool c0 = (ja >= 1 && ja <= jc - 2), c1 = (jb2 <= jc - 2);
                const unsigned u0 = c0 ? (__float_as_uint(v0) + 1u) : 0u, u1 = c1 ? (__float_as_uint(v1) + 1u) : 0u;
                unsigned thr = 0u;
                for (int bit = 31; bit >= 0; --bit) { const unsigned tr = thr | (1u << bit);
                    const int cnt = __popcll(__ballot(u0 >= tr)) + __popcll(__ballot(u1 >= tr)); if (cnt >= 13) thr = tr; }
                const unsigned long long g0 = __ballot(u0 > thr), g1 = __ballot(u1 > thr), e0 = __ballot(u0 == thr), e1 = __ballot(u1 == thr);
                int need = 13 - (__popcll(g0) + __popcll(g1));
                const unsigned long long lt_mask = (1ull << lane) - 1ull;
                const int rk0 = __popcll(e0 & lt_mask), rk1 = __popcll(e0) + __popcll(e1 & lt_mask);
                const bool s0 = (u0 > thr) || (u0 == thr && rk0 < need) || ja == 0 || ja == jc || ja == jc - 1;
                const bool s1 = (u1 > thr) || (u1 == thr && rk1 < need) || jb2 == jc || jb2 == jc - 1;
                m0 = __ballot(s0); m1 = __ballot(s1);
            }
            if (lane == 0) { sel[q * 4 + 0] = (unsigned)m0; sel[q * 4 + 1] = (unsigned)(m0 >> 32); sel[q * 4 + 2] = (unsigned)m1; sel[q * 4 + 3] = (unsigned)(m1 >> 32); }
        }
    }
    __syncthreads();
#endif
#ifndef SKIP_N3
    {
        TileSrc T; T.K = U + UC_KV + 128; T.kpitch = NU; T.V = U + UC_KV + 192; T.vpitch = NU;
        const int NT = qt + 1; const float cfar = bth[128];
        float m = NEG_INF, l = 0.f; f32x16 o[2]; o[0] = f32x16{}; o[1] = f32x16{}; Stage st;
        stage_load<64>(st, T, 0, wid, lane); stage_write<64>(st, lds, 0, wid, lane); __syncthreads();
        for (int jt = 0; jt < NT; ++jt) {
            if (jt + 1 < NT) stage_load<64>(st, T, 64 * (jt + 1), wid, lane);
            const bool selb = ((sel[qi * 4 + (jt >> 5)] >> (jt & 31)) & 1u) != 0u;
            if (__any(selb)) {
                const bool near = (jt >= qt - 2);
                f32x16 p0, p1; qk<64>(p0, p1, lds + L_K + (jt & 1) * KSLOT, qf, near ? 0.f : cfar, r32, hi);
                if (near) {
#pragma unroll
                    for (int r = 0; r < 16; ++r) { const int d0 = t - (64 * jt + crow(r, hi)), d1 = d0 - 32;
                        p0[r] = (selb && d0 >= 0) ? p0[r] + bth[d0 < 128 ? d0 : 128] : NEG_INF; p1[r] = (selb && d1 >= 0) ? p1[r] + bth[d1 < 128 ? d1 : 128] : NEG_INF; }
                } else if (!selb) {
#pragma unroll
                    for (int r = 0; r < 16; ++r) { p0[r] = NEG_INF; p1[r] = NEG_INF; }
                }
                softmax_pv(p0, p1, m, l, o, lds + L_V + (jt & 1) * VSLOT, wsf, lane);
            }
            if (jt + 1 < NT) stage_write<64>(st, lds, (jt + 1) & 1, wid, lane);
            __syncthreads();
        }
        const float lt = half_swap_sum(l);
        scaled_add(outacc, o, lt > 0.f ? gate[qi * 12 + h * 3 + 1] / lt : 0.f, wsf, lane, false);
    }
#endif
#ifndef SKIP_N4
    {
        TileSrc T; T.K = U + UC_KV + 256; T.kpitch = NU; T.V = U + UC_KV + 320; T.vpitch = NU;
        const int j_lo = qt >= 8 ? qt - 8 : 0; const float cfar = bth[128];
        float m = NEG_INF, l = 0.f; f32x16 o[2]; o[0] = f32x16{}; o[1] = f32x16{}; Stage st;
        stage_load<64>(st, T, 64 * j_lo, wid, lane); stage_write<64>(st, lds, 0, wid, lane); __syncthreads();
        for (int jt = j_lo; jt <= qt; ++jt) {
            const int it = jt - j_lo;
            if (jt < qt) stage_load<64>(st, T, 64 * (jt + 1), wid, lane);
            const bool edge = (jt >= qt - 2) || (jt == qt - 8);
            f32x16 p0, p1; qk<64>(p0, p1, lds + L_K + (it & 1) * KSLOT, qf, edge ? 0.f : cfar, r32, hi);
            if (edge) {
#pragma unroll
                for (int r = 0; r < 16; ++r) { const int d0 = t - (64 * jt + crow(r, hi)), d1 = d0 - 32;
                    p0[r] = (d0 >= 0 && d0 < 512) ? p0[r] + bth[d0 < 128 ? d0 : 128] : NEG_INF; p1[r] = (d1 >= 0 && d1 < 512) ? p1[r] + bth[d1 < 128 ? d1 : 128] : NEG_INF; }
            }
            softmax_pv(p0, p1, m, l, o, lds + L_V + (it & 1) * VSLOT, wsf, lane);
            if (jt < qt) stage_write<64>(st, lds, (it + 1) & 1, wid, lane);
            __syncthreads();
        }
        const float lt = half_swap_sum(l);
        scaled_add(outacc, o, lt > 0.f ? gate[qi * 12 + h * 3 + 2] / lt : 0.f, wsf, lane, false);
    }
#endif
    store_oacc(outacc, (bf16_t*)(F.ws + WS_CAT) + (size_t)(b * SEQ + t0 + 32 * qh) * DMODEL + CC_NSA + h * 64, DMODEL, lane);
    __syncthreads();
}

__device__ __forceinline__ void phaseC(Frame F) {
    LAUNDER(F);
    { LAS float* bt = (LAS float*)(F.lds + L_BT);
      for (int idx = F.tid; idx < 4 * 132; idx += 512) { const int h = idx / 132, d = idx - h * 132; bt[idx] = (d <= 128) ? IN(F, 21)[BUCKET[d] * 4 + h] * LOG2E : 0.f; }
      __syncthreads(); }
    for (int p = F.vcu; p < 256; p += F.G) {
#ifndef SKIP_C1
        { const int bh = p >> 4, s = p & 15; mla_unit(F, bh >> 2, bh & 3, 31 - s); mla_unit(F, bh >> 2, bh & 3, s); }
#endif
#ifndef SKIP_C2
        { const int b = p >> 6, s = p & 63; nsa_unit(F, b, 127 - s); nsa_unit(F, b, s); }
#endif
    }
}
}
constexpr int NTHREADS = 512;

template <class Sched> __device__ __forceinline__ void build_rs(Frame& F, const Sched& S) {
    LAS float* rs = (LAS float*)(F.lds + LDS_RS); const float* ss = (const float*)(F.ws + WS_SS); pg8::Unit u;
    for (int i = 0; S.next(i, u); ++i) {
        if (F.tid < 256) { const int row = u.pm * 256 + F.tid; const f32x4* p = (const f32x4*)(ss + (size_t)row * 16); const f32x4 v0 = p[0], v1 = p[1], v2 = p[2], v3 = p[3];
            const float s = (((v0[0] + v0[1]) + (v0[2] + v0[3])) + ((v1[0] + v1[1]) + (v1[2] + v1[3]))) + (((v2[0] + v2[1]) + (v2[2] + v2[3])) + ((v3[0] + v3[1]) + (v3[2] + v3[3])));
            rs[i * 256 + F.tid] = 1.0f / sqrtf(s * (1.f / DMODEL) + EPS); }
    }
    __syncthreads();
}

__device__ __forceinline__ void phaseA(Frame F, int l) {
    LAUNDER(F);
    pg8::Gemm g{(const bf16_t*)(F.ws + WS_HB), (const bf16_t*)(F.ws + WS_W + (size_t)l * W_LAYER + WO_WIN), MTOK, NU, DMODEL};
    pg8::StaticOrder S; S.init(MTOK, NU, F.G, F.bid);
    build_rs(F, S);
    pg8::EpiRowScale<0> E{(bf16_t*)(F.ws + WS_U), NU, (const LAS float*)(F.lds + LDS_RS)};
    pg8::gemm_phase<pg8::EpiRowScale<0>, pg8::StaticOrder, true, true>(F.lds, g, S, E);
}
__device__ __forceinline__ void phaseRes(Frame F, size_t a_off, size_t b_off, int K, bool first) {
    LAUNDER(F);
    float* out = (float*)IN(F, 23); const float* base = first ? IN(F, 0) : out;
    const bf16_t* A = (const bf16_t*)(F.ws + a_off); const bf16_t* Bt = (const bf16_t*)(F.ws + b_off);
    pg8::Gemm g{A, Bt, MTOK, DMODEL, K};
    pg8::StaticOrder S; S.init(MTOK, DMODEL, F.G, F.bid);
    pg8::EpiResidual E{base, out, (bf16_t*)(F.ws + WS_HB), (float*)(F.ws + WS_SS)};
    pg8::gemm_phase<pg8::EpiResidual, pg8::StaticOrder, true, true>(F.lds, g, S, E);
}
__device__ __forceinline__ void phaseE(Frame F, int l) {
    LAUNDER(F);
    pg8::Gemm g{(const bf16_t*)(F.ws + WS_HB), (const bf16_t*)(F.ws + WS_W + (size_t)l * W_LAYER + WO_W1), MTOK, DFF, DMODEL};
    pg8::StaticOrder S; S.init(MTOK, DFF, F.G, F.bid);
    build_rs(F, S);
    pg8::EpiRowScale<1> E{(bf16_t*)(F.ws + WS_Z), DFF, (const LAS float*)(F.lds + LDS_RS)};
    pg8::gemm_phase<pg8::EpiRowScale<1>, pg8::StaticOrder, true, true>(F.lds, g, S, E);
}
__device__ __forceinline__ void phaseG(Frame F) {
    LAUNDER(F);
    const float* ss = (const float*)(F.ws + WS_SS); const int gw = F.bid * 8 + F.wave, NGW = F.G * 8;
    const f32x4* gp = (const f32x4*)IN(F, 22) + F.lane; float* outp = (float*)IN(F, 23);
    for (int m = gw; m < MTOK; m += NGW) {
        float s = (F.lane < 16) ? ss[(size_t)m * 16 + F.lane] : 0.f; s = wave_sum(s);
        const float r = 1.0f / sqrtf(s * (1.f / DMODEL) + EPS);
        f32x4* hr = (f32x4*)(outp + (size_t)m * DMODEL) + F.lane;
#pragma unroll
        for (int j = 0; j < 4; ++j) { const f32x4 v = hr[64 * j]; hr[64 * j] = v * r * gp[64 * j]; }
    }
}

__global__ void __launch_bounds__(NTHREADS, 2) mega_fwd(Args a) {
    extern __shared__ __attribute__((aligned(16))) unsigned char lds_raw[];
    cg::grid_group grid = cg::this_grid();
    Frame F;
    F.lds = (LAS unsigned char*)lds_raw; F.tid = threadIdx.x; F.lane = F.tid & 63; F.wave = __builtin_amdgcn_readfirstlane(F.tid >> 6);
    F.G = gridDim.x; F.bid = blockIdx.x; F.vcu = (F.G % 8 == 0) ? (F.bid % 8) * (F.G / 8) + F.bid / 8 : F.bid; F.ws = a.ws;
    if (F.tid < 128) ((LAS unsigned*)(F.lds + LDS_CTL))[F.tid] = 0u;
    __syncthreads();
    const XcdBarrier bar = xcd_barrier_post((unsigned*)(a.ws + WS_BAR), (volatile LAS unsigned*)(F.lds + LDS_CTL));
#define SEAM() xcd_barrier(bar)
#ifndef SKIP_P0
    prologue(a, F);
#ifdef PROBE_P0
    __syncthreads(); prologue(a, F);
#endif
#endif
    grid.sync();
    for (int l = 0; l < NLAYER; ++l) {
#ifndef SKIP_PA
        phaseA(F, l);
#ifdef PROBE_PA
        phaseA(F, l);
#endif
#endif
        SEAM();
#ifndef SKIP_PB
        phaseB(F, l);
#ifdef PROBE_PB
        phaseB(F, l);
#endif
#endif
        SEAM();
#ifndef SKIP_PC
        att::phaseC(F);
#ifdef PROBE_PC
        att::phaseC(F);
#endif
#endif
        SEAM();
#ifndef SKIP_PD
        phaseRes(F, WS_CAT, WS_W + (size_t)l * W_LAYER + WO_WOUT, DMODEL, l == 0);
#endif
        SEAM();
#ifndef SKIP_PE
        phaseE(F, l);
#ifdef PROBE_PE
        phaseE(F, l);
#endif
#endif
        SEAM();
#ifndef SKIP_PF
        phaseRes(F, WS_Z, WS_W + (size_t)l * W_LAYER + WO_W2, DFF, false);
#endif
        SEAM();
#ifdef PROBE_SYNC
        SEAM(); SEAM(); SEAM(); SEAM(); SEAM(); SEAM();
#endif
    }
    phaseG(F);
}

extern "C" void kernel_launch(void* const* d_in, const int* in_sizes, int n_in, void* d_out, int out_size, void* d_ws, size_t ws_size, hipStream_t stream) {
    static int grid = 0;
    if (grid == 0) {
        if (n_in != 23 || out_size != MTOK * DMODEL || ws_size < WS_END) { fprintf(stderr, "kernel_launch: unexpected shapes: n_in %d out %d ws %zu (need >= %zu)\n", n_in, out_size, ws_size, (size_t)WS_END); grid = -1; return; }
        int dev = 0, cus = 0, per_cu = 0;
        if (hipGetDevice(&dev) != hipSuccess || hipDeviceGetAttribute(&cus, hipDeviceAttributeMultiprocessorCount, dev) != hipSuccess) { grid = -1; return; }
        if (hipFuncSetAttribute((const void*)mega_fwd, hipFuncAttributeMaxDynamicSharedMemorySize, LDS_BYTES) != hipSuccess) { fprintf(stderr, "kernel_launch: hipFuncSetAttribute failed\n"); grid = -1; return; }
        if (hipOccupancyMaxActiveBlocksPerMultiprocessor(&per_cu, (const void*)mega_fwd, NTHREADS, LDS_BYTES) != hipSuccess || per_cu < 1) { fprintf(stderr, "kernel_launch: occupancy query says %d blocks/CU\n", per_cu); grid = -1; return; }
        grid = cus;
        if (grid != 256) fprintf(stderr, "kernel_launch: note: %d CUs (built for 256)\n", grid);
    }
    if (grid < 0) return;
    if (hipMemsetAsync((char*)d_ws + WS_BAR, 0, 16384, stream) != hipSuccess) { fprintf(stderr, "kernel_launch: hipMemsetAsync failed\n"); return; }
    Args a{};
    for (int i = 0; i < 23; ++i) a.in[i] = (const float*)d_in[i];
    a.out = (float*)d_out; a.ws = (unsigned char*)d_ws;
    void* args[] = {&a};
    const hipError_t e = hipLaunchCooperativeKernel((const void*)mega_fwd, dim3(grid), dim3(NTHREADS), args, LDS_BYTES, stream);
    if (e != hipSuccess) fprintf(stderr, "kernel_launch: cooperative launch failed: %s (grid %d)\n", hipGetErrorString(e), grid);
}
```

```cpp
#include <hip/hip_runtime.h>
#include <hip/hip_cooperative_groups.h>
#include <cstdio>
#include <cstdint>
namespace cg = cooperative_groups;
namespace pg8 {
#define PG8_LAS __attribute__((address_space(3)))
typedef unsigned short bf16_t;
typedef short bf16x8 __attribute__((ext_vector_type(8)));
typedef float f32x4 __attribute__((ext_vector_type(4)));
typedef unsigned u32x4 __attribute__((ext_vector_type(4)));
typedef unsigned u32x2 __attribute__((ext_vector_type(2)));
constexpr int BM = 256, BK = 64, HALF = 128, HTB = HALF * BK * 2  , STAGE_BYTES = 8 * HTB, NXCD = 8, WGM = 8;

__host__ __device__ __forceinline__ int lds_byte(int r, int c) { const int st = (r >> 4) * 2 + (c >> 5), rr = r & 15, cc = c & 31, ob = rr * 64 + cc * 2; return st * 1024 + (ob ^ (((ob >> 9) & 1) << 5)); }
__host__ __device__ __forceinline__ void stage_rc(int b, int& R, int& C) { const int st = b / 1024, sb = b % 1024, swz = sb ^ (((sb >> 9) & 1) << 5); R = (st >> 1) * 16 + swz / 64; C = (st & 1) * 32 + (swz % 64) / 2; }
__host__ __device__ __forceinline__ int perm32(int rho) { const int n = rho >> 4, i = rho & 15; return 8 * (i >> 2) + 4 * n + (i & 3); }

struct Unit { int pm, pn, ui; };
struct Gemm { const bf16_t* A; const bf16_t* Bt; int M, N, K; };

struct StaticOrder {
    int nM, nN, nwg, G, c;
    __host__ __device__ void init(int M, int N, int G_, int c_) { nM = M / BM; nN = N / BM; nwg = nM * nN; G = G_; c = c_; }
    __host__ __device__ bool next(int i, Unit& u) const {
        const long L = (long)i * G + c; if (L >= nwg) return false;
        int wgid = (int)L; { const int q = nwg / NXCD, r = nwg % NXCD, xcd = wgid % NXCD, off = wgid / NXCD; wgid = (xcd < r ? xcd * (q + 1) : r * (q + 1) + (xcd - r) * q) + off; }
        const int nig = WGM * nN, gid = wgid / nig, fm = gid * WGM, gsz = (nM - fm) < WGM ? (nM - fm) : WGM;
        u.pm = fm + ((wgid % nig) % gsz); u.pn = (wgid % nig) / gsz; u.ui = i; return true;
    }
    __device__ __forceinline__ void a_ready(const Unit&) const {}
    __device__ __forceinline__ void done(const Unit&) const {}
};

typedef float f32x2 __attribute__((ext_vector_type(2)));
typedef __bf16 bf16x2_t __attribute__((ext_vector_type(2)));
__device__ __forceinline__ unsigned cvt_pk_bf16(float lo, float hi) { f32x2 v = {lo, hi}; bf16x2_t b = __builtin_convertvector(v, bf16x2_t); return __builtin_bit_cast(unsigned, b); }

template <int ACT> struct EpiRowScale {
    static constexpr bool PERM = true, AFTER_DRAIN = false;
    bf16_t* O; int ldc; const PG8_LAS float* rs;
    __device__ __forceinline__ void operator()(const f32x4 (&acc)[2][2][4][2], const Unit& u, int wr, int wc, int fr, int fq) const {
        const int rl0 = wr * 64 + fr, col0 = u.pn * BM + wc * 32 + 8 * fq;
#pragma unroll
        for (int ai = 0; ai < 2; ++ai)
#pragma unroll
            for (int m = 0; m < 4; ++m) { const int rl = rl0 + ai * HALF + m * 16; const float s = rs[u.ui * 256 + rl];
                bf16_t* rowp = O + (size_t)(u.pm * BM + rl) * ldc + col0;
#pragma unroll
                for (int bj = 0; bj < 2; ++bj) { f32x4 v0 = acc[ai][bj][m][0] * s, v1 = acc[ai][bj][m][1] * s;
                    if (ACT == 1) {
#pragma unroll
                        for (int e = 0; e < 4; ++e) { float a = fmaxf(v0[e], 0.f), b = fmaxf(v1[e], 0.f); v0[e] = a * a; v1[e] = b * b; } }
                    u32x4 w; w.x = cvt_pk_bf16(v0[0], v0[1]); w.y = cvt_pk_bf16(v0[2], v0[3]); w.z = cvt_pk_bf16(v1[0], v1[1]); w.w = cvt_pk_bf16(v1[2], v1[3]);
                    *(u32x4*)(rowp + bj * HALF) = w; } }
    }
};
struct EpiResidual {
    static constexpr bool PERM = false, AFTER_DRAIN = false;
    const float* base; float* out; bf16_t* hb; float* ss;
    __device__ __forceinline__ void operator()(const f32x4 (&acc)[2][2][4][2], const Unit& u, int wr, int wc, int fr, int fq) const {
        const int col0 = u.pn * BM + wc * 32 + 4 * fq;
#pragma unroll
        for (int ai = 0; ai < 2; ++ai)
#pragma unroll
            for (int m = 0; m < 4; ++m) { const int row = u.pm * BM + wr * 64 + fr + ai * HALF + m * 16; const size_t off = (size_t)row * 1024 + col0; float q = 0.f;
#pragma unroll
                for (int bj = 0; bj < 2; ++bj)
#pragma unroll
                    for (int n = 0; n < 2; ++n) { const size_t o2 = off + bj * HALF + n * 16; const f32x4 b = *(const f32x4*)(base + o2); const f32x4 o = b + acc[ai][bj][m][n];
                        *(f32x4*)(out + o2) = o; q += (o[0] * o[0] + o[1] * o[1]) + (o[2] * o[2] + o[3] * o[3]);
                        u32x2 w; w.x = cvt_pk_bf16(o[0], o[1]); w.y = cvt_pk_bf16(o[2], o[3]); *(u32x2*)(hb + o2) = w; }
                q += __shfl_xor(q, 16); q += __shfl_xor(q, 32);
                if (fq == 0) ss[(size_t)row * 16 + u.pn * 4 + wc] = q; }
    }
};

template <class Epi, class Sched, bool ALIGN_EPI = false, bool SP2 = false>
__device__ __forceinline__ void gemm_phase(PG8_LAS unsigned char* lds, const Gemm g, const Sched& S, const Epi& E) {
    int tid_ = threadIdx.x; asm volatile("" : "+v"(tid_));
    const int tid = tid_, wid = __builtin_amdgcn_readfirstlane(tid >> 6), lane = tid & 63, wr = wid >> 2, wc = wid & 3, fr = lane & 15, fq = lane >> 4;
    const int K = g.K, nt = K / BK;
    unsigned voffA[2], voffB[2];
#pragma unroll
    for (int i = 0; i < 2; ++i) { int R, C; stage_rc(tid * 16 + i * 8192, R, C); const int Rb = Epi::PERM ? ((R & ~31) + perm32(R & 31)) : R;
        voffA[i] = (unsigned)(R * K + C) * 2u; voffB[i] = (unsigned)(Rb * K + C) * 2u; }
    const size_t kstep = (size_t)(BK * 2);
    const size_t hstep = (size_t)HALF * K * 2;
    const size_t tstep = 2 * hstep;
    const unsigned ldsw = (unsigned)wid * 1024u;
    const int aoff = lds_byte(wr * 64 + fr, fq * 8), boff = lds_byte(wc * 32 + fr, fq * 8);
#define PG8_SA(b, h) (((b) * 2 + (h)) * HTB)
#define PG8_SB(b, h) ((4 + (b) * 2 + (h)) * HTB)
#define PG8_STAGE(bufoff, gbase, voff) do { _Pragma("unroll") for (int _i = 0; _i < 2; ++_i) \
        __builtin_amdgcn_global_load_lds((const unsigned*)((const char*)(gbase) + (voff)[_i]), (PG8_LAS unsigned*)(lds + (bufoff) + ldsw + _i * 8192), 16, 0, 0); } while (0)
#define PG8_LDA(dst, b, h) do { _Pragma("unroll") for (int m = 0; m < 4; ++m) _Pragma("unroll") for (int k = 0; k < 2; ++k) dst[m][k] = *(const PG8_LAS bf16x8*)(lds + PG8_SA(b, h) + aoff + m * 2048 + k * 1024); } while (0)
#define PG8_LDB(dst, b, h) do { _Pragma("unroll") for (int n = 0; n < 2; ++n) _Pragma("unroll") for (int k = 0; k < 2; ++k) dst[n][k] = *(const PG8_LAS bf16x8*)(lds + PG8_SB(b, h) + boff + n * 2048 + k * 1024); } while (0)
#define PG8_MMA(ai, bj, At, Bt) do { __builtin_amdgcn_s_setprio(1); _Pragma("unroll") for (int m = 0; m < 4; ++m) _Pragma("unroll") for (int n = 0; n < 2; ++n) _Pragma("unroll") for (int k = 0; k < 2; ++k) \
        acc[ai][bj][m][n] = __builtin_amdgcn_mfma_f32_16x16x32_bf16(Bt[n][k], At[m][k], acc[ai][bj][m][n], 0, 0, 0); __builtin_amdgcn_s_setprio(0); } while (0)
#define PG8_WAIT_V(n) asm volatile("s_waitcnt vmcnt(" #n ")" ::: "memory")
#define PG8_WAIT_L(n) asm volatile("s_waitcnt lgkmcnt(" #n ")" ::: "memory")
#define PG8_BAR __builtin_amdgcn_s_barrier()
#define PG8_SCHED __builtin_amdgcn_sched_barrier(0)
    Unit cur, nxt; int ui = 0;
    if (!S.next(0, cur)) return;
    f32x4 acc[2][2][4][2];
#pragma unroll
    for (int a = 0; a < 2; ++a)
#pragma unroll
        for (int b = 0; b < 2; ++b)
#pragma unroll
            for (int m = 0; m < 4; ++m)
#pragma unroll
                for (int n = 0; n < 2; ++n) acc[a][b][m][n] = (f32x4){0.f, 0.f, 0.f, 0.f};
    bf16x8 At[4][2], B0[2][2], B1[2][2];
    const char* cA = (const char*)g.A + (size_t)cur.pm * tstep; const char* cB = (const char*)g.Bt + (size_t)cur.pn * tstep;
    S.a_ready(cur);
    if constexpr (SP2) {
        PG8_STAGE(PG8_SB(0, 0), cB, voffB); PG8_STAGE(PG8_SB(0, 1), cB + hstep, voffB); PG8_STAGE(PG8_SA(0, 0), cA, voffA); PG8_STAGE(PG8_SA(0, 1), cA + hstep, voffA);
        if (wr == 1) PG8_BAR;
        PG8_WAIT_V(2); PG8_BAR;
        PG8_STAGE(PG8_SB(1, 0), cB + kstep, voffB); PG8_STAGE(PG8_SA(1, 0), cA + kstep, voffA); PG8_STAGE(PG8_SB(1, 1), cB + hstep + kstep, voffB);
        PG8_WAIT_V(6); PG8_BAR;
    } else {
        PG8_STAGE(PG8_SB(0, 0), cB, voffB); PG8_STAGE(PG8_SA(0, 0), cA, voffA); PG8_STAGE(PG8_SB(0, 1), cB + hstep, voffB); PG8_STAGE(PG8_SA(0, 1), cA + hstep, voffA);
        if (wr == 1) PG8_BAR;
        PG8_WAIT_V(4); PG8_BAR;
        PG8_STAGE(PG8_SB(1, 0), cB + kstep, voffB); PG8_STAGE(PG8_SA(1, 0), cA + kstep, voffA); PG8_STAGE(PG8_SB(1, 1), cB + hstep + kstep, voffB);
        PG8_WAIT_V(6); PG8_BAR;
    }
    for (;;) {
        const bool has_next = S.next(ui + 1, nxt);
        const char* nA = has_next ? (const char*)g.A + (size_t)nxt.pm * tstep : cA; const char* nB = has_next ? (const char*)g.Bt + (size_t)nxt.pn * tstep : cB;
        for (int t = 0; t < nt; t += 2) {
            const bool last = (t == nt - 2);
            const char* a1 = cA + (size_t)(t + 1) * kstep;
            const char* a2 = last ? nA : cA + (size_t)(t + 2) * kstep; const char* b2 = last ? nB : cB + (size_t)(t + 2) * kstep;
            const char* a3 = a2 + kstep; const char* b3 = b2 + kstep;
            if (last && has_next) S.a_ready(nxt);
            if constexpr (SP2) {
            PG8_LDB(B0, 0, 0); PG8_LDB(B1, 0, 1); PG8_SCHED; PG8_LDA(At, 0, 0); PG8_STAGE(PG8_SA(1, 1), a1 + hstep, voffA);
            PG8_WAIT_V(8); PG8_WAIT_L(0); PG8_BAR; PG8_MMA(0, 0, At, B0); PG8_MMA(0, 1, At, B1); PG8_BAR; PG8_SCHED;
            PG8_LDA(At, 0, 1); PG8_STAGE(PG8_SB(0, 0), b2, voffB); PG8_STAGE(PG8_SB(0, 1), b2 + hstep, voffB); PG8_STAGE(PG8_SA(0, 0), a2, voffA);
            PG8_WAIT_V(8); PG8_WAIT_L(0); PG8_BAR; PG8_MMA(1, 0, At, B0); PG8_MMA(1, 1, At, B1); PG8_BAR; PG8_SCHED;
            PG8_LDB(B0, 1, 0); PG8_LDB(B1, 1, 1); PG8_SCHED; PG8_LDA(At, 1, 0); PG8_STAGE(PG8_SA(0, 1), a2 + hstep, voffA);
            PG8_WAIT_V(8); PG8_WAIT_L(0); PG8_BAR; PG8_MMA(0, 0, At, B0); PG8_MMA(0, 1, At, B1); PG8_BAR; PG8_SCHED;
            PG8_LDA(At, 1, 1); PG8_STAGE(PG8_SB(1, 0), b3, voffB); PG8_STAGE(PG8_SB(1, 1), b3 + hstep, voffB); PG8_STAGE(PG8_SA(1, 0), a3, voffA);
            PG8_WAIT_V(8); PG8_WAIT_L(0); PG8_BAR; PG8_MMA(1, 0, At, B0); PG8_MMA(1, 1, At, B1); PG8_BAR; PG8_SCHED;
            } else {
            PG8_LDB(B0, 0, 0); PG8_SCHED; PG8_LDA(At, 0, 0); PG8_STAGE(PG8_SA(1, 1), a1 + hstep, voffA);
            PG8_WAIT_L(8); PG8_BAR; PG8_WAIT_L(0); PG8_MMA(0, 0, At, B0); PG8_BAR; PG8_SCHED;
            PG8_LDB(B1, 0, 1); PG8_STAGE(PG8_SB(0, 0), b2, voffB);
            PG8_BAR; PG8_WAIT_L(0); PG8_MMA(0, 1, At, B1); PG8_BAR;
            PG8_LDA(At, 0, 1); PG8_STAGE(PG8_SA(0, 0), a2, voffA);
            PG8_BAR; PG8_WAIT_L(0); PG8_MMA(1, 0, At, B0); PG8_BAR; PG8_SCHED;
            PG8_STAGE(PG8_SB(0, 1), b2 + hstep, voffB);
            PG8_WAIT_V(6); PG8_BAR; PG8_MMA(1, 1, At, B1); PG8_BAR;
            PG8_LDB(B0, 1, 0); PG8_SCHED; PG8_LDA(At, 1, 0); PG8_STAGE(PG8_SA(0, 1), a2 + hstep, voffA);
            PG8_WAIT_L(8); PG8_BAR; PG8_WAIT_L(0); PG8_MMA(0, 0, At, B0); PG8_BAR; PG8_SCHED;
            PG8_LDB(B1, 1, 1); PG8_STAGE(PG8_SB(1, 0), b3, voffB);
            PG8_BAR; PG8_WAIT_L(0); PG8_MMA(0, 1, At, B1); PG8_BAR;
            PG8_LDA(At, 1, 1); PG8_STAGE(PG8_SA(1, 0), a3, voffA);
            PG8_BAR; PG8_WAIT_L(0); PG8_MMA(1, 0, At, B0); PG8_BAR; PG8_SCHED;
            PG8_STAGE(PG8_SB(1, 1), b3 + hstep, voffB);
            PG8_WAIT_V(6); PG8_BAR; PG8_MMA(1, 1, At, B1); PG8_BAR;
            }
        }
        if constexpr (ALIGN_EPI) { if (wr == 0) PG8_BAR; }
        if constexpr (!Epi::AFTER_DRAIN) { E(acc, cur, wr, wc, fr, fq); S.done(cur); }
        if (!has_next) break;
#pragma unroll
        for (int a = 0; a < 2; ++a)
#pragma unroll
            for (int b = 0; b < 2; ++b)
#pragma unroll
                for (int m = 0; m < 4; ++m)
#pragma unroll
                    for (int n = 0; n < 2; ++n) acc[a][b][m][n] = (f32x4){0.f, 0.f, 0.f, 0.f};
        cur = nxt; cA = nA; cB = nB; ++ui;
        if constexpr (ALIGN_EPI) { if (wr == 1) PG8_BAR; }
    }
    PG8_WAIT_V(0);
    if constexpr (!ALIGN_EPI) { if (wr == 0) PG8_BAR; }
    PG8_BAR;
#undef PG8_SA
#undef PG8_SB
#undef PG8_STAGE
#undef PG8_LDA
#undef PG8_LDB
#undef PG8_MMA
#undef PG8_WAIT_V
#undef PG8_WAIT_L
#undef PG8_BAR
#undef PG8_SCHED
}
}
#define LAS __attribute__((address_space(3)))
using pg8::bf16_t; using pg8::bf16x8; using pg8::f32x4; using pg8::u32x4; using pg8::u32x2; using pg8::cvt_pk_bf16;
typedef float f32x16 __attribute__((ext_vector_type(16)));
typedef short s16x4 __attribute__((ext_vector_type(4)));

constexpr int NB = 4, SEQ = 8192, MTOK = NB * SEQ, DMODEL = 1024, DIN = 1836, NU = 2048, DFF = 4096, NLAYER = 2;
constexpr float EPS = 1e-6f, LOG2E = 1.4426950408889634f;
constexpr float NSA_QSCALE = 0.125f * LOG2E;
constexpr float MLA_QSCALE = 0.10206207261596575f * LOG2E;
constexpr int UC_A = 0, UC_G = 256, UC_Q = 512, UC_KV = 768, UC_CQ = 1152, UC_CKV = 1408, UC_POOL = 1536, UC_KR = 1792, UC_GATE = 1824;
constexpr int CC_CONV = 0, CC_NSA = 256, CC_MLA = 512, CC_POOL = 768;

constexpr size_t MiB = 1u << 20;
constexpr size_t WS_W = 1 * MiB, W_LAYER = 24 * MiB;
constexpr size_t WO_WIN = 0, WO_WOUT = 4 * MiB, WO_W1 = 6 * MiB, WO_W2 = 14 * MiB, WO_SMALL = 22 * MiB;
constexpr size_t WO_PW = WO_SMALL, WO_UQ = WO_SMALL + 131072, WO_UKV = WO_SMALL + 327680, WO_C1 = WO_SMALL + 458752, WO_C2 = WO_SMALL + 1507328, WO_POOL = WO_SMALL + 1540096;
constexpr size_t WS_TAB = 4096, WS_ROPE = 50 * MiB, WS_CB1 = 51 * MiB  , WS_SS = 52 * MiB, WS_HB = 56 * MiB, WS_KC = 120 * MiB;
constexpr size_t WS_U = 128 * MiB, WS_CAT = 256 * MiB, WS_QM = 320 * MiB, WS_KM = 344 * MiB, WS_VM = 368 * MiB, WS_Z = 128 * MiB, WS_END = 384 * MiB;

constexpr int LDS_BYTES = 163840;
constexpr int LDS_RS = 131072;

__device__ const unsigned char BUCKET[129] = {0,1,2,3,4,5,6,7,8,9,10,11,12,13,14,15,16,16,16,17,17,18,18,18,19,19,19,20,20,20,20,21,21,21,21,22,22,22,22,22,23,23,23,23,23,23,24,24,24,24,24,24,25,25,25,25,25,25,25,26,26,26,26,26,26,26,26,27,27,27,27,27,27,27,27,27,27,28,28,28,28,28,28,28,28,28,28,29,29,29,29,29,29,29,29,29,29,29,29,30,30,30,30,30,30,30,30,30,30,30,30,30,30,31,31,31,31,31,31,31,31,31,31,31,31,31,31,31,31};

__device__ __forceinline__ float bf2f(unsigned short x) { return __uint_as_float((unsigned)x << 16); }
__device__ __forceinline__ unsigned short f2bf(float f) { return (unsigned short)(cvt_pk_bf16(f, 0.f) & 0xffffu); }
__device__ __forceinline__ float wave_sum(float v) {
#pragma unroll
    for (int o = 1; o < 64; o <<= 1) v += __shfl_xor(v, o);
    return v;
}
__device__ __forceinline__ float sigmoidf_(float x) { return 1.0f / (1.0f + __expf(-x)); }
__device__ __forceinline__ int crow(int r, int hi) { return (r & 3) + 8 * (r >> 2) + 4 * hi; }

struct Args { const float* in[23]; float* out; unsigned char* ws; int pad0, pad1; };

struct Frame {
    LAS unsigned char* lds;
    int tid, lane, wave, G, bid, vcu;
    unsigned char* ws;
};

#define LAUNDER(F) do { unsigned long long _w = (unsigned long long)(F).ws; asm volatile("" : "+s"(_w)); (F).ws = (unsigned char*)_w; \
    unsigned _l = (unsigned)(size_t)(F).lds; asm volatile("" : "+s"(_l)); (F).lds = (LAS unsigned char*)(size_t)_l; \
    asm volatile("" : "+v"((F).tid)); (F).lane = (F).tid & 63; (F).wave = __builtin_amdgcn_readfirstlane((F).tid >> 6); } while (0)

__device__ __forceinline__ const float* IN(const Frame& F, int k) { return ((const float* const*)(F.ws + WS_TAB))[k]; }

template <int K> __device__ __forceinline__ f32x16 small_mm(const LAS unsigned char* A, int lda_b, const bf16_t* BT, int lane) {
    const int r32 = lane & 31, hi = lane >> 5; f32x16 acc = {};
    const LAS unsigned char* ap = A + r32 * lda_b + hi * 16; const bf16_t* bp = BT + (size_t)r32 * K + hi * 8;
    bf16x8 bv[K / 16];
#pragma unroll
    for (int ks = 0; ks < K / 16; ++ks) bv[ks] = *(const bf16x8*)(bp + ks * 16);
#pragma unroll
    for (int ks = 0; ks < K / 16; ++ks) {
        const bf16x8 a = *(const LAS bf16x8*)(ap + ks * 32);
        acc = __builtin_amdgcn_mfma_f32_32x32x16_bf16(a, bv[ks], acc, 0, 0, 0);
    }
    return acc;
}
#define XB_TMO      128
#define XB_XCNT(j)  (256  + 64 * (j))
#define XB_XSUB(j)  (1280 + 64 * (j))
#define XB_XGEN(j)  (2304 + 64 * (j))
#define XB_TOP      3328
#define XB_TOPGEN   3392
#define XCD_BAR_WORDS 3456
#define XB_SPIN_CAP (1u << 18)
constexpr size_t WS_BAR = 65536;
constexpr int LDS_CTL = LDS_BYTES - 512;

__device__ __forceinline__ unsigned xb_ld(unsigned* p)              { return __hip_atomic_load(p, __ATOMIC_RELAXED, __HIP_MEMORY_SCOPE_AGENT); }
__device__ __forceinline__ unsigned xb_add(unsigned* p, unsigned v) { return __hip_atomic_fetch_add(p, v, __ATOMIC_RELAXED, __HIP_MEMORY_SCOPE_AGENT); }
__device__ __forceinline__ unsigned xb_xcc_id() { return (unsigned)__builtin_amdgcn_s_getreg((3 << 11) | 20) & 0xFu; }
#define XB_SPIN(cond, bar) do { unsigned _sp = 0; while (cond) { __builtin_amdgcn_s_sleep(1); \
    if ((++_sp & 255u) == 0u) { if (xb_ld(&(bar)[XB_TMO])) break; if (_sp > XB_SPIN_CAP) { atomicAdd(&(bar)[XB_TMO], 1u); break; } } } } while (0)

struct XcdBarrier { unsigned* bar; unsigned x; volatile LAS unsigned* st; };

__device__ __forceinline__ XcdBarrier xcd_barrier_post(unsigned* bar, volatile LAS unsigned* st) {
    XcdBarrier b; b.bar = bar; b.x = xb_xcc_id(); b.st = st;
    if (threadIdx.x == 0) (void)xb_add(&bar[XB_XCNT(b.x)], 1u);
    return b;
}
__device__ __forceinline__ void xcd_barrier_complete(unsigned* bar, unsigned x, unsigned& nloc, unsigned& nx) {
    const unsigned G = gridDim.x * gridDim.y * gridDim.z;
    unsigned sum, cnt, mine, sp = 0u;
    for (;;) {
        sum = 0u; cnt = 0u; mine = 0u;
#pragma unroll 1
        for (unsigned j = 0; j < 16; ++j) { const unsigned c = xb_ld(&bar[XB_XCNT(j)]); sum += c; cnt += (c > 0u) ? 1u : 0u; mine = (j == x) ? c : mine; }
        if (sum == G) break;
        __builtin_amdgcn_s_sleep(1);
        if ((++sp & 255u) == 0u) { if (xb_ld(&bar[XB_TMO])) break; if (sp > XB_SPIN_CAP) { atomicAdd(&bar[XB_TMO], 1u); break; } }
    }
    nloc = mine > 0u ? mine : 1u; nx = cnt > 0u ? cnt : 1u;
}
__device__ __forceinline__ void xcd_barrier(const XcdBarrier& b) {
    asm volatile("s_waitcnt vmcnt(0)" ::: "memory");
    __syncthreads();
    if (threadIdx.x == 0) {
        unsigned* bar; { unsigned long long _b = (unsigned long long)b.bar; asm volatile("" : "+s"(_b)); bar = (unsigned*)_b; }
        __builtin_amdgcn_s_waitcnt(0);
        unsigned nloc = b.st[0], nx = b.st[1];
        if (nloc == 0u) { xcd_barrier_complete(bar, b.x, nloc, nx); b.st[0] = nloc; b.st[1] = nx; }
        const unsigned old = xb_add(&bar[XB_XSUB(b.x)], 1u);
        const unsigned gen = old / nloc;
        if (old + 1u == (gen + 1u) * nloc) {
            __builtin_amdgcn_fence(__ATOMIC_RELEASE, "agent");
            asm volatile("s_waitcnt vmcnt(0)" ::: "memory");
            const unsigned og = xb_add(&bar[XB_TOP], 1u);
            const unsigned tg = og / nx;
            if (og + 1u == (tg + 1u) * nx) xb_add(&bar[XB_TOPGEN], 1u);
            else XB_SPIN(xb_ld(&bar[XB_TOPGEN]) == tg, bar);
            __builtin_amdgcn_fence(__ATOMIC_ACQUIRE, "agent");
            xb_add(&bar[XB_XGEN(b.x)], 1u);
            asm volatile("s_waitcnt vmcnt(0)" ::: "memory");
        } else {
            XB_SPIN(xb_ld(&bar[XB_XGEN(b.x)]) == gen, bar);
            __builtin_amdgcn_fence(__ATOMIC_ACQUIRE, "agent");
            asm volatile("s_waitcnt vmcnt(0)" ::: "memory");
        }
    }
    __syncthreads();
}
__device__ __forceinline__ int win_src(int n) {
    if (n < 1152) return n;
    if (n < 1408) return n - 1152 + 1164;
    if (n < 1536) return n - 1408 + 1420;
    if (n < 1792) return n - 1536 + 1580;
    if (n < 1824) return n - 1792 + 1548;
    if (n < 1836) return n - 1824 + 1152;
    return -1;
}
template <int MODE> __device__ __forceinline__ void transpose_item(const float* W, int K, int ldn, bf16_t* WT, const float* ks, float cs0, LAS float* scr, int item, int nblk, int lane) {
    const int kb = item / nblk, nb = item % nblk, k0 = 64 * kb, n0 = 32 * nb;
    const int nn = n0 + (lane & 31);
    int sc = nn; float cs = cs0;
    if (MODE == 1) { sc = win_src(nn); cs = (nn >= UC_Q && nn < UC_KV) ? NSA_QSCALE : 1.0f; }
#pragma unroll 8
    for (int i = 0; i < 32; ++i) { const int kk = 2 * i + (lane >> 5); float v = 0.f;
        if (sc >= 0) v = W[(size_t)(k0 + kk) * ldn + sc];
        if (ks) v *= ks[k0 + kk];
        scr[kk * 33 + (lane & 31)] = v * cs; }
    asm volatile("s_waitcnt lgkmcnt(0)" ::: "memory");
    const int c = lane & 7;
#pragma unroll
    for (int j = 0; j < 4; ++j) { const int n = (lane >> 3) + 8 * j; const LAS float* s = scr + (8 * c) * 33 + n;
        u32x4 o; o.x = cvt_pk_bf16(s[0 * 33], s[1 * 33]); o.y = cvt_pk_bf16(s[2 * 33], s[3 * 33]); o.z = cvt_pk_bf16(s[4 * 33], s[5 * 33]); o.w = cvt_pk_bf16(s[6 * 33], s[7 * 33]);
        *(u32x4*)(WT + (size_t)(n0 + n) * K + k0 + 8 * c) = o; }
    asm volatile("s_waitcnt lgkmcnt(0)" ::: "memory");
}

__device__ __forceinline__ void prologue(const Args& a, Frame F) {
    LAUNDER(F);
    if (F.bid == 0 && F.tid == 0) { const float** tab = (const float**)(F.ws + WS_TAB);
#pragma unroll
        for (int k = 0; k < 23; ++k) tab[k] = a.in[k];
        tab[23] = a.out; }
    LAS float* scr = (LAS float*)(F.lds + F.wave * 16384);
    const int gw = F.bid * 8 + F.wave, NGW = F.G * 8;
    constexpr int I_WIN = 16 * 64, I_WOUT = 16 * 32, I_W1 = 16 * 128, I_W2 = 64 * 32, I_PW = 4 * 8, I_UQ = 4 * 12, I_UKV = 2 * 16, I_C1 = 32 * 4, I_C2 = 2 * 2, I_PL = 1 * 2;
    constexpr int I_LAYER = I_WIN + I_WOUT + I_W1 + I_W2 + I_PW + I_UQ + I_UKV + 2 * I_C1 + 2 * I_C2 + 4 * I_PL;
    for (int it = gw; it < NLAYER * I_LAYER; it += NGW) {
        const int l = it / I_LAYER; int r = it % I_LAYER;
        unsigned char* wl = F.ws + WS_W + (size_t)l * W_LAYER;
        if (r < I_WIN) { transpose_item<1>(a.in[1] + (size_t)l * DMODEL * DIN, DMODEL, DIN, (bf16_t*)(wl + WO_WIN), a.in[3] + l * DMODEL, 1.f, scr, r, 64, F.lane); continue; } r -= I_WIN;
        if (r < I_WOUT) { transpose_item<0>(a.in[2] + (size_t)l * DMODEL * DMODEL, DMODEL, DMODEL, (bf16_t*)(wl + WO_WOUT), nullptr, 1.f, scr, r, 32, F.lane); continue; } r -= I_WOUT;
        if (r < I_W1) { transpose_item<0>(a.in[19] + (size_t)l * DMODEL * DFF, DMODEL, DFF, (bf16_t*)(wl + WO_W1), a.in[4] + l * DMODEL, 1.f, scr, r, 128, F.lane); continue; } r -= I_W1;
        if (r < I_W2) { transpose_item<0>(a.in[20] + (size_t)l * DFF * DMODEL, DFF, DMODEL, (bf16_t*)(wl + WO_W2), nullptr, 1.f, scr, r, 32, F.lane); continue; } r -= I_W2;
        if (r < I_PW) { transpose_item<0>(a.in[9] + (size_t)l * 256 * 256, 256, 256, (bf16_t*)(wl + WO_PW), nullptr, 1.f, scr, r, 8, F.lane); continue; } r -= I_PW;
        if (r < I_UQ) { transpose_item<0>(a.in[14] + (size_t)l * 256 * 384, 256, 384, (bf16_t*)(wl + WO_UQ), a.in[13] + l * 256, MLA_QSCALE, scr, r, 12, F.lane); continue; } r -= I_UQ;
        if (r < I_UKV) { transpose_item<0>(a.in[16] + (size_t)l * 128 * 512, 128, 512, (bf16_t*)(wl + WO_UKV), a.in[15] + l * 128, 1.f, scr, r, 16, F.lane); continue; } r -= I_UKV;
        if (r < 2 * I_C1) { const int i = r / I_C1; transpose_item<0>(a.in[11] + (size_t)(l * 2 + i) * 2048 * 128, 2048, 128, (bf16_t*)(wl + WO_C1) + (size_t)i * 128 * 2048, nullptr, 1.f, scr, r % I_C1, 4, F.lane); continue; } r -= 2 * I_C1;
        if (r < 2 * I_C2) { const int i = r / I_C2; transpose_item<0>(a.in[12] + (size_t)(l * 2 + i) * 128 * 64, 128, 64, (bf16_t*)(wl + WO_C2) + (size_t)i * 64 * 128, nullptr, 1.f, scr, r % I_C2, 2, F.lane); continue; } r -= 2 * I_C2;
        { const int g = r / I_PL; transpose_item<0>(a.in[17] + (size_t)(l * 4 + g) * 64 * 64, 64, 64, (bf16_t*)(wl + WO_POOL) + (size_t)g * 64 * 64, nullptr, 1.f, scr, r % I_PL, 2, F.lane); }
    }
    {
        const float* x = a.in[0]; bf16_t* hb = (bf16_t*)(F.ws + WS_HB); float* ss = (float*)(F.ws + WS_SS);
        for (int m = gw; m < MTOK; m += NGW) {
            const f32x4* xr = (const f32x4*)(x + (size_t)m * DMODEL) + F.lane; u32x2* hr = (u32x2*)(hb + (size_t)m * DMODEL) + F.lane; float s = 0.f;
#pragma unroll
            for (int j = 0; j < 4; ++j) { const f32x4 v = xr[64 * j]; s += (v[0] * v[0] + v[1] * v[1]) + (v[2] * v[2] + v[3] * v[3]); u32x2 w; w.x = cvt_pk_bf16(v[0], v[1]); w.y = cvt_pk_bf16(v[2], v[3]); hr[64 * j] = w; }
            s = wave_sum(s);
            if (F.lane < 16) ss[(size_t)m * 16 + F.lane] = (F.lane == 0) ? s : 0.f;
        }
    }
    {
        float* rope = (float*)(F.ws + WS_ROPE);
        for (int idx = F.bid * 512 + F.tid; idx < SEQ * 16; idx += F.G * 512) {
            const int pos = idx >> 4, f = idx & 15;
            const float inv_freq = powf(10000.0f, -(float)(2 * f) / 32.0f);
            const float ang = (float)pos * inv_freq;
            const double ad = (double)ang; const double kq = rint(ad * 0.15915494309189535);
            const float rr = (float)(ad - kq * 6.283185307179586);
            rope[pos * 32 + f] = cosf(rr); rope[pos * 32 + 16 + f] = sinf(rr);
        }
    }
    if (F.bid < 64) {
        const int li = F.bid >> 4, kc = F.bid & 15; const float* pos = a.in[10] + (size_t)li * 2048; const float* w1 = a.in[11] + (size_t)li * 2048 * 128;
        const int n = F.tid & 127, kq = F.tid >> 7; float s = 0.f;
#pragma unroll 8
        for (int k = kc * 128 + kq * 32; k < kc * 128 + kq * 32 + 32; ++k) s += pos[k] * w1[(size_t)k * 128 + n];
        LAS float* red = (LAS float*)(F.lds + 8 * 16384);
        red[F.tid] = s; __syncthreads();
        if (F.tid < 128) ((float*)(F.ws + WS_CB1))[(li * 16 + kc) * 128 + F.tid] = (red[F.tid] + red[128 + F.tid]) + (red[256 + F.tid] + red[384 + F.tid]);
        __syncthreads();
    }
    if (F.bid == 4) { bf16_t* kc = (bf16_t*)(F.ws + WS_KC); for (int i = F.tid; i < 8 * 64; i += 512) kc[((size_t)(i >> 6) * 512 + 511) * 64 + (i & 63)] = 0; }
}
constexpr int ASTR = 528;
constexpr int ASTR2 = 272;

__device__ __forceinline__ void conv_tile(Frame& F, int l, int tile) {
    const int T0 = tile * 64, tb = T0 & (SEQ - 1);
    const bf16_t* U = (const bf16_t*)(F.ws + WS_U); bf16_t* CAT = (bf16_t*)(F.ws + WS_CAT);
    LAS bf16_t* glu = (LAS bf16_t*)F.lds;
    LAS float* cv = (LAS float*)(F.lds + 49152);
    LAS unsigned char* At = F.lds;
    for (int p = F.tid; p < 94 * 32; p += 512) {
        const int r = p >> 5, c8 = (p & 31) * 8; u32x4 o = {0u, 0u, 0u, 0u};
        if (tb - 30 + r >= 0) {
            const bf16_t* up = U + (size_t)(T0 - 30 + r) * NU + c8;
            const u32x4 av = *(const u32x4*)(up + UC_A), gv = *(const u32x4*)(up + UC_G);
#pragma unroll
            for (int e = 0; e < 4; ++e) {
                const float a0 = __uint_as_float(av[e] << 16), a1 = __uint_as_float(av[e] & 0xffff0000u), g0 = __uint_as_float(gv[e] << 16), g1 = __uint_as_float(gv[e] & 0xffff0000u);
                o[e] = cvt_pk_bf16(a0 * sigmoidf_(g0), a1 * sigmoidf_(g1)); }
        }
        *(LAS u32x4*)(glu + r * 256 + c8) = o;
    }
    __syncthreads();
    {
        const int c = F.tid & 255, half = F.tid >> 8; float w[31];
        const float* dw = IN(F, 5) + (size_t)l * 31 * 256 + c;
#pragma unroll
        for (int k = 0; k < 31; ++k) w[k] = dw[k * 256];
        const float bias = IN(F, 6)[l * 256 + c];
#pragma unroll 1
        for (int i = 0; i < 32; ++i) {
            const LAS bf16_t* gp = glu + (32 * half + i) * 256 + c; float acc = bias;
#pragma unroll
            for (int k = 0; k < 31; ++k) acc += w[k] * bf2f(gp[k * 256]);
            cv[(32 * half + i) * 256 + c] = acc;
        }
    }
    __syncthreads();
    {
        const f32x4 g4 = *((const f32x4*)(IN(F, 7) + l * 256) + F.lane), b4 = *((const f32x4*)(IN(F, 8) + l * 256) + F.lane);
        for (int tt = 0; tt < 8; ++tt) {
            const int row = 8 * F.wave + tt; const f32x4 x = *((const LAS f32x4*)(cv + row * 256) + F.lane);
            const float mean = wave_sum((x[0] + x[1]) + (x[2] + x[3])) * (1.f / 256.f); const f32x4 d = x - mean;
            const float var = wave_sum((d[0] * d[0] + d[1] * d[1]) + (d[2] * d[2] + d[3] * d[3])) * (1.f / 256.f); const float rstd = 1.0f / sqrtf(var + EPS);
            f32x4 y = d * rstd * g4 + b4;
#pragma unroll
            for (int e = 0; e < 4; ++e) y[e] = y[e] * sigmoidf_(y[e]);
            u32x2 wv; wv.x = cvt_pk_bf16(y[0], y[1]); wv.y = cvt_pk_bf16(y[2], y[3]);
            *(LAS u32x2*)(At + row * ASTR + F.lane * 8) = wv;
        }
    }
    __syncthreads();
    {
        const bf16_t* pwT = (const bf16_t*)(F.ws + WS_W + (size_t)l * W_LAYER + WO_PW); const int r32 = F.lane & 31, hi = F.lane >> 5;
        for (int j = 0; j < 2; ++j) {
            const int task = F.wave + 8 * j, rb = task & 1, cb = task >> 1;
            const f32x16 acc = small_mm<256>(At + rb * 32 * ASTR, ASTR, pwT + (size_t)cb * 32 * 256, F.lane);
#pragma unroll
            for (int r = 0; r < 16; ++r) CAT[(size_t)(T0 + rb * 32 + crow(r, hi)) * DMODEL + CC_CONV + cb * 32 + r32] = f2bf(acc[r]);
        }
    }
    __syncthreads();
}

__device__ __forceinline__ void pool_tile(Frame& F, int l, int tile) {
    const int T0 = tile * 64, tb = T0 & (SEQ - 1);
    const bf16_t* U = (const bf16_t*)(F.ws + WS_U); bf16_t* CAT = (bf16_t*)(F.ws + WS_CAT);
    LAS float* P = (LAS float*)F.lds;
    LAS unsigned char* At = F.lds + 81920;
    for (int p = F.tid; p < 79 * 32; p += 512) {
        const int r = p >> 5, c8 = (p & 31) * 8; f32x4 lo = {0.f, 0.f, 0.f, 0.f}, hi4 = lo;
        if (tb - 15 + r >= 0) { const u32x4 v = *(const u32x4*)(U + (size_t)(T0 - 15 + r) * NU + UC_POOL + c8);
            lo = (f32x4){__uint_as_float(v[0] << 16), __uint_as_float(v[0] & 0xffff0000u), __uint_as_float(v[1] << 16), __uint_as_float(v[1] & 0xffff0000u)};
            hi4 = (f32x4){__uint_as_float(v[2] << 16), __uint_as_float(v[2] & 0xffff0000u), __uint_as_float(v[3] << 16), __uint_as_float(v[3] & 0xffff0000u)}; }
        *(LAS f32x4*)(P + r * 256 + c8) = lo; *(LAS f32x4*)(P + r * 256 + c8 + 4) = hi4;
    }
    __syncthreads();
    {
        const int c = F.tid & 255, half = F.tid >> 8, w = 2 << (c >> 6);
        for (int i = 0; i < 32; ++i) {
            const int row = 32 * half + i, tpos = tb + row; const int cnt = (tpos + 1 < w) ? tpos + 1 : w; float s = 0.f;
            for (int j = 0; j < w; ++j) s += P[(15 + row - j) * 256 + c];
            const float d = s / (float)cnt - P[(15 + row) * 256 + c];
            *(LAS bf16_t*)(At + row * ASTR + c * 2) = f2bf(d);
        }
    }
    __syncthreads();
    {
        const bf16_t* plT = (const bf16_t*)(F.ws + WS_W + (size_t)l * W_LAYER + WO_POOL); const int r32 = F.lane & 31, hi = F.lane >> 5;
        for (int j = 0; j < 2; ++j) {
            const int task = F.wave + 8 * j, rb = task & 1, g = (task >> 1) & 3, cbl = task >> 3;
            const f32x16 acc = small_mm<64>(At + rb * 32 * ASTR + g * 128, ASTR, plT + (size_t)g * 4096 + (size_t)cbl * 32 * 64, F.lane);
            const int col = g * 64 + cbl * 32 + r32; const float sc = IN(F, 18)[l * 256 + col];
#pragma unroll
            for (int r = 0; r < 16; ++r) CAT[(size_t)(T0 + rb * 32 + crow(r, hi)) * DMODEL + CC_POOL + col] = f2bf(acc[r] * sc);
        }
    }
    __syncthreads();
}

__device__ __forceinline__ void mla_tile(Frame& F, int l, int tile) {
    const int T0 = tile * 64, tb = T0 & (SEQ - 1), b = T0 >> 13;
    const bf16_t* U = (const bf16_t*)(F.ws + WS_U); const float* rope = (const float*)(F.ws + WS_ROPE);
    bf16_t* QM = (bf16_t*)(F.ws + WS_QM); bf16_t* KM = (bf16_t*)(F.ws + WS_KM); bf16_t* VM = (bf16_t*)(F.ws + WS_VM);
    LAS unsigned char* Aq = F.lds; LAS unsigned char* Akv = F.lds + 33792;
    for (int tt = 0; tt < 8; ++tt) {
        const int row = 8 * F.wave + tt; const bf16_t* up = U + (size_t)(T0 + row) * NU;
        { const u32x2 v = *((const u32x2*)(up + UC_CQ) + F.lane);
          const float x0 = __uint_as_float(v.x << 16), x1 = __uint_as_float(v.x & 0xffff0000u), x2 = __uint_as_float(v.y << 16), x3 = __uint_as_float(v.y & 0xffff0000u);
          const float rs = 1.0f / sqrtf(wave_sum((x0 * x0 + x1 * x1) + (x2 * x2 + x3 * x3)) * (1.f / 256.f) + EPS);
          u32x2 w; w.x = cvt_pk_bf16(x0 * rs, x1 * rs); w.y = cvt_pk_bf16(x2 * rs, x3 * rs); *(LAS u32x2*)(Aq + row * ASTR + F.lane * 8) = w; }
        { const unsigned v = *((const unsigned*)(up + UC_CKV) + F.lane);
          const float x0 = __uint_as_float(v << 16), x1 = __uint_as_float(v & 0xffff0000u);
          const float rs = 1.0f / sqrtf(wave_sum(x0 * x0 + x1 * x1) * (1.f / 128.f) + EPS);
          *(LAS unsigned*)(Akv + row * ASTR2 + F.lane * 4) = cvt_pk_bf16(x0 * rs, x1 * rs); }
    }
    for (int j = 0; j < 2; ++j) {
        const int idx = F.tid + 512 * j, tok = idx >> 4, i = idx & 15, pos = tb + tok; const bf16_t* up = U + (size_t)(T0 + tok) * NU + UC_KR;
        const float x1 = bf2f(up[i]), x2 = bf2f(up[16 + i]), cs = rope[pos * 32 + i], sn = rope[pos * 32 + 16 + i];
        const unsigned short o1 = f2bf(x1 * cs - x2 * sn), o2 = f2bf(x1 * sn + x2 * cs);
#pragma unroll
        for (int h = 0; h < 4; ++h) { bf16_t* kp = KM + ((size_t)(b * 4 + h) * SEQ + pos) * 96 + 64; kp[i] = o1; kp[16 + i] = o2; }
    }
    __syncthreads();
    const int r32 = F.lane & 31, hi = F.lane >> 5;
    {
        const bf16_t* uqT = (const bf16_t*)(F.ws + WS_W + (size_t)l * W_LAYER + WO_UQ);
        for (int j = 0; j < 3; ++j) {
            const int task = F.wave + 8 * j, rb = task & 1, cb = task >> 1, head = cb / 3, part = cb % 3;
            const f32x16 acc = small_mm<256>(Aq + rb * 32 * ASTR, ASTR, uqT + (size_t)cb * 32 * 256, F.lane);
#pragma unroll
            for (int r = 0; r < 16; ++r) {
                const int pos = tb + rb * 32 + crow(r, hi); bf16_t* qp = QM + ((size_t)(b * 4 + head) * SEQ + pos) * 96;
                if (part < 2) qp[part * 32 + r32] = f2bf(acc[r]);
                else { const float other = __shfl_xor(acc[r], 16); const int i = r32 & 15; const float cs = rope[pos * 32 + i], sn = rope[pos * 32 + 16 + i];
                       const float o = (r32 < 16) ? (acc[r] * cs - other * sn) : (other * sn + acc[r] * cs); qp[64 + r32] = f2bf(o); }
            }
        }
    }
    {
        const bf16_t* ukvT = (const bf16_t*)(F.ws + WS_W + (size_t)l * W_LAYER + WO_UKV);
        for (int j = 0; j < 4; ++j) {
            const int task = F.wave + 8 * j, rb = task & 1, cb = task >> 1, head = cb >> 2, part = cb & 3;
            const f32x16 acc = small_mm<128>(Akv + rb * 32 * ASTR2, ASTR2, ukvT + (size_t)cb * 32 * 128, F.lane);
#pragma unroll
            for (int r = 0; r < 16; ++r) {
                const int pos = tb + rb * 32 + crow(r, hi); const size_t rowi = (size_t)(b * 4 + head) * SEQ + pos;
                if (part < 2) KM[rowi * 96 + part * 32 + r32] = f2bf(acc[r]); else VM[rowi * 64 + (part - 2) * 32 + r32] = f2bf(acc[r]);
            }
        }
    }
    __syncthreads();
}

__device__ __forceinline__ void compress_item(Frame& F, int l, int item) {
    const int i = item >> 6, b = (item >> 4) & 3, gq = item & 15, c0 = 32 * gq, tok0 = 16 * c0;
    const bf16_t* U = (const bf16_t*)(F.ws + WS_U); bf16_t* KC = (bf16_t*)(F.ws + WS_KC);
    LAS unsigned char* Tk = F.lds;
    LAS float* part = (LAS float*)(F.lds + 67584);
    LAS unsigned char* A2 = F.lds + 83968;
    for (int p = F.tid; p < 528 * 8; p += 512) {
        const int r = p >> 3, ch = p & 7; u32x4 v = {0u, 0u, 0u, 0u};
        if (tok0 + r < SEQ) v = *(const u32x4*)(U + (size_t)(b * SEQ + tok0 + r) * NU + UC_KV + i * 64 + ch * 8);
        *(LAS u32x4*)(Tk + r * 128 + ((ch ^ ((r >> 4) & 7)) * 16)) = v;
    }
    __syncthreads();
    const int r32 = F.lane & 31, hi = F.lane >> 5, cb = F.wave & 3, kh = F.wave >> 2;
    const unsigned char* wl = F.ws + WS_W + (size_t)l * W_LAYER;
    f32x16 acc = {};
    {
        const bf16_t* bp = (const bf16_t*)(wl + WO_C1) + (size_t)i * 128 * 2048 + (size_t)(cb * 32 + r32) * 2048 + hi * 8;
#pragma unroll 8
        for (int ks = kh * 64; ks < kh * 64 + 64; ++ks) {
            const int ll = ks >> 2, dq = ks & 3, token = 16 * r32 + ll, chunk = dq * 2 + hi;
            const bf16x8 av = *(const LAS bf16x8*)(Tk + token * 128 + ((chunk ^ ((token >> 4) & 7)) * 16));
            const bf16x8 bv = *(const bf16x8*)(bp + ks * 16);
            acc = __builtin_amdgcn_mfma_f32_32x32x16_bf16(av, bv, acc, 0, 0, 0);
        }
    }
    if (kh == 1) {
#pragma unroll
        for (int r = 0; r < 16; ++r) part[cb * 1024 + r * 64 + F.lane] = acc[r];
    }
    __syncthreads();
    if (kh == 0) {
        float bias = 0.f; { const float* cbp = (const float*)(F.ws + WS_CB1) + (size_t)(l * 2 + i) * 16 * 128 + cb * 32 + r32;
#pragma unroll
            for (int kc = 0; kc < 16; ++kc) bias += cbp[kc * 128]; }
#pragma unroll
        for (int r = 0; r < 16; ++r) { float h = acc[r] + part[cb * 1024 + r * 64 + F.lane] + bias; h = h * sigmoidf_(h);
            *(LAS bf16_t*)(A2 + crow(r, hi) * ASTR2 + (cb * 32 + r32) * 2) = f2bf(h); }
    }
    __syncthreads();
    if (F.wave < 2) {
        const f32x16 o = small_mm<128>(A2, ASTR2, (const bf16_t*)(wl + WO_C2) + (size_t)i * 64 * 128 + (size_t)F.wave * 32 * 128, F.lane);
#pragma unroll
        for (int r = 0; r < 16; ++r) { const int row = c0 + crow(r, hi); KC[((size_t)(i * 4 + b) * 512 + row) * 64 + F.wave * 32 + r32] = (row < 511) ? f2bf(o[r]) : (bf16_t)0; }
    }
    __syncthreads();
}

__device__ __forceinline__ void phaseB(Frame F, int l) {
    LAUNDER(F);
#ifndef SKIP_B1
    for (int t = F.bid; t < MTOK / 64; t += F.G) conv_tile(F, l, t);
#endif
#ifndef SKIP_B2
    for (int t = F.bid; t < MTOK / 64; t += F.G) pool_tile(F, l, t);
#endif
#ifndef SKIP_B3
    for (int t = F.bid; t < MTOK / 64; t += F.G) mla_tile(F, l, t);
#endif
#ifndef SKIP_B4
    for (int t = F.G - 1 - F.bid; t < 128; t += F.G) compress_item(F, l, t);
#endif
}
namespace att {
constexpr int SLOTB = 20480, VOFF = 12288;
constexpr int L_RING = 0, L_WS = 4 * SLOTB, L_BT = L_WS + 2048, L_SEL = L_BT + 2304, L_GATE = L_SEL + 1024, L_OACC = L_GATE + 3072, L_IMP = L_OACC, L_END = L_OACC + 65536;
static_assert(L_END <= LDS_CTL, "attention LDS");
constexpr float NEG_INF = -__builtin_inff();

struct TileSrc { const bf16_t* K; int kpitch; const bf16_t* V; int vpitch; };

struct DmaPtr { const bf16_t* k; const bf16_t* v; };
template <int DQK> __device__ __forceinline__ DmaPtr dma_init(const TileSrc& T, int kv0, int wid, int lane) {
    DmaPtr p; p.k = T.K + (size_t)(kv0 + lane) * T.kpitch + wid * 8;
    p.v = T.V + (size_t)(kv0 + 16 * (wid & 3) + (lane >> 2)) * T.vpitch + (wid >> 2) * 32 + (lane & 3) * 8; return p;
}
template <int DQK> __device__ __forceinline__ void dma_tile(DmaPtr& p, const TileSrc& T, LAS unsigned char* slot, int wid) {
    __builtin_amdgcn_global_load_lds((const unsigned*)p.k, (LAS unsigned*)(slot + wid * 1024), 16, 0, 0);
    if (DQK == 96) { if (wid < 4) __builtin_amdgcn_global_load_lds((const unsigned*)(p.k + 64), (LAS unsigned*)(slot + (wid + 8) * 1024), 16, 0, 0); }
    __builtin_amdgcn_global_load_lds((const unsigned*)p.v, (LAS unsigned*)(slot + VOFF + wid * 1024), 16, 0, 0);
    p.k += (size_t)64 * T.kpitch; p.v += (size_t)64 * T.vpitch;
}
#define ATT_VMWAIT(n) asm volatile("s_waitcnt vmcnt(" #n ")" ::: "memory")
__device__ __forceinline__ void wait_tiles(int rem, bool three) {
    if (three) { if (rem == 0) ATT_VMWAIT(0); else if (rem == 1) ATT_VMWAIT(3); else ATT_VMWAIT(6); }
    else       { if (rem == 0) ATT_VMWAIT(0); else if (rem == 1) ATT_VMWAIT(2); else ATT_VMWAIT(4); }
}
template <int DQK, class Body> __device__ __forceinline__ void tile_loop(const TileSrc& T, int NT, int kv_first, Body body, LAS unsigned char* ring, int wid, int lane) {
    const bool three = (DQK == 96) && (wid < 4);
    DmaPtr dp = dma_init<DQK>(T, kv_first, wid, lane);
    for (int i = 0; i < 3; ++i) if (i < NT) dma_tile<DQK>(dp, T, ring + i * SLOTB, wid);
    for (int i = 0; i < NT; ++i) {
        const int rem = (NT - 1 - i) < 2 ? (NT - 1 - i) : 2;
        wait_tiles(rem, three);
        __builtin_amdgcn_s_barrier();
        if (i + 3 < NT) dma_tile<DQK>(dp, T, ring + ((i + 3) & 3) * SLOTB, wid);
        body(i, ring + (i & 3) * SLOTB);
    }
    asm volatile("s_waitcnt lgkmcnt(0)" ::: "memory");
    __builtin_amdgcn_s_barrier();
}

template <int DQK> __device__ __forceinline__ void qk(f32x16& p0, f32x16& p1, const LAS unsigned char* kslot, const bf16x8* qf, float cinit, int r32, int hi) {
#pragma unroll
    for (int r = 0; r < 16; ++r) { p0[r] = cinit; p1[r] = cinit; }
    const LAS unsigned char* kb = kslot + hi * 1024 + r32 * 16;
    bf16x8 kf[DQK / 8];
#pragma unroll
    for (int d0 = 0; d0 < DQK / 16; ++d0) { kf[2 * d0] = *(const LAS bf16x8*)(kb + d0 * 2048); kf[2 * d0 + 1] = *(const LAS bf16x8*)(kb + d0 * 2048 + 512); }
    __builtin_amdgcn_sched_barrier(0);
#pragma unroll
    for (int d0 = 0; d0 < DQK / 16; ++d0) {
        p0 = __builtin_amdgcn_mfma_f32_32x32x16_bf16(kf[2 * d0], qf[d0], p0, 0, 0, 0);
        p1 = __builtin_amdgcn_mfma_f32_32x32x16_bf16(kf[2 * d0 + 1], qf[d0], p1, 0, 0, 0);
    }
}
template <int DQK> __device__ __forceinline__ void qk_c(f32x16& p0, f32x16& p1, const LAS unsigned char* kslot, const bf16x8* qf, const f32x16& c, int r32, int hi) {
    const LAS unsigned char* kb = kslot + hi * 1024 + r32 * 16;
    bf16x8 kf[DQK / 8];
#pragma unroll
    for (int d0 = 0; d0 < DQK / 16; ++d0) { kf[2 * d0] = *(const LAS bf16x8*)(kb + d0 * 2048); kf[2 * d0 + 1] = *(const LAS bf16x8*)(kb + d0 * 2048 + 512); }
    __builtin_amdgcn_sched_barrier(0);
    p0 = __builtin_amdgcn_mfma_f32_32x32x16_bf16(kf[0], qf[0], c, 0, 0, 0);
    p1 = __builtin_amdgcn_mfma_f32_32x32x16_bf16(kf[1], qf[0], c, 0, 0, 0);
#pragma unroll
    for (int d0 = 1; d0 < DQK / 16; ++d0) {
        p0 = __builtin_amdgcn_mfma_f32_32x32x16_bf16(kf[2 * d0], qf[d0], p0, 0, 0, 0);
        p1 = __builtin_amdgcn_mfma_f32_32x32x16_bf16(kf[2 * d0 + 1], qf[d0], p1, 0, 0, 0);
    }
}
__device__ __forceinline__ float max3f(float a, float b, float c) { float r; asm("v_max3_f32 %0, %1, %2, %3" : "=v"(r) : "v"(a), "v"(b), "v"(c)); return r; }
__device__ __forceinline__ float half_swap_max(float v) { auto rr = __builtin_amdgcn_permlane32_swap(__float_as_uint(v), __float_as_uint(v), false, false); return fmaxf(__uint_as_float(rr[0]), __uint_as_float(rr[1])); }
__device__ __forceinline__ float half_swap_sum(float v) { auto rr = __builtin_amdgcn_permlane32_swap(__float_as_uint(v), __float_as_uint(v), false, false); return __uint_as_float(rr[0]) + __uint_as_float(rr[1]); }
__device__ __forceinline__ float rowmax(const f32x16& p0, const f32x16& p1) {
    float a = max3f(p0[0], p1[0], p0[1]), b = max3f(p1[1], p0[2], p1[2]);
#pragma unroll
    for (int r = 3; r < 15; r += 2) { a = max3f(a, p0[r], p1[r]); b = max3f(b, p0[r + 1], p1[r + 1]); }
    a = max3f(a, p0[15], p1[15]);
    return half_swap_max(fmaxf(a, b));
}
__device__ __forceinline__ void pv(f32x16 (&o)[2], const f32x16& p0, const f32x16& p1, const LAS unsigned char* vslot, int lane) {
    u32x4 pw[4];
#pragma unroll
    for (int e = 0; e < 4; ++e) { pw[0][e] = cvt_pk_bf16(p0[2 * e], p0[2 * e + 1]); pw[1][e] = cvt_pk_bf16(p0[8 + 2 * e], p0[9 + 2 * e]);
                                  pw[2][e] = cvt_pk_bf16(p1[2 * e], p1[2 * e + 1]); pw[3][e] = cvt_pk_bf16(p1[8 + 2 * e], p1[9 + 2 * e]); }
    const int hi = lane >> 5;
    const unsigned vb = (unsigned)(size_t)vslot + ((lane >> 4) & 1) * 32 + (lane & 3) * 8 + (4 * hi + ((lane & 15) >> 2)) * 64;
#pragma unroll
    for (int d0 = 0; d0 < 2; ++d0) {
        s16x4 lo[4], hh[4];
#pragma unroll
        for (int ks = 0; ks < 4; ++ks) {
            asm volatile("ds_read_b64_tr_b16 %0, %1 offset:%c2" : "=&v"(lo[ks]) : "v"(vb), "i"(d0 * 4096 + ks * 1024) : "memory");
            asm volatile("ds_read_b64_tr_b16 %0, %1 offset:%c2" : "=&v"(hh[ks]) : "v"(vb), "i"(d0 * 4096 + ks * 1024 + 512) : "memory");
        }
        asm volatile("s_waitcnt lgkmcnt(0)" ::: "memory"); __builtin_amdgcn_sched_barrier(0);
#pragma unroll
        for (int ks = 0; ks < 4; ++ks) {
            const bf16x8 vf = (bf16x8){lo[ks][0], lo[ks][1], lo[ks][2], lo[ks][3], hh[ks][0], hh[ks][1], hh[ks][2], hh[ks][3]};
            o[d0] = __builtin_amdgcn_mfma_f32_32x32x16_bf16(__builtin_bit_cast(bf16x8, pw[ks]), vf, o[d0], 0, 0, 0);
        }
    }
}
__device__ __forceinline__ void softmax_pv(f32x16& p0, f32x16& p1, float& m, float& l, f32x16 (&o)[2], const LAS unsigned char* vslot, LAS float* wsf, int lane) {
    const int r32 = lane & 31, hi = lane >> 5;
    const float rm = rowmax(p0, p1), mn = fmaxf(m, rm), ms = (mn == NEG_INF) ? 0.f : mn;
    const float alpha = __builtin_amdgcn_exp2f(m - ms);
    const bool need = __any(mn > m) != 0;
    m = mn;
    float sum = 0.f;
#pragma unroll
    for (int r = 0; r < 16; ++r) { p0[r] = __builtin_amdgcn_exp2f(p0[r] - ms); p1[r] = __builtin_amdgcn_exp2f(p1[r] - ms); sum += p0[r] + p1[r]; }
    l = l * alpha + sum;
    if (need) {
        if (hi == 0) wsf[r32] = alpha;
        __builtin_amdgcn_fence(__ATOMIC_RELEASE, "wavefront"); __builtin_amdgcn_wave_barrier();
#pragma unroll
        for (int r = 0; r < 16; ++r) { const float f = wsf[crow(r, hi)]; o[0][r] *= f; o[1][r] *= f; }
    }
    pv(o, p0, p1, vslot, lane);
}
struct SmState { float mref, l; f32x16 negm; bool started; };
__device__ __forceinline__ void sm_init(SmState& s, float c) { s.mref = 0.f; s.l = 0.f; s.started = false;
#pragma unroll
    for (int r = 0; r < 16; ++r) s.negm[r] = c;
    asm volatile("" : "+v"(s.negm)); }
__device__ __forceinline__ void softmax_pv2(f32x16& p0, f32x16& p1, SmState& s, f32x16 (&o)[2], const LAS unsigned char* vslot, LAS float* wsf, int lane) {
    const int r32 = lane & 31, hi = lane >> 5;
    const float rm = rowmax(p0, p1);
    if (!s.started) {
        const float d = (rm == NEG_INF) ? 0.f : rm; s.mref = d; s.started = true;
#pragma unroll
        for (int r = 0; r < 16; ++r) { p0[r] -= d; p1[r] -= d; s.negm[r] -= d; }
    } else if (__any(rm > 8.0f)) {
        const float d = fmaxf(rm, 0.f), alpha = __builtin_amdgcn_exp2f(-d); s.mref += d; s.l *= alpha;
#pragma unroll
        for (int r = 0; r < 16; ++r) { p0[r] -= d; p1[r] -= d; s.negm[r] -= d; }
        if (hi == 0) wsf[r32] = alpha;
        __builtin_amdgcn_fence(__ATOMIC_RELEASE, "wavefront"); __builtin_amdgcn_wave_barrier();
#pragma unroll
        for (int r = 0; r < 16; ++r) { const float f = wsf[crow(r, hi)]; o[0][r] *= f; o[1][r] *= f; }
    }
    float sum = 0.f;
#pragma unroll
    for (int r = 0; r < 16; ++r) { p0[r] = __builtin_amdgcn_exp2f(p0[r]); p1[r] = __builtin_amdgcn_exp2f(p1[r]); sum += p0[r] + p1[r]; }
    s.l += sum;
    pv(o, p0, p1, vslot, lane);
}
__device__ __forceinline__ void scaled_add(LAS float* oacc, const f32x16 (&o)[2], float f, LAS float* wsf, int lane, bool assign) {
    const int r32 = lane & 31, hi = lane >> 5;
    if (hi == 0) wsf[32 + r32] = f;
    __builtin_amdgcn_fence(__ATOMIC_RELEASE, "wavefront"); __builtin_amdgcn_wave_barrier();
#pragma unroll
    for (int r = 0; r < 16; ++r) { const float g = wsf[32 + crow(r, hi)];
        if (assign) { oacc[r * 64 + lane] = o[0][r] * g; oacc[(16 + r) * 64 + lane] = o[1][r] * g; } else { oacc[r * 64 + lane] += o[0][r] * g; oacc[(16 + r) * 64 + lane] += o[1][r] * g; } }
}
__device__ __forceinline__ void store_oacc(const LAS float* oacc, bf16_t* dst, int pitch, int lane) {
    const int r32 = lane & 31, hi = lane >> 5;
#pragma unroll
    for (int r = 0; r < 16; ++r) { bf16_t* rp = dst + (size_t)crow(r, hi) * pitch; rp[r32] = f2bf(oacc[r * 64 + lane]); rp[32 + r32] = f2bf(oacc[(16 + r) * 64 + lane]); }
}

__device__ __forceinline__ void mla_unit(Frame F, int b, int h, int qb) {
    LAUNDER(F);
    LAS unsigned char* lds = F.lds; LAS float* wsf = (LAS float*)(lds + L_WS) + F.wave * 64;
    const int wid = F.wave, lane = F.lane, r32 = lane & 31, hi = lane >> 5;
    const size_t hrow = (size_t)(b * 4 + h) * SEQ;
    const bf16_t* QM = (const bf16_t*)(F.ws + WS_QM) + hrow * 96;
    TileSrc T; T.K = (const bf16_t*)(F.ws + WS_KM) + hrow * 96; T.kpitch = 96; T.V = (const bf16_t*)(F.ws + WS_VM) + hrow * 64; T.vpitch = 64;
    const int q0 = qb * 256, qw0 = q0 + 32 * wid, qrow = qw0 + r32;
    bf16x8 qf[6];
#pragma unroll
    for (int d0 = 0; d0 < 6; ++d0) qf[d0] = *(const bf16x8*)(QM + (size_t)qrow * 96 + d0 * 16 + hi * 8);
    SmState sm; sm_init(sm, 0.f); f32x16 o[2]; o[0] = f32x16{}; o[1] = f32x16{};
    const int NT = (q0 + 256) / 64;
    tile_loop<96>(T, NT, 0, [&](int t, const LAS unsigned char* slot) {
        const int kv0 = 64 * t;
        if (kv0 <= qw0 + 31) {
            f32x16 p0, p1; qk_c<96>(p0, p1, slot, qf, sm.negm, r32, hi);
            if (kv0 + 63 > qw0) {
#pragma unroll
                for (int r = 0; r < 16; ++r) { const int kv = kv0 + crow(r, hi); if (kv > qrow) p0[r] = NEG_INF; if (kv + 32 > qrow) p1[r] = NEG_INF; }
            }
            softmax_pv2(p0, p1, sm, o, slot + VOFF, wsf, lane);
        }
    }, lds + L_RING, wid, lane);
    const float lt = half_swap_sum(sm.l); const float inv = lt > 0.f ? 1.0f / lt : 0.f;
    LAS float* oacc = (LAS float*)(lds + L_OACC) + F.wave * 2048;
    scaled_add(oacc, o, inv, wsf, lane, true);
    store_oacc(oacc, (bf16_t*)(F.ws + WS_CAT) + (size_t)(b * SEQ + qw0) * DMODEL + CC_MLA + h * 64, DMODEL, lane);
}

__device__ __forceinline__ void nsa_unit(Frame F, int b, int qt) {
    LAUNDER(F);
    LAS unsigned char* lds = F.lds; LAS float* wsf = (LAS float*)(lds + L_WS) + F.wave * 64;
    LAS float* bt = (LAS float*)(lds + L_BT); LAS float* imp = (LAS float*)(lds + L_IMP); LAS unsigned* sel = (LAS unsigned*)(lds + L_SEL); LAS float* gate = (LAS float*)(lds + L_GATE);
    LAS float* outacc = (LAS float*)(lds + L_OACC) + F.wave * 2048;
    const int wid = F.wave, lane = F.lane, tid = F.tid, r32 = lane & 31, hi = lane >> 5, h = wid & 3, qh = wid >> 2;
    const int t0 = 64 * qt, qi = 32 * qh + r32, t = t0 + qi;
    const bf16_t* U = (const bf16_t*)(F.ws + WS_U) + (size_t)b * SEQ * NU;
    bf16x8 qf[4];
#pragma unroll
    for (int d0 = 0; d0 < 4; ++d0) qf[d0] = *(const bf16x8*)(U + (size_t)t * NU + UC_Q + h * 64 + d0 * 16 + hi * 8);
    __syncthreads();
    for (int idx = tid; idx < 64 * 12; idx += 512) { const int q = idx / 12, k = idx - q * 12; gate[idx] = sigmoidf_(bf2f(U[(size_t)(t0 + q) * NU + UC_GATE + k])); }
    for (int idx = tid; idx < 64 * 128; idx += 512) imp[idx] = 0.f;
    __syncthreads();
    const LAS float* bth = bt + h * 132;
    {
        const bf16_t* KC = (const bf16_t*)(F.ws + WS_KC);
        TileSrc T; T.K = KC + (size_t)(0 * 4 + b) * 512 * 64; T.kpitch = 64; T.V = KC + (size_t)(1 * 4 + b) * 512 * 64; T.vpitch = 64;
        const int NTc = (((t0 + 32) >> 4) >> 6) + 1;
        float m = NEG_INF, l = 0.f;
        tile_loop<64>(T, NTc, 0, [&](int ct, const LAS unsigned char* slot) {
            f32x16 p0, p1; qk<64>(p0, p1, slot, qf, 0.f, r32, hi);
#pragma unroll
            for (int r = 0; r < 16; ++r) { const int c = 64 * ct + crow(r, hi); const int d0 = t - (16 * c + 31), d1 = d0 - 512;
                p0[r] = (d0 >= 0) ? p0[r] + bth[d0 < 128 ? d0 : 128] : NEG_INF; p1[r] = (d1 >= 0) ? p1[r] + bth[d1 < 128 ? d1 : 128] : NEG_INF; }
            const float rm = rowmax(p0, p1), mn = fmaxf(m, rm), ms = (mn == NEG_INF) ? 0.f : mn; const float alpha = __builtin_amdgcn_exp2f(m - ms); m = mn; float sum = 0.f;
#pragma unroll
            for (int r = 0; r < 16; ++r) sum += __builtin_amdgcn_exp2f(p0[r] - ms) + __builtin_amdgcn_exp2f(p1[r] - ms);
            l = l * alpha + sum;
        }, lds + L_RING, wid, lane);
        const float lt = half_swap_sum(l), inv = lt > 0.f ? 1.0f / lt : 0.f, ms = (m == NEG_INF) ? 0.f : m;
        f32x16 o[2]; o[0] = f32x16{}; o[1] = f32x16{};
        tile_loop<64>(T, NTc, 0, [&](int ct, const LAS unsigned char* slot) {
            f32x16 p0, p1; qk<64>(p0, p1, slot, qf, 0.f, r32, hi);
#pragma unroll
            for (int r = 0; r < 16; ++r) { const int c = 64 * ct + crow(r, hi); const int d0 = t - (16 * c + 31), d1 = d0 - 512;
                p0[r] = (d0 >= 0) ? __builtin_amdgcn_exp2f(p0[r] + bth[d0 < 128 ? d0 : 128] - ms) * inv : 0.f;
                p1[r] = (d1 >= 0) ? __builtin_amdgcn_exp2f(p1[r] + bth[d1 < 128 ? d1 : 128] - ms) * inv : 0.f; }
            const int jb = 16 * ct + hi; LAS float* ip = imp + jb * 64 + qi;
#pragma unroll
            for (int g = 0; g < 4; ++g) {
                const float a0 = (p0[4 * g] + p0[4 * g + 1]) + (p0[4 * g + 2] + 0.5f * p0[4 * g + 3]), b0 = 0.5f * p0[4 * g + 3];
                const float a1 = (p1[4 * g] + p1[4 * g + 1]) + (p1[4 * g + 2] + 0.5f * p1[4 * g + 3]), b1 = 0.5f * p1[4 * g + 3];
                const int j0 = 2 * g, j1 = 8 + 2 * g;
                atomicAdd((float*)(ip + j0 * 64), a0); atomicAdd((float*)(ip + j1 * 64), a1);
                if (jb + j0 + 1 < 128) atomicAdd((float*)(ip + (j0 + 1) * 64), b0);
                if (jb + j1 + 1 < 128) atomicAdd((float*)(ip + (j1 + 1) * 64), b1);
            }
            pv(o, p0, p1, slot + VOFF, lane);
        }, lds + L_RING, wid, lane);
        {
            const int jc = qt;
            for (int qq = 0; qq < 8; ++qq) {
                const int q = 8 * wid + qq; unsigned long long m0, m1;
                if (jc + 1 <= 16) { m0 = (1ull << (jc + 1)) - 1ull; m1 = 0ull; }
                else {
                    const int ja = lane, jb2 = lane + 64;
                    const float v0 = imp[ja * 64 + q], v1 = imp[jb2 * 64 + q];
                    const bool c0 = (ja >= 1 && ja <= jc - 2), c1 = (jb2 <= jc - 2);
                    const unsigned u0 = c0 ? (__float_as_uint(v0) + 1u) : 0u, u1 = c1 ? (__float_as_uint(v1) + 1u) : 0u;
                    unsigned thr = 0u;
                    for (int bit = 31; bit >= 0; --bit) { const unsigned tr = thr | (1u << bit);
                        const int cnt = __popcll(__ballot(u0 >= tr)) + __popcll(__ballot(u1 >= tr)); if (cnt >= 13) thr = tr; }
                    const unsigned long long g0 = __ballot(u0 > thr), g1 = __ballot(u1 > thr), e0 = __ballot(u0 == thr), e1 = __ballot(u1 == thr);
                    const int need = 13 - (__popcll(g0) + __popcll(g1));
                    const unsigned long long lt_mask = (1ull << lane) - 1ull;
                    const int rk0 = __popcll(e0 & lt_mask), rk1 = __popcll(e0) + __popcll(e1 & lt_mask);
                    const bool s0 = (u0 > thr) || (u0 == thr && rk0 < need) || ja == 0 || ja == jc || ja == jc - 1;
                    const bool s1 = (u1 > thr) || (u1 == thr && rk1 < need) || jb2 == jc || jb2 == jc - 1;
                    m0 = __ballot(s0); m1 = __ballot(s1);
                }
                if (lane == 0) { sel[q * 4 + 0] = (unsigned)m0; sel[q * 4 + 1] = (unsigned)(m0 >> 32); sel[q * 4 + 2] = (unsigned)m1; sel[q * 4 + 3] = (unsigned)(m1 >> 32); }
            }
        }
        __syncthreads();
        scaled_add(outacc, o, gate[qi * 12 + h * 3 + 0], wsf, lane, true);
    }
    {
        TileSrc T; T.K = U + UC_KV + 128; T.kpitch = NU; T.V = U + UC_KV + 192; T.vpitch = NU;
        const int NT = qt + 1; const float cfar = bth[128];
        SmState sm; sm_init(sm, cfar); f32x16 o[2]; o[0] = f32x16{}; o[1] = f32x16{};
        tile_loop<64>(T, NT, 0, [&](int jt, const LAS unsigned char* slot) {
            const bool selb = ((sel[qi * 4 + (jt >> 5)] >> (jt & 31)) & 1u) != 0u;
            if (__any(selb)) {
                f32x16 p0, p1; qk_c<64>(p0, p1, slot, qf, sm.negm, r32, hi);
                if (jt >= qt - 2) {
#pragma unroll
                    for (int r = 0; r < 16; ++r) { const int d0 = t - (64 * jt + crow(r, hi)), d1 = d0 - 32;
                        p0[r] = (selb && d0 >= 0) ? p0[r] + (bth[d0 < 128 ? d0 : 128] - cfar) : NEG_INF; p1[r] = (selb && d1 >= 0) ? p1[r] + (bth[d1 < 128 ? d1 : 128] - cfar) : NEG_INF; }
                } else if (!selb) {
#pragma unroll
                    for (int r = 0; r < 16; ++r) { p0[r] = NEG_INF; p1[r] = NEG_INF; }
                }
                softmax_pv2(p0, p1, sm, o, slot + VOFF, wsf, lane);
            }
        }, lds + L_RING, wid, lane);
        const float lt = half_swap_sum(sm.l);
        scaled_add(outacc, o, lt > 0.f ? gate[qi * 12 + h * 3 + 1] / lt : 0.f, wsf, lane, false);
    }
    {
        TileSrc T; T.K = U + UC_KV + 256; T.kpitch = NU; T.V = U + UC_KV + 320; T.vpitch = NU;
        const int j_lo = qt >= 8 ? qt - 8 : 0; const float cfar = bth[128];
        SmState sm; sm_init(sm, cfar); f32x16 o[2]; o[0] = f32x16{}; o[1] = f32x16{};
        tile_loop<64>(T, qt - j_lo + 1, 64 * j_lo, [&](int it, const LAS unsigned char* slot) {
            const int jt = j_lo + it;
            f32x16 p0, p1; qk_c<64>(p0, p1, slot, qf, sm.negm, r32, hi);
            if ((jt >= qt - 2) || (jt == qt - 8)) {
#pragma unroll
                for (int r = 0; r < 16; ++r) { const int d0 = t - (64 * jt + crow(r, hi)), d1 = d0 - 32;
                    p0[r] = (d0 >= 0 && d0 < 512) ? p0[r] + (bth[d0 < 128 ? d0 : 128] - cfar) : NEG_INF; p1[r] = (d1 >= 0 && d1 < 512) ? p1[r] + (bth[d1 < 128 ? d1 : 128] - cfar) : NEG_INF; }
            }
            softmax_pv2(p0, p1, sm, o, slot + VOFF, wsf, lane);
        }, lds + L_RING, wid, lane);
        const float lt = half_swap_sum(sm.l);
        scaled_add(outacc, o, lt > 0.f ? gate[qi * 12 + h * 3 + 2] / lt : 0.f, wsf, lane, false);
    }
    store_oacc(outacc, (bf16_t*)(F.ws + WS_CAT) + (size_t)(b * SEQ + t0 + 32 * qh) * DMODEL + CC_NSA + h * 64, DMODEL, lane);
    __syncthreads();
}

__device__ __forceinline__ void phaseC(Frame F) {
    LAUNDER(F);
    { LAS float* bt = (LAS float*)(F.lds + L_BT); const float* tab = IN(F, 21);
      for (int idx = F.tid; idx < 4 * 132; idx += 512) { const int h = idx / 132, d = idx - h * 132; bt[idx] = (d <= 128) ? tab[BUCKET[d] * 4 + h] * LOG2E : 0.f; }
      __syncthreads(); }
    for (int p = F.vcu; p < 256; p += F.G) {
        { const int bh = p >> 4, s = p & 15; mla_unit(F, bh >> 2, bh & 3, 31 - s); mla_unit(F, bh >> 2, bh & 3, s); }
        { const int b = p >> 6, s = p & 63; nsa_unit(F, b, 127 - s); nsa_unit(F, b, s); }
    }
}
}
constexpr int NTHREADS = 512;

template <class Sched> __device__ __forceinline__ void build_rs(Frame& F, const Sched& S) {
    LAS float* rs = (LAS float*)(F.lds + LDS_RS); const float* ss = (const float*)(F.ws + WS_SS); pg8::Unit u;
    for (int i = 0; S.next(i, u); ++i) {
        if (F.tid < 256) { const int row = u.pm * 256 + F.tid; const f32x4* p = (const f32x4*)(ss + (size_t)row * 16); const f32x4 v0 = p[0], v1 = p[1], v2 = p[2], v3 = p[3];
            const float s = (((v0[0] + v0[1]) + (v0[2] + v0[3])) + ((v1[0] + v1[1]) + (v1[2] + v1[3]))) + (((v2[0] + v2[1]) + (v2[2] + v2[3])) + ((v3[0] + v3[1]) + (v3[2] + v3[3])));
            rs[i * 256 + F.tid] = 1.0f / sqrtf(s * (1.f / DMODEL) + EPS); }
    }
    __syncthreads();
}

__device__ __forceinline__ void phaseA(Frame F, int l) {
    LAUNDER(F);
    pg8::Gemm g{(const bf16_t*)(F.ws + WS_HB), (const bf16_t*)(F.ws + WS_W + (size_t)l * W_LAYER + WO_WIN), MTOK, NU, DMODEL};
    pg8::StaticOrder S; S.init(MTOK, NU, F.G, F.bid);
    build_rs(F, S);
    pg8::EpiRowScale<0> E{(bf16_t*)(F.ws + WS_U), NU, (const LAS float*)(F.lds + LDS_RS)};
    pg8::gemm_phase<pg8::EpiRowScale<0>, pg8::StaticOrder, true, true>(F.lds, g, S, E);
}
__device__ __forceinline__ void phaseRes(Frame F, size_t a_off, size_t b_off, int K, bool first) {
    LAUNDER(F);
    float* out = (float*)IN(F, 23); const float* base = first ? IN(F, 0) : out;
    const bf16_t* A = (const bf16_t*)(F.ws + a_off); const bf16_t* Bt = (const bf16_t*)(F.ws + b_off);
    pg8::Gemm g{A, Bt, MTOK, DMODEL, K};
    pg8::StaticOrder S; S.init(MTOK, DMODEL, F.G, F.bid);
    pg8::EpiResidual E{base, out, (bf16_t*)(F.ws + WS_HB), (float*)(F.ws + WS_SS)};
    pg8::gemm_phase<pg8::EpiResidual, pg8::StaticOrder, true, true>(F.lds, g, S, E);
}
__device__ __forceinline__ void phaseE(Frame F, int l) {
    LAUNDER(F);
    pg8::Gemm g{(const bf16_t*)(F.ws + WS_HB), (const bf16_t*)(F.ws + WS_W + (size_t)l * W_LAYER + WO_W1), MTOK, DFF, DMODEL};
    pg8::StaticOrder S; S.init(MTOK, DFF, F.G, F.bid);
    build_rs(F, S);
    pg8::EpiRowScale<1> E{(bf16_t*)(F.ws + WS_Z), DFF, (const LAS float*)(F.lds + LDS_RS)};
    pg8::gemm_phase<pg8::EpiRowScale<1>, pg8::StaticOrder, true, true>(F.lds, g, S, E);
}
__device__ __forceinline__ void phaseG(Frame F) {
    LAUNDER(F);
    const float* ss = (const float*)(F.ws + WS_SS); const int gw = F.bid * 8 + F.wave, NGW = F.G * 8;
    const f32x4* gp = (const f32x4*)IN(F, 22) + F.lane; float* outp = (float*)IN(F, 23);
    for (int m = gw; m < MTOK; m += NGW) {
        float s = (F.lane < 16) ? ss[(size_t)m * 16 + F.lane] : 0.f; s = wave_sum(s);
        const float r = 1.0f / sqrtf(s * (1.f / DMODEL) + EPS);
        f32x4* hr = (f32x4*)(outp + (size_t)m * DMODEL) + F.lane;
#pragma unroll
        for (int j = 0; j < 4; ++j) { const f32x4 v = hr[64 * j]; hr[64 * j] = v * r * gp[64 * j]; }
    }
}

__global__ void __launch_bounds__(NTHREADS, 2) mega_fwd(Args a) {
    extern __shared__ __attribute__((aligned(16))) unsigned char lds_raw[];
    cg::grid_group grid = cg::this_grid();
    Frame F;
    F.lds = (LAS unsigned char*)lds_raw; F.tid = threadIdx.x; F.lane = F.tid & 63; F.wave = __builtin_amdgcn_readfirstlane(F.tid >> 6);
    F.G = gridDim.x; F.bid = blockIdx.x; F.vcu = (F.G % 8 == 0) ? (F.bid % 8) * (F.G / 8) + F.bid / 8 : F.bid; F.ws = a.ws;
    if (F.tid < 128) ((LAS unsigned*)(F.lds + LDS_CTL))[F.tid] = 0u;
    __syncthreads();
    const XcdBarrier bar = xcd_barrier_post((unsigned*)(a.ws + WS_BAR), (volatile LAS unsigned*)(F.lds + LDS_CTL));
#define SEAM() xcd_barrier(bar)
#ifndef SKIP_P0
    prologue(a, F);
#ifdef PROBE_P0
    __syncthreads(); prologue(a, F);
#endif
#endif
    grid.sync();
    for (int l = 0; l < NLAYER; ++l) {
#ifndef SKIP_PA
        phaseA(F, l);
#ifdef PROBE_PA
        phaseA(F, l);
#endif
#endif
        SEAM();
#ifndef SKIP_PB
        phaseB(F, l);
#ifdef PROBE_PB
        phaseB(F, l);
#endif
#endif
        SEAM();
#ifndef SKIP_PC
        att::phaseC(F);
#ifdef PROBE_PC
        att::phaseC(F);
#endif
#endif
        SEAM();
#ifndef SKIP_PD
        phaseRes(F, WS_CAT, WS_W + (size_t)l * W_LAYER + WO_WOUT, DMODEL, l == 0);
#endif
        SEAM();
#ifndef SKIP_PE
        phaseE(F, l);
#ifdef PROBE_PE
        phaseE(F, l);
#endif
#endif
        SEAM();
#ifndef SKIP_PF
        phaseRes(F, WS_Z, WS_W + (size_t)l * W_LAYER + WO_W2, DFF, false);
#endif
        SEAM();
#ifdef PROBE_SYNC
        SEAM(); SEAM(); SEAM(); SEAM(); SEAM(); SEAM();
#endif
    }
    phaseG(F);
}

extern "C" void kernel_launch(void* const* d_in, const int* in_sizes, int n_in, void* d_out, int out_size, void* d_ws, size_t ws_size, hipStream_t stream) {
    static int grid = 0;
    if (grid == 0) {
        if (n_in != 23 || out_size != MTOK * DMODEL || ws_size < WS_END) { fprintf(stderr, "kernel_launch: unexpected shapes: n_in %d out %d ws %zu (need >= %zu)\n", n_in, out_size, ws_size, (size_t)WS_END); grid = -1; return; }
        int dev = 0, cus = 0, per_cu = 0;
        if (hipGetDevice(&dev) != hipSuccess || hipDeviceGetAttribute(&cus, hipDeviceAttributeMultiprocessorCount, dev) != hipSuccess) { grid = -1; return; }
        if (hipFuncSetAttribute((const void*)mega_fwd, hipFuncAttributeMaxDynamicSharedMemorySize, LDS_BYTES) != hipSuccess) { fprintf(stderr, "kernel_launch: hipFuncSetAttribute failed\n"); grid = -1; return; }
        if (hipOccupancyMaxActiveBlocksPerMultiprocessor(&per_cu, (const void*)mega_fwd, NTHREADS, LDS_BYTES) != hipSuccess || per_cu < 1) { fprintf(stderr, "kernel_launch: occupancy query says %d blocks/CU\n", per_cu); grid = -1; return; }
        grid = cus;
        if (grid != 256) fprintf(stderr, "kernel_launch: note: %d CUs (built for 256)\n", grid);
    }
    if (grid < 0) return;
    if (hipMemsetAsync((char*)d_ws + WS_BAR, 0, 16384, stream) != hipSuccess) { fprintf(stderr, "kernel_launch: hipMemsetAsync failed\n"); return; }
    Args a{};
    for (int i = 0; i < 23; ++i) a.in[i] = (const float*)d_in[i];
    a.out = (float*)d_out; a.ws = (unsigned char*)d_ws;
    void* args[] = {&a};
    const hipError_t e = hipLaunchCooperativeKernel((const void*)mega_fwd, dim3(grid), dim3(NTHREADS), args, LDS_BYTES, stream);
    if (e != hipSuccess) fprintf(stderr, "kernel_launch: cooperative launch failed: %s (grid %d)\n", hipGetErrorString(e), grid);
}
```

```cpp
#include <hip/hip_runtime.h>
#include <hip/hip_cooperative_groups.h>
#include <cstdio>
#include <cstdint>
namespace cg = cooperative_groups;
namespace pg8 {
#define PG8_LAS __attribute__((address_space(3)))
typedef unsigned short bf16_t;
typedef short bf16x8 __attribute__((ext_vector_type(8)));
typedef float f32x4 __attribute__((ext_vector_type(4)));
typedef unsigned u32x4 __attribute__((ext_vector_type(4)));
typedef unsigned u32x2 __attribute__((ext_vector_type(2)));
constexpr int BM = 256, BK = 64, HALF = 128, HTB = HALF * BK * 2  , STAGE_BYTES = 8 * HTB, NXCD = 8, WGM = 8;

__host__ __device__ __forceinline__ int lds_byte(int r, int c) { const int st = (r >> 4) * 2 + (c >> 5), rr = r & 15, cc = c & 31, ob = rr * 64 + cc * 2; return st * 1024 + (ob ^ (((ob >> 9) & 1) << 5)); }
__host__ __device__ __forceinline__ void stage_rc(int b, int& R, int& C) { const int st = b / 1024, sb = b % 1024, swz = sb ^ (((sb >> 9) & 1) << 5); R = (st >> 1) * 16 + swz / 64; C = (st & 1) * 32 + (swz % 64) / 2; }
__host__ __device__ __forceinline__ int perm32(int rho) { const int n = rho >> 4, i = rho & 15; return 8 * (i >> 2) + 4 * n + (i & 3); }

struct Unit { int pm, pn, ui; };
struct Gemm { const bf16_t* A; const bf16_t* Bt; int M, N, K; };

struct StaticOrder {
    int nM, nN, nwg, G, c;
    __host__ __device__ void init(int M, int N, int G_, int c_) { nM = M / BM; nN = N / BM; nwg = nM * nN; G = G_; c = c_; }
    __host__ __device__ bool next(int i, Unit& u) const {
        const long L = (long)i * G + c; if (L >= nwg) return false;
        int wgid = (int)L; { const int q = nwg / NXCD, r = nwg % NXCD, xcd = wgid % NXCD, off = wgid / NXCD; wgid = (xcd < r ? xcd * (q + 1) : r * (q + 1) + (xcd - r) * q) + off; }
        const int nig = WGM * nN, gid = wgid / nig, fm = gid * WGM, gsz = (nM - fm) < WGM ? (nM - fm) : WGM;
        u.pm = fm + ((wgid % nig) % gsz); u.pn = (wgid % nig) / gsz; u.ui = i; return true;
    }
    __device__ __forceinline__ void a_ready(const Unit&) const {}
    __device__ __forceinline__ void done(const Unit&) const {}
};

typedef float f32x2 __attribute__((ext_vector_type(2)));
typedef __bf16 bf16x2_t __attribute__((ext_vector_type(2)));
__device__ __forceinline__ unsigned cvt_pk_bf16(float lo, float hi) { f32x2 v = {lo, hi}; bf16x2_t b = __builtin_convertvector(v, bf16x2_t); return __builtin_bit_cast(unsigned, b); }

template <int ACT> struct EpiRowScale {
    static constexpr bool PERM = true, AFTER_DRAIN = false;
    bf16_t* O; int ldc; const PG8_LAS float* rs;
    __device__ __forceinline__ void operator()(const f32x4 (&acc)[2][2][4][2], const Unit& u, int wr, int wc, int fr, int fq) const {
        { int ln_; asm volatile("v_mbcnt_lo_u32_b32 %0, -1, 0\n\tv_mbcnt_hi_u32_b32 %0, -1, %0" : "=v"(ln_)); fr = ln_ & 15; fq = ln_ >> 4; }
        const int rl0 = wr * 64 + fr, col0 = u.pn * BM + wc * 32 + 8 * fq;
#pragma unroll
        for (int ai = 0; ai < 2; ++ai)
#pragma unroll
            for (int m = 0; m < 4; ++m) { const int rl = rl0 + ai * HALF + m * 16; const float s = rs[u.ui * 256 + rl];
                bf16_t* rowp = O + (size_t)(u.pm * BM + rl) * ldc + col0;
#pragma unroll
                for (int bj = 0; bj < 2; ++bj) { f32x4 v0 = acc[ai][bj][m][0] * s, v1 = acc[ai][bj][m][1] * s;
                    if (ACT == 1) {
#pragma unroll
                        for (int e = 0; e < 4; ++e) { float a = fmaxf(v0[e], 0.f), b = fmaxf(v1[e], 0.f); v0[e] = a * a; v1[e] = b * b; } }
                    u32x4 w; w.x = cvt_pk_bf16(v0[0], v0[1]); w.y = cvt_pk_bf16(v0[2], v0[3]); w.z = cvt_pk_bf16(v1[0], v1[1]); w.w = cvt_pk_bf16(v1[2], v1[3]);
                    *(u32x4*)(rowp + bj * HALF) = w; } }
    }
};
struct EpiResidual {
    static constexpr bool PERM = true, AFTER_DRAIN = false;
    bf16_t* hb; float* ss;
    __device__ __forceinline__ void operator()(const f32x4 (&acc)[2][2][4][2], const Unit& u, int wr, int wc, int fr, int fq) const {
        { int ln_; asm volatile("v_mbcnt_lo_u32_b32 %0, -1, 0\n\tv_mbcnt_hi_u32_b32 %0, -1, %0" : "=v"(ln_)); fr = ln_ & 15; fq = ln_ >> 4; }
        const int col0 = u.pn * BM + wc * 32 + 8 * fq;
        bf16_t* hb0 = hb + (size_t)(u.pm * BM + wr * 64 + fr) * 1024 + col0;
        u32x4 bv[2][4][2];
#pragma unroll
        for (int ai = 0; ai < 2; ++ai)
#pragma unroll
            for (int m = 0; m < 4; ++m)
#pragma unroll
                for (int bj = 0; bj < 2; ++bj) bv[ai][m][bj] = *(const u32x4*)(hb0 + (size_t)(ai * HALF + m * 16) * 1024 + bj * HALF);
        __builtin_amdgcn_sched_barrier(0);
#pragma unroll
        for (int ai = 0; ai < 2; ++ai)
#pragma unroll
            for (int m = 0; m < 4; ++m) { const int row = u.pm * BM + wr * 64 + fr + ai * HALF + m * 16; float q = 0.f;
#pragma unroll
                for (int bj = 0; bj < 2; ++bj) { u32x4* hp = (u32x4*)(hb0 + (size_t)(ai * HALF + m * 16) * 1024 + bj * HALF); const u32x4 b = bv[ai][m][bj]; const f32x4 a0 = acc[ai][bj][m][0], a1 = acc[ai][bj][m][1];
                    u32x4 w;
                    w.x = cvt_pk_bf16(__uint_as_float(b.x << 16) + a0[0], __uint_as_float(b.x & 0xffff0000u) + a0[1]);
                    w.y = cvt_pk_bf16(__uint_as_float(b.y << 16) + a0[2], __uint_as_float(b.y & 0xffff0000u) + a0[3]);
                    w.z = cvt_pk_bf16(__uint_as_float(b.z << 16) + a1[0], __uint_as_float(b.z & 0xffff0000u) + a1[1]);
                    w.w = cvt_pk_bf16(__uint_as_float(b.w << 16) + a1[2], __uint_as_float(b.w & 0xffff0000u) + a1[3]);
                    *hp = w;
#pragma unroll
                    for (int e = 0; e < 4; ++e) { const float r0 = __uint_as_float(w[e] << 16), r1 = __uint_as_float(w[e] & 0xffff0000u); q += r0 * r0 + r1 * r1; } }
                q += __shfl_xor(q, 16); q += __shfl_xor(q, 32);
                if (fq == 0) ss[(size_t)row * 16 + u.pn * 4 + wc] = q; }
    }
};

template <class Epi, class Sched, bool ALIGN_EPI = false, bool SP2 = false>
__device__ __forceinline__ void gemm_phase(PG8_LAS unsigned char* lds, const Gemm g, const Sched& S, const Epi& E, int wave_id) {
    int lane_; asm volatile("v_mbcnt_lo_u32_b32 %0, -1, 0\n\tv_mbcnt_hi_u32_b32 %0, -1, %0" : "=v"(lane_));
    const int wid = wave_id, lane = lane_, tid = wid * 64 + lane, wr = wid >> 2, wc = wid & 3, fr = lane & 15, fq = lane >> 4;
    const int K = g.K, nt = K / BK;
    unsigned voffA[2], voffB[2];
#pragma unroll
    for (int i = 0; i < 2; ++i) { int R, C; stage_rc(tid * 16 + i * 8192, R, C); const int Rb = Epi::PERM ? ((R & ~31) + perm32(R & 31)) : R;
        voffA[i] = (unsigned)(R * K + C) * 2u; voffB[i] = (unsigned)(Rb * K + C) * 2u; }
    const size_t kstep = (size_t)(BK * 2);
    const size_t hstep = (size_t)HALF * K * 2;
    const size_t tstep = 2 * hstep;
    const unsigned ldsw = (unsigned)wid * 1024u;
    const int aoff = lds_byte(wr * 64 + fr, fq * 8), boff = lds_byte(wc * 32 + fr, fq * 8);
#define PG8_SA(b, h) (((b) * 2 + (h)) * HTB)
#define PG8_SB(b, h) ((4 + (b) * 2 + (h)) * HTB)
#define PG8_STAGE(bufoff, gbase, voff) do { _Pragma("unroll") for (int _i = 0; _i < 2; ++_i) \
        __builtin_amdgcn_global_load_lds((const unsigned*)((const char*)(gbase) + (voff)[_i]), (PG8_LAS unsigned*)(lds + (bufoff) + ldsw + _i * 8192), 16, 0, 0); } while (0)
#define PG8_LDA(dst, b, h) do { _Pragma("unroll") for (int m = 0; m < 4; ++m) _Pragma("unroll") for (int k = 0; k < 2; ++k) dst[m][k] = *(const PG8_LAS bf16x8*)(lds + PG8_SA(b, h) + aoff + m * 2048 + k * 1024); } while (0)
#define PG8_LDB(dst, b, h) do { _Pragma("unroll") for (int n = 0; n < 2; ++n) _Pragma("unroll") for (int k = 0; k < 2; ++k) dst[n][k] = *(const PG8_LAS bf16x8*)(lds + PG8_SB(b, h) + boff + n * 2048 + k * 1024); } while (0)
#define PG8_MMA(ai, bj, At, Bt) do { __builtin_amdgcn_s_setprio(1); _Pragma("unroll") for (int m = 0; m < 4; ++m) _Pragma("unroll") for (int n = 0; n < 2; ++n) _Pragma("unroll") for (int k = 0; k < 2; ++k) \
        acc[ai][bj][m][n] = __builtin_amdgcn_mfma_f32_16x16x32_bf16(Bt[n][k], At[m][k], acc[ai][bj][m][n], 0, 0, 0); __builtin_amdgcn_s_setprio(0); } while (0)
#define PG8_WAIT_V(n) asm volatile("s_waitcnt vmcnt(" #n ")" ::: "memory")
#define PG8_WAIT_L(n) asm volatile("s_waitcnt lgkmcnt(" #n ")" ::: "memory")
#define PG8_BAR __builtin_amdgcn_s_barrier()
#define PG8_SCHED __builtin_amdgcn_sched_barrier(0)
    Unit cur, nxt; int ui = 0;
    if (!S.next(0, cur)) return;
    f32x4 acc[2][2][4][2];
#pragma unroll
    for (int a = 0; a < 2; ++a)
#pragma unroll
        for (int b = 0; b < 2; ++b)
#pragma unroll
            for (int m = 0; m < 4; ++m)
#pragma unroll
                for (int n = 0; n < 2; ++n) acc[a][b][m][n] = (f32x4){0.f, 0.f, 0.f, 0.f};
    bf16x8 At[4][2], B0[2][2], B1[2][2];
    const char* cA = (const char*)g.A + (size_t)cur.pm * tstep; const char* cB = (const char*)g.Bt + (size_t)cur.pn * tstep;
    S.a_ready(cur);
    if constexpr (SP2) {
        PG8_STAGE(PG8_SB(0, 0), cB, voffB); PG8_STAGE(PG8_SB(0, 1), cB + hstep, voffB); PG8_STAGE(PG8_SA(0, 0), cA, voffA); PG8_STAGE(PG8_SA(0, 1), cA + hstep, voffA);
        if (wr == 1) PG8_BAR;
        PG8_WAIT_V(2); PG8_BAR;
        PG8_STAGE(PG8_SB(1, 0), cB + kstep, voffB); PG8_STAGE(PG8_SA(1, 0), cA + kstep, voffA); PG8_STAGE(PG8_SB(1, 1), cB + hstep + kstep, voffB);
        PG8_WAIT_V(6); PG8_BAR;
    } else {
        PG8_STAGE(PG8_SB(0, 0), cB, voffB); PG8_STAGE(PG8_SA(0, 0), cA, voffA); PG8_STAGE(PG8_SB(0, 1), cB + hstep, voffB); PG8_STAGE(PG8_SA(0, 1), cA + hstep, voffA);
        if (wr == 1) PG8_BAR;
        PG8_WAIT_V(4); PG8_BAR;
        PG8_STAGE(PG8_SB(1, 0), cB + kstep, voffB); PG8_STAGE(PG8_SA(1, 0), cA + kstep, voffA); PG8_STAGE(PG8_SB(1, 1), cB + hstep + kstep, voffB);
        PG8_WAIT_V(6); PG8_BAR;
    }
    for (;;) {
        const bool has_next = S.next(ui + 1, nxt);
        const char* nA = has_next ? (const char*)g.A + (size_t)nxt.pm * tstep : cA; const char* nB = has_next ? (const char*)g.Bt + (size_t)nxt.pn * tstep : cB;
        for (int t = 0; t < nt; t += 2) {
            const bool last = (t == nt - 2);
            const char* a1 = cA + (size_t)(t + 1) * kstep;
            const char* a2 = last ? nA : cA + (size_t)(t + 2) * kstep; const char* b2 = last ? nB : cB + (size_t)(t + 2) * kstep;
            const char* a3 = a2 + kstep; const char* b3 = b2 + kstep;
            if (last && has_next) S.a_ready(nxt);
            if constexpr (SP2) {
            PG8_LDB(B0, 0, 0); PG8_LDB(B1, 0, 1); PG8_SCHED; PG8_LDA(At, 0, 0); PG8_STAGE(PG8_SA(1, 1), a1 + hstep, voffA);
            PG8_WAIT_V(8); PG8_WAIT_L(0); PG8_BAR; PG8_MMA(0, 0, At, B0); PG8_MMA(0, 1, At, B1); PG8_BAR; PG8_SCHED;
            PG8_LDA(At, 0, 1); PG8_STAGE(PG8_SB(0, 0), b2, voffB); PG8_STAGE(PG8_SB(0, 1), b2 + hstep, voffB); PG8_STAGE(PG8_SA(0, 0), a2, voffA);
            PG8_WAIT_V(8); PG8_WAIT_L(0); PG8_BAR; PG8_MMA(1, 0, At, B0); PG8_MMA(1, 1, At, B1); PG8_BAR; PG8_SCHED;
            PG8_LDB(B0, 1, 0); PG8_LDB(B1, 1, 1); PG8_SCHED; PG8_LDA(At, 1, 0); PG8_STAGE(PG8_SA(0, 1), a2 + hstep, voffA);
            PG8_WAIT_V(8); PG8_WAIT_L(0); PG8_BAR; PG8_MMA(0, 0, At, B0); PG8_MMA(0, 1, At, B1); PG8_BAR; PG8_SCHED;
            PG8_LDA(At, 1, 1); PG8_STAGE(PG8_SB(1, 0), b3, voffB); PG8_STAGE(PG8_SB(1, 1), b3 + hstep, voffB); PG8_STAGE(PG8_SA(1, 0), a3, voffA);
            PG8_WAIT_V(8); PG8_WAIT_L(0); PG8_BAR; PG8_MMA(1, 0, At, B0); PG8_MMA(1, 1, At, B1); PG8_BAR; PG8_SCHED;
            } else {
            PG8_LDB(B0, 0, 0); PG8_SCHED; PG8_LDA(At, 0, 0); PG8_STAGE(PG8_SA(1, 1), a1 + hstep, voffA);
            PG8_WAIT_L(8); PG8_BAR; PG8_WAIT_L(0); PG8_MMA(0, 0, At, B0); PG8_BAR; PG8_SCHED;
            PG8_LDB(B1, 0, 1); PG8_STAGE(PG8_SB(0, 0), b2, voffB);
            PG8_BAR; PG8_WAIT_L(0); PG8_MMA(0, 1, At, B1); PG8_BAR;
            PG8_LDA(At, 0, 1); PG8_STAGE(PG8_SA(0, 0), a2, voffA);
            PG8_BAR; PG8_WAIT_L(0); PG8_MMA(1, 0, At, B0); PG8_BAR; PG8_SCHED;
            PG8_STAGE(PG8_SB(0, 1), b2 + hstep, voffB);
            PG8_WAIT_V(6); PG8_BAR; PG8_MMA(1, 1, At, B1); PG8_BAR;
            PG8_LDB(B0, 1, 0); PG8_SCHED; PG8_LDA(At, 1, 0); PG8_STAGE(PG8_SA(0, 1), a2 + hstep, voffA);
            PG8_WAIT_L(8); PG8_BAR; PG8_WAIT_L(0); PG8_MMA(0, 0, At, B0); PG8_BAR; PG8_SCHED;
            PG8_LDB(B1, 1, 1); PG8_STAGE(PG8_SB(1, 0), b3, voffB);
            PG8_BAR; PG8_WAIT_L(0); PG8_MMA(0, 1, At, B1); PG8_BAR;
            PG8_LDA(At, 1, 1); PG8_STAGE(PG8_SA(1, 0), a3, voffA);
            PG8_BAR; PG8_WAIT_L(0); PG8_MMA(1, 0, At, B0); PG8_BAR; PG8_SCHED;
            PG8_STAGE(PG8_SB(1, 1), b3 + hstep, voffB);
            PG8_WAIT_V(6); PG8_BAR; PG8_MMA(1, 1, At, B1); PG8_BAR;
            }
        }
        if constexpr (ALIGN_EPI) { if (wr == 0) PG8_BAR; }
        if constexpr (!Epi::AFTER_DRAIN) { E(acc, cur, wr, wc, fr, fq); S.done(cur); }
        if (!has_next) break;
#pragma unroll
        for (int a = 0; a < 2; ++a)
#pragma unroll
            for (int b = 0; b < 2; ++b)
#pragma unroll
                for (int m = 0; m < 4; ++m)
#pragma unroll
                    for (int n = 0; n < 2; ++n) acc[a][b][m][n] = (f32x4){0.f, 0.f, 0.f, 0.f};
        cur = nxt; cA = nA; cB = nB; ++ui;
        if constexpr (ALIGN_EPI) { if (wr == 1) PG8_BAR; }
    }
    PG8_WAIT_V(0);
    if constexpr (!ALIGN_EPI) { if (wr == 0) PG8_BAR; }
    PG8_BAR;
#undef PG8_SA
#undef PG8_SB
#undef PG8_STAGE
#undef PG8_LDA
#undef PG8_LDB
#undef PG8_MMA
#undef PG8_WAIT_V
#undef PG8_WAIT_L
#undef PG8_BAR
#undef PG8_SCHED
}
}
#define LAS __attribute__((address_space(3)))
using pg8::bf16_t; using pg8::bf16x8; using pg8::f32x4; using pg8::u32x4; using pg8::u32x2; using pg8::cvt_pk_bf16;
typedef float f32x16 __attribute__((ext_vector_type(16)));
typedef short s16x4 __attribute__((ext_vector_type(4)));

constexpr int NB = 4, SEQ = 8192, MTOK = NB * SEQ, DMODEL = 1024, DIN = 1836, NU = 2048, DFF = 4096, NLAYER = 2;
constexpr float EPS = 1e-6f, LOG2E = 1.4426950408889634f;
constexpr float NSA_QSCALE = 0.125f * LOG2E;
constexpr float MLA_QSCALE = 0.10206207261596575f * LOG2E;
constexpr int UC_A = 0, UC_G = 256, UC_Q = 512, UC_KV = 768, UC_CQ = 1152, UC_CKV = 1408, UC_POOL = 1536, UC_KR = 1792, UC_GATE = 1824;
constexpr int CC_CONV = 0, CC_NSA = 256, CC_MLA = 512, CC_POOL = 768;

constexpr size_t MiB = 1u << 20;
constexpr size_t WS_W = 1 * MiB, W_LAYER = 25 * MiB;
constexpr size_t WO_WIN = 0, WO_WOUT = 4 * MiB, WO_W1 = 6 * MiB, WO_W2 = 14 * MiB, WO_SMALL = 22 * MiB;
constexpr size_t WO_C1 = WO_SMALL, WO_C2 = WO_SMALL + 1048576, WO_QKV = WO_SMALL + 1081344  , WO_CP = WO_SMALL + 1867776  ;
static_assert(WO_CP + 524288 <= W_LAYER, "weight map");
constexpr size_t WS_TAB = 4096, WS_ROPE = 52 * MiB, WS_CB1 = 53 * MiB  , WS_SS = 54 * MiB, WS_HB = 56 * MiB, WS_KC = 120 * MiB;
constexpr size_t WS_U = 128 * MiB, WS_CAT = 256 * MiB, WS_QKVO = 320 * MiB  , WS_KR = 121 * MiB  , WS_Z = 128 * MiB,
                 WS_AQKV = 384 * MiB  , WS_ACP = 408 * MiB  , WS_END = 440 * MiB;

constexpr int LDS_BYTES = 163840;
constexpr int LDS_RS = 131072;

__device__ const unsigned char BUCKET[129] = {0,1,2,3,4,5,6,7,8,9,10,11,12,13,14,15,16,16,16,17,17,18,18,18,19,19,19,20,20,20,20,21,21,21,21,22,22,22,22,22,23,23,23,23,23,23,24,24,24,24,24,24,25,25,25,25,25,25,25,26,26,26,26,26,26,26,26,27,27,27,27,27,27,27,27,27,27,28,28,28,28,28,28,28,28,28,28,29,29,29,29,29,29,29,29,29,29,29,29,30,30,30,30,30,30,30,30,30,30,30,30,30,30,31,31,31,31,31,31,31,31,31,31,31,31,31,31,31,31};

__device__ __forceinline__ float bf2f(unsigned short x) { return __uint_as_float((unsigned)x << 16); }
__device__ __forceinline__ unsigned short f2bf(float f) { return (unsigned short)(cvt_pk_bf16(f, 0.f) & 0xffffu); }
template <int CTRL> __device__ __forceinline__ float dpp_f(float v) { return __builtin_bit_cast(float, __builtin_amdgcn_update_dpp(0, __builtin_bit_cast(int, v), CTRL, 0xf, 0xf, true)); }
__device__ __forceinline__ float wave_sum(float v) {
    v += dpp_f<0xB1>(v);
    v += dpp_f<0x4E>(v);
    v += dpp_f<0x141>(v);
    v += dpp_f<0x140>(v);
    { auto r = __builtin_amdgcn_permlane16_swap(__float_as_uint(v), __float_as_uint(v), false, false); v = __uint_as_float(r[0]) + __uint_as_float(r[1]); }
    { auto r = __builtin_amdgcn_permlane32_swap(__float_as_uint(v), __float_as_uint(v), false, false); v = __uint_as_float(r[0]) + __uint_as_float(r[1]); }
    return v;
}
__device__ __forceinline__ float sigmoidf_(float x) { return __builtin_amdgcn_rcpf(1.0f + __builtin_amdgcn_exp2f(-1.4426950408889634f * x)); }
__device__ __forceinline__ int crow(int r, int hi) { return (r & 3) + 8 * (r >> 2) + 4 * hi; }

struct Args { const float* in[23]; float* out; unsigned char* ws; int pad0, pad1; };

#define GAS __attribute__((address_space(1)))
struct Frame {
    LAS unsigned char* lds;
    int tid, lane, wave, G, bid, vcu;
    GAS unsigned char* ws;
};

__device__ __forceinline__ int hw_lane() { int x; asm volatile("v_mbcnt_lo_u32_b32 %0, -1, 0\n\tv_mbcnt_hi_u32_b32 %0, -1, %0" : "=v"(x)); return x; }
#define LAUNDER(F) do { unsigned long long _w = (unsigned long long)(F).ws; asm volatile("" : "+s"(_w)); (F).ws = (GAS unsigned char*)_w; \
    unsigned _l = (unsigned)(size_t)(F).lds; asm volatile("" : "+s"(_l)); (F).lds = (LAS unsigned char*)(size_t)_l; \
    int _ln = hw_lane(); (F).lane = _ln; (F).tid = (F).wave * 64 + _ln; } while (0)

#ifdef STAMP_ID
#define TICK(F, k) do { if ((F).bid == 0 && (F).wave == 0) { const unsigned long long _t = __builtin_amdgcn_s_memrealtime(); volatile LAS unsigned long long* _a = (volatile LAS unsigned long long*)((F).lds + LDS_BYTES - 512 + 64); \
    if (hw_lane() == 0) { _a[1 + (k)] += _t - _a[0]; _a[0] = _t; } } } while (0)
#else
#define TICK(F, k) do { } while (0)
#endif

__device__ __forceinline__ const float* IN(const Frame& F, int k) { return (const float*)(const GAS float*)(((const float* const*)(F.ws + WS_TAB))[k]); }

template <int K> __device__ __forceinline__ f32x16 small_mm(const LAS unsigned char* A, int lda_b, const bf16_t* BT, int lane) {
    const int r32 = lane & 31, hi = lane >> 5; f32x16 acc = {};
    const LAS unsigned char* ap = A + r32 * lda_b + hi * 16; const bf16_t* bp = BT + (size_t)r32 * K + hi * 8;
    bf16x8 bv[K / 16];
#pragma unroll
    for (int ks = 0; ks < K / 16; ++ks) bv[ks] = *(const bf16x8*)(bp + ks * 16);
#pragma unroll
    for (int ks = 0; ks < K / 16; ++ks) {
        const bf16x8 a = *(const LAS bf16x8*)(ap + ks * 32);
        acc = __builtin_amdgcn_mfma_f32_32x32x16_bf16(a, bv[ks], acc, 0, 0, 0);
    }
    return acc;
}
#define XB_TMO      128
#define XB_XCNT(j)  (256  + 64 * (j))
#define XB_XSUB(j)  (1280 + 64 * (j))
#define XB_XGEN(j)  (2304 + 64 * (j))
#define XB_TOP      3328
#define XB_TOPGEN   3392
#define XCD_BAR_WORDS 3456
#define XB_SPIN_CAP (1u << 18)
constexpr size_t WS_BAR = 65536;
constexpr int LDS_CTL = LDS_BYTES - 512;

__device__ __forceinline__ unsigned xb_ld(unsigned* p)              { return __hip_atomic_load(p, __ATOMIC_RELAXED, __HIP_MEMORY_SCOPE_AGENT); }
__device__ __forceinline__ unsigned xb_add(unsigned* p, unsigned v) { return __hip_atomic_fetch_add(p, v, __ATOMIC_RELAXED, __HIP_MEMORY_SCOPE_AGENT); }
__device__ __forceinline__ unsigned xb_xcc_id() { return (unsigned)__builtin_amdgcn_s_getreg((3 << 11) | 20) & 0xFu; }
#define XB_SPIN(cond, bar) do { unsigned _sp = 0; while (cond) { __builtin_amdgcn_s_sleep(1); \
    if ((++_sp & 255u) == 0u) { if (xb_ld(&(bar)[XB_TMO])) break; if (_sp > XB_SPIN_CAP) { atomicAdd(&(bar)[XB_TMO], 1u); break; } } } } while (0)

struct XcdBarrier { unsigned* bar; unsigned x; volatile LAS unsigned* st; };

__device__ __forceinline__ XcdBarrier xcd_barrier_post(unsigned* bar, volatile LAS unsigned* st, bool leader) {
    XcdBarrier b; b.bar = bar; b.x = xb_xcc_id(); b.st = st;
    if (leader) (void)xb_add(&bar[XB_XCNT(b.x)], 1u);
    return b;
}
__device__ __forceinline__ void xcd_barrier_complete(unsigned* bar, unsigned x, unsigned& nloc, unsigned& nx) {
    const unsigned G = gridDim.x * gridDim.y * gridDim.z;
    unsigned sum, cnt, mine, sp = 0u;
    for (;;) {
        sum = 0u; cnt = 0u; mine = 0u;
#pragma unroll 1
        for (unsigned j = 0; j < 16; ++j) { const unsigned c = xb_ld(&bar[XB_XCNT(j)]); sum += c; cnt += (c > 0u) ? 1u : 0u; mine = (j == x) ? c : mine; }
        if (sum == G) break;
        __builtin_amdgcn_s_sleep(1);
        if ((++sp & 255u) == 0u) { if (xb_ld(&bar[XB_TMO])) break; if (sp > XB_SPIN_CAP) { atomicAdd(&bar[XB_TMO], 1u); break; } }
    }
    nloc = mine > 0u ? mine : 1u; nx = cnt > 0u ? cnt : 1u;
}
__device__ __forceinline__ void xcd_barrier(const XcdBarrier& b, int wave_id) {
    asm volatile("s_waitcnt vmcnt(0)" ::: "memory");
    __syncthreads();
    if (wave_id == 0 && hw_lane() == 0) {
        unsigned* bar; { unsigned long long _b = (unsigned long long)b.bar; asm volatile("" : "+s"(_b)); bar = (unsigned*)_b; }
        __builtin_amdgcn_s_waitcnt(0);
        unsigned nloc = b.st[0], nx = b.st[1];
        if (nloc == 0u) { xcd_barrier_complete(bar, b.x, nloc, nx); b.st[0] = nloc; b.st[1] = nx; }
        const unsigned old = xb_add(&bar[XB_XSUB(b.x)], 1u);
        const unsigned gen = old / nloc;
        if (old + 1u == (gen + 1u) * nloc) {
            __builtin_amdgcn_fence(__ATOMIC_RELEASE, "agent");
            asm volatile("s_waitcnt vmcnt(0)" ::: "memory");
            const unsigned og = xb_add(&bar[XB_TOP], 1u);
            const unsigned tg = og / nx;
            if (og + 1u == (tg + 1u) * nx) xb_add(&bar[XB_TOPGEN], 1u);
            else XB_SPIN(xb_ld(&bar[XB_TOPGEN]) == tg, bar);
            __builtin_amdgcn_fence(__ATOMIC_ACQUIRE, "agent");
            xb_add(&bar[XB_XGEN(b.x)], 1u);
            asm volatile("s_waitcnt vmcnt(0)" ::: "memory");
        } else {
            XB_SPIN(xb_ld(&bar[XB_XGEN(b.x)]) == gen, bar);
            __builtin_amdgcn_fence(__ATOMIC_ACQUIRE, "agent");
            asm volatile("s_waitcnt vmcnt(0)" ::: "memory");
        }
    }
    __syncthreads();
}

#ifdef PROBE_CLK
#define CLK_S(k) do { if (F.wave == 0) { volatile unsigned long long* _c = (volatile unsigned long long*)((unsigned char*)F.ws + 131072 + F.bid * 1024); const unsigned long long _r = __builtin_amdgcn_s_memrealtime(), _t = __builtin_amdgcn_s_memtime(); if (hw_lane() == 0) { _c[(k)] = _r; _c[32 + (k)] = _t; } } } while (0)
#define CLK_X(k) do { if (F.wave == 0) { volatile unsigned long long* _c = (volatile unsigned long long*)((unsigned char*)F.ws + 131072 + F.bid * 1024); const unsigned long long _r = __builtin_amdgcn_s_memrealtime(); if (hw_lane() == 0) _c[64 + (k)] = _r; } } while (0)
#else
#define CLK_X(k) do { } while (0)
#define CLK_S(k) do { } while (0)
#endif
__device__ __forceinline__ int win_src(int n) {
    if (n < 1152) return n;
    if (n < 1408) return n - 1152 + 1164;
    if (n < 1536) return n - 1408 + 1420;
    if (n < 1792) return n - 1536 + 1580;
    if (n < 1824) return n - 1792 + 1548;
    if (n < 1836) return n - 1824 + 1152;
    return -1;
}
template <int MODE> __device__ __forceinline__ void transpose_item(const float* W, int K, int ldn, bf16_t* WT, const float* ks, float cs0, LAS float* scr, int item, int nblk, int lane, int ldw = 0, const float* ncs = nullptr) {
    if (ldw == 0) ldw = K;
    const int kb = item / nblk, nb = item % nblk, k0 = 64 * kb, n0 = 32 * nb;
    {
        const int n4 = (lane & 7) * 4; f32x4 nsc = {cs0, cs0, cs0, cs0};
        int sc4 = n0 + n4;
        if (MODE == 1) { sc4 = win_src(n0 + n4); const float q = (n0 + n4 >= UC_Q && n0 + n4 < UC_KV) ? NSA_QSCALE : 1.0f; nsc = (f32x4){q, q, q, q}; }
        if (ncs) { const f32x4 t = *(const f32x4*)(ncs + n0 + n4); nsc = nsc * t; }
        f32x4 v[8];
#pragma unroll
        for (int i = 0; i < 8; ++i) v[i] = (sc4 >= 0) ? *(const f32x4*)(W + (size_t)(k0 + (lane >> 3) + 8 * i) * ldn + sc4) : (f32x4){0.f, 0.f, 0.f, 0.f};
#pragma unroll
        for (int i = 0; i < 8; ++i) { const int kk = (lane >> 3) + 8 * i; f32x4 x = v[i] * nsc; if (ks) x = x * ks[k0 + kk];
            LAS float* d = scr + kk * 33 + n4; d[0] = x[0]; d[1] = x[1]; d[2] = x[2]; d[3] = x[3]; }
    }
    asm volatile("s_waitcnt lgkmcnt(0)" ::: "memory");
    const int c = lane & 7;
#pragma unroll
    for (int j = 0; j < 4; ++j) { const int n = (lane >> 3) + 8 * j; const LAS float* s = scr + (8 * c) * 33 + n;
        u32x4 o; o.x = cvt_pk_bf16(s[0 * 33], s[1 * 33]); o.y = cvt_pk_bf16(s[2 * 33], s[3 * 33]); o.z = cvt_pk_bf16(s[4 * 33], s[5 * 33]); o.w = cvt_pk_bf16(s[6 * 33], s[7 * 33]);
        *(u32x4*)(WT + (size_t)(n0 + n) * ldw + k0 + 8 * c) = o; }
    asm volatile("s_waitcnt lgkmcnt(0)" ::: "memory");
}

__device__ __forceinline__ void fold_item(int kind, int k8, int nblk, const float* pw, const float* poolw, const float* pscale, const float* Wout, bf16_t* WoutT, int lane) {
    const int n = 64 * nblk + lane; float acc[8];
#pragma unroll
    for (int i = 0; i < 8; ++i) acc[i] = 0.f;
    int kdst, J; const float* arow; const float* wsrc; const float* sc = nullptr;
    if (kind == 0) { kdst = 8 * k8; J = 256; arow = pw + (size_t)kdst * 256; wsrc = Wout + n; }
    else { const int g = k8 >> 3, c0 = 8 * (k8 & 7); kdst = 768 + 64 * g + c0; J = 64; arow = poolw + (size_t)(g * 64 + c0) * 64; wsrc = Wout + (size_t)(768 + 64 * g) * DMODEL + n; sc = pscale + 64 * g; }
#pragma unroll 1
    for (int j0 = 0; j0 < J; j0 += 32) {
        float av[4], w[32];
#pragma unroll
        for (int q = 0; q < 4; ++q) av[q] = arow[(lane >> 3) * J + j0 + (lane & 7) + 8 * q];
#pragma unroll
        for (int jj = 0; jj < 32; ++jj) { w[jj] = wsrc[(size_t)(j0 + jj) * DMODEL]; if (sc) w[jj] *= sc[j0 + jj]; }
#pragma unroll
        for (int i = 0; i < 8; ++i)
#pragma unroll
            for (int jj = 0; jj < 32; ++jj) acc[i] += __builtin_bit_cast(float, __builtin_amdgcn_readlane(__builtin_bit_cast(int, av[jj >> 3]), 8 * i + (jj & 7))) * w[jj];
    }
    u32x4 o; o.x = cvt_pk_bf16(acc[0], acc[1]); o.y = cvt_pk_bf16(acc[2], acc[3]); o.z = cvt_pk_bf16(acc[4], acc[5]); o.w = cvt_pk_bf16(acc[6], acc[7]);
    *(u32x4*)(WoutT + (size_t)n * DMODEL + kdst) = o;
}

__device__ __forceinline__ void zero_item(bf16_t* WT, int ldw, int kb, int nb, int lane) {
#pragma unroll
    for (int j = 0; j < 4; ++j) { const int n = (lane >> 3) + 8 * j; *(u32x4*)(WT + (size_t)(32 * nb + n) * ldw + 64 * kb + 8 * (lane & 7)) = (u32x4){0u, 0u, 0u, 0u}; }
}

__device__ __forceinline__ void prologue(const Args& a, Frame F) {
    LAUNDER(F);
    if (F.bid == 0 && F.tid == 0) { const float** tab = (const float**)(F.ws + WS_TAB);
#pragma unroll
        for (int k = 0; k < 23; ++k) tab[k] = a.in[k];
        tab[23] = a.out; }
    LAS float* scr = (LAS float*)(F.lds + F.wave * 16384);
    const int gw = F.bid * 8 + F.wave, NGW = F.G * 8;
    constexpr int I_WIN = 16 * 64, I_WOUT = 8 * 32, I_W1 = 16 * 128, I_W2 = 64 * 32, I_QKV = 6 * 32, I_FOLD = 2 * 32 * 16, I_C1 = 32 * 4, I_C2 = 2 * 2;
    auto item = [&](int kind, int idx) {
        if (kind == 0) { if (idx >= NLAYER * I_FOLD) return; const int l = idx / I_FOLD, g_ = idx % I_FOLD, r = ((g_ & 1) << 9) | (g_ >> 1);
            unsigned char* wl = (unsigned char*)(F.ws + WS_W + (size_t)l * W_LAYER);
            fold_item(r >> 9, (r >> 4) & 31, r & 15, a.in[9] + (size_t)l * 256 * 256, a.in[17] + (size_t)l * 4 * 64 * 64, a.in[18] + l * 256, a.in[2] + (size_t)l * DMODEL * DMODEL, (bf16_t*)(wl + WO_WOUT), F.lane); }
        else if (kind == 1) { if (idx >= NLAYER * I_WIN) return; const int l = idx / I_WIN, r = idx % I_WIN; unsigned char* wl = (unsigned char*)(F.ws + WS_W + (size_t)l * W_LAYER);
            transpose_item<1>(a.in[1] + (size_t)l * DMODEL * DIN, DMODEL, DIN, (bf16_t*)(wl + WO_WIN), a.in[3] + l * DMODEL, 1.f, scr, r, 64, F.lane); }
        else if (kind == 2) { if (idx >= NLAYER * I_W1) return; const int l = idx / I_W1, r = idx % I_W1; unsigned char* wl = (unsigned char*)(F.ws + WS_W + (size_t)l * W_LAYER);
            transpose_item<0>(a.in[19] + (size_t)l * DMODEL * DFF, DMODEL, DFF, (bf16_t*)(wl + WO_W1), a.in[4] + l * DMODEL, 1.f, scr, r, 128, F.lane); }
        else if (kind == 3) { if (idx >= NLAYER * I_W2) return; const int l = idx / I_W2, r = idx % I_W2; unsigned char* wl = (unsigned char*)(F.ws + WS_W + (size_t)l * W_LAYER);
            transpose_item<0>(a.in[20] + (size_t)l * DFF * DMODEL, DFF, DMODEL, (bf16_t*)(wl + WO_W2), nullptr, 1.f, scr, r, 32, F.lane); }
        else {
            constexpr int I_MISC = I_WOUT + I_QKV + 2 * I_C1 + 2 * I_C2;
            if (idx >= NLAYER * I_MISC) return; const int l = idx / I_MISC; int r = idx % I_MISC; unsigned char* wl = (unsigned char*)(F.ws + WS_W + (size_t)l * W_LAYER);
            if (r < I_WOUT) {
                transpose_item<0>(a.in[2] + (size_t)l * DMODEL * DMODEL, DMODEL, DMODEL, (bf16_t*)(wl + WO_WOUT), nullptr, 1.f, scr, r + 4 * 32, 32, F.lane); return; } r -= I_WOUT;
            if (r < I_QKV) {
                const int kb = r / 32, nb = r % 32; bf16_t* WT = (bf16_t*)(wl + WO_QKV);
                if (nb < 12 && kb < 4) transpose_item<0>(a.in[14] + (size_t)l * 256 * 384, 256, 384, WT, a.in[13] + l * 256, MLA_QSCALE, scr, kb * 12 + nb, 12, F.lane, 384);
                else if (nb >= 12 && nb < 28 && kb >= 4) transpose_item<0>(a.in[16] + (size_t)l * 128 * 512, 128, 512, WT + (size_t)384 * 384 + 256, a.in[15] + l * 128, 1.f, scr, (kb - 4) * 16 + (nb - 12), 16, F.lane, 384);
                else zero_item(WT, 384, kb, nb, F.lane);
                return; } r -= I_QKV;
            if (r < 2 * I_C1) { const int i = r / I_C1; transpose_item<0>(a.in[11] + (size_t)(l * 2 + i) * 2048 * 128, 2048, 128, (bf16_t*)(wl + WO_C1) + (size_t)i * 128 * 2048, nullptr, 1.f, scr, r % I_C1, 4, F.lane); return; } r -= 2 * I_C1;
            { const int i = r / I_C2; transpose_item<0>(a.in[12] + (size_t)(l * 2 + i) * 128 * 64, 128, 64, (bf16_t*)(wl + WO_C2) + (size_t)i * 64 * 128, nullptr, 1.f, scr, r % I_C2, 2, F.lane); }
        }
    };
    for (int g = gw; g < 2048; g += NGW) {
        item(0, g); item(1, g); item(2, g); item(2, g + 2048); item(3, g); item(3, g + 2048); item(4, g);
    }
    CLK_X(0);
    {
        const float* x = a.in[0]; bf16_t* hb = (bf16_t*)(F.ws + WS_HB); float* ss = (float*)(F.ws + WS_SS);
        LAS unsigned* ctr = (LAS unsigned*)(F.lds + LDS_CTL + 64);
        const int nchunk = (MTOK / 4 - F.bid + F.G - 1) / F.G;
        for (;;) {
            unsigned cch = 0; if (F.lane == 0) cch = __hip_atomic_fetch_add(ctr, 1u, __ATOMIC_RELAXED, __HIP_MEMORY_SCOPE_WORKGROUP);
            cch = (unsigned)__builtin_amdgcn_readfirstlane((int)cch);
            if ((int)cch >= nchunk) break;
            const int m0 = (F.bid + (int)cch * F.G) * 4;
            f32x4 v[4][4];
#pragma unroll
            for (int r = 0; r < 4; ++r) { const f32x4* xr = (const f32x4*)(x + (size_t)(m0 + r) * DMODEL) + F.lane;
#pragma unroll
                for (int j = 0; j < 4; ++j) v[r][j] = __builtin_nontemporal_load(xr + 64 * j); }
#pragma unroll
            for (int r = 0; r < 4; ++r) { u32x2* hr = (u32x2*)(hb + (size_t)(m0 + r) * DMODEL) + F.lane; float s = 0.f;
#pragma unroll
                for (int j = 0; j < 4; ++j) { u32x2 w; w.x = cvt_pk_bf16(v[r][j][0], v[r][j][1]); w.y = cvt_pk_bf16(v[r][j][2], v[r][j][3]); hr[64 * j] = w;
                    const float r0 = __uint_as_float(w.x << 16), r1 = __uint_as_float(w.x & 0xffff0000u), r2 = __uint_as_float(w.y << 16), r3 = __uint_as_float(w.y & 0xffff0000u); s += (r0 * r0 + r1 * r1) + (r2 * r2 + r3 * r3); }
                s = wave_sum(s);
                if (F.lane < 16) ss[(size_t)(m0 + r) * 16 + F.lane] = (F.lane == 0) ? s : 0.f; }
        }
    }
    CLK_X(1);
    {
        float* rope = (float*)(F.ws + WS_ROPE);
        for (int idx = F.bid * 512 + F.tid; idx < SEQ * 16; idx += F.G * 512) {
            const int pos = idx >> 4, f = idx & 15;
            const float inv_freq = powf(10000.0f, -(float)(2 * f) / 32.0f);
            const float ang = (float)pos * inv_freq;
            const double ad = (double)ang; const double kq = rint(ad * 0.15915494309189535);
            const float rr = (float)(ad - kq * 6.283185307179586);
            rope[pos * 32 + f] = cosf(rr); rope[pos * 32 + 16 + f] = sinf(rr);
        }
    }
    CLK_X(2);
    if (F.bid < 64) {
        const int li = F.bid >> 4, kc = F.bid & 15; const float* pos = a.in[10] + (size_t)li * 2048; const float* w1 = a.in[11] + (size_t)li * 2048 * 128;
        const int n = F.tid & 127, kq = F.tid >> 7; float s = 0.f;
#pragma unroll 8
        for (int k = kc * 128 + kq * 32; k < kc * 128 + kq * 32 + 32; ++k) s += pos[k] * w1[(size_t)k * 128 + n];
        LAS float* red = (LAS float*)(F.lds + 8 * 16384);
        red[F.tid] = s; __syncthreads();
        if (F.tid < 128) ((float*)(F.ws + WS_CB1))[(li * 16 + kc) * 128 + F.tid] = (red[F.tid] + red[128 + F.tid]) + (red[256 + F.tid] + red[384 + F.tid]);
        __syncthreads();
    }
    CLK_X(3);
    if (F.bid == 4) { bf16_t* kc = (bf16_t*)(F.ws + WS_KC); for (int i = F.tid; i < 8 * 64; i += 512) kc[((size_t)(i >> 6) * 512 + 511) * 64 + (i & 63)] = 0; }
}
constexpr int ASTR = 528;
constexpr int ASTR2 = 272;

__device__ __forceinline__ void conv_tile(Frame& F, int l, int tile) {
    const int T0 = tile * 64, tb = T0 & (SEQ - 1);
    const bf16_t* U = (const bf16_t*)(F.ws + WS_U); bf16_t* CAT = (bf16_t*)(F.ws + WS_CAT);
    LAS bf16_t* glu = (LAS bf16_t*)F.lds;
    LAS float* cv = (LAS float*)(F.lds + 49152);
    {
        u32x4 av[6], gv[6];
#pragma unroll
        for (int k = 0; k < 6; ++k) { int p = F.tid + 512 * k; p = p < 94 * 32 ? p : 94 * 32 - 1; const int r = p >> 5, c8 = (p & 31) * 8;
            const int rr = (tb - 30 + r >= 0) ? (T0 - 30 + r) : T0; const bf16_t* up = U + (size_t)rr * NU + c8;
            av[k] = *(const u32x4*)(up + UC_A); gv[k] = *(const u32x4*)(up + UC_G); }
#pragma unroll
        for (int k = 0; k < 6; ++k) { const int p = F.tid + 512 * k; const int r = p >> 5, c8 = (p & 31) * 8; const bool inb = (tb - 30 + r >= 0); u32x4 o;
#pragma unroll
            for (int e = 0; e < 4; ++e) {
                const float a0 = __uint_as_float(av[k][e] << 16), a1 = __uint_as_float(av[k][e] & 0xffff0000u), g0 = __uint_as_float(gv[k][e] << 16), g1 = __uint_as_float(gv[k][e] & 0xffff0000u);
                o[e] = inb ? cvt_pk_bf16(a0 * sigmoidf_(g0), a1 * sigmoidf_(g1)) : 0u; }
            if (p < 94 * 32) *(LAS u32x4*)(glu + r * 256 + c8) = o; }
    }
    __syncthreads();
    {
        typedef float f32x2v __attribute__((ext_vector_type(2)));
        const int cp = F.tid & 127, tq = F.tid >> 7; f32x2v w2[31];
        const float* dw = IN(F, 5) + (size_t)l * 31 * 256 + 2 * cp;
#pragma unroll
        for (int k = 0; k < 31; ++k) w2[k] = *(const f32x2v*)(dw + k * 256);
        const f32x2v bias2 = *(const f32x2v*)(IN(F, 6) + l * 256 + 2 * cp);
        const LAS unsigned* gl = (const LAS unsigned*)glu + cp;
        LAS f32x2v* cv2 = (LAS f32x2v*)cv + cp;
#pragma unroll 1
        for (int j = 0; j < 2; ++j) {
            const int r0 = 16 * tq + 8 * j; f32x2v x[38];
#pragma unroll
            for (int i = 0; i < 38; ++i) { const unsigned u = gl[(r0 + i) * 128]; x[i] = (f32x2v){__uint_as_float(u << 16), __uint_as_float(u & 0xffff0000u)}; }
#pragma unroll
            for (int tt = 0; tt < 8; ++tt) { f32x2v acc = bias2;
#pragma unroll
                for (int k = 0; k < 31; ++k) acc = __builtin_elementwise_fma(w2[k], x[tt + k], acc);
                cv2[(r0 + tt) * 128] = acc; }
        }
    }
    __syncthreads();
    {
        const f32x4 g4 = *((const f32x4*)(IN(F, 7) + l * 256) + F.lane), b4 = *((const f32x4*)(IN(F, 8) + l * 256) + F.lane);
        for (int tt = 0; tt < 8; ++tt) {
            const int row = 8 * F.wave + tt; const f32x4 x = *((const LAS f32x4*)(cv + row * 256) + F.lane);
            const float mean = wave_sum((x[0] + x[1]) + (x[2] + x[3])) * (1.f / 256.f); const f32x4 d = x - mean;
            const float var = wave_sum((d[0] * d[0] + d[1] * d[1]) + (d[2] * d[2] + d[3] * d[3])) * (1.f / 256.f); const float rstd = __builtin_amdgcn_rsqf(var + EPS);
            f32x4 y = d * rstd * g4 + b4;
#pragma unroll
            for (int e = 0; e < 4; ++e) y[e] = y[e] * sigmoidf_(y[e]);
            u32x2 wv; wv.x = cvt_pk_bf16(y[0], y[1]); wv.y = cvt_pk_bf16(y[2], y[3]);
            *((u32x2*)(CAT + (size_t)(T0 + row) * DMODEL + CC_CONV) + F.lane) = wv;
        }
    }
    __syncthreads();
}

__device__ __forceinline__ void pool_tile(Frame& F, int l, int tile) {
    const int T0 = tile * 64, tb = T0 & (SEQ - 1);
    const bf16_t* U = (const bf16_t*)(F.ws + WS_U); bf16_t* CAT = (bf16_t*)(F.ws + WS_CAT);
    LAS float* P = (LAS float*)F.lds;
    {
        u32x4 pvv[5];
#pragma unroll
        for (int k = 0; k < 5; ++k) { int p = F.tid + 512 * k; p = p < 79 * 32 ? p : 79 * 32 - 1; const int r = p >> 5, c8 = (p & 31) * 8;
            const int rr = (tb - 15 + r >= 0) ? (T0 - 15 + r) : T0; pvv[k] = *(const u32x4*)(U + (size_t)rr * NU + UC_POOL + c8); }
#pragma unroll
        for (int k = 0; k < 5; ++k) { const int p = F.tid + 512 * k; const int r = p >> 5, c8 = (p & 31) * 8; const bool inb = (tb - 15 + r >= 0); const u32x4 v = pvv[k];
            f32x4 lo = (f32x4){__uint_as_float(v[0] << 16), __uint_as_float(v[0] & 0xffff0000u), __uint_as_float(v[1] << 16), __uint_as_float(v[1] & 0xffff0000u)};
            f32x4 hi4 = (f32x4){__uint_as_float(v[2] << 16), __uint_as_float(v[2] & 0xffff0000u), __uint_as_float(v[3] << 16), __uint_as_float(v[3] & 0xffff0000u)};
            if (!inb) { lo = (f32x4){0.f, 0.f, 0.f, 0.f}; hi4 = lo; }
            if (p < 79 * 32) { *(LAS f32x4*)(P + r * 256 + c8) = lo; *(LAS f32x4*)(P + r * 256 + c8 + 4) = hi4; } }
    }
    __syncthreads();
    {
        const int c = F.tid & 255, half = F.tid >> 8, w = 2 << (c >> 6); const float invw = 1.0f / (float)w;
        float s = 0.f;
        for (int j = 1; j < w; ++j) s += P[(15 + 32 * half - j) * 256 + c];
        for (int i = 0; i < 32; ++i) {
            const int row = 32 * half + i, tpos = tb + row; const float xc = P[(15 + row) * 256 + c];
            s += xc;
            const float d = s * ((tpos + 1 < w) ? __builtin_amdgcn_rcpf((float)(tpos + 1)) : invw) - xc;
            s -= P[(15 + row - (w - 1)) * 256 + c];
            CAT[(size_t)(T0 + row) * DMODEL + CC_POOL + c] = f2bf(d);
        }
    }
    __syncthreads();
}

__device__ __forceinline__ void mla_tile(Frame& F, int l, int tile) {
    const int T0 = tile * 64, tb = T0 & (SEQ - 1);
    const bf16_t* U = (const bf16_t*)(F.ws + WS_U); const float* rope = (const float*)(F.ws + WS_ROPE);
    bf16_t* AQ = (bf16_t*)(F.ws + WS_AQKV); bf16_t* KR = (bf16_t*)(F.ws + WS_KR);
    {
        u32x2 qv[8]; unsigned kv[8];
#pragma unroll
        for (int tt = 0; tt < 8; ++tt) { const bf16_t* up = U + (size_t)(T0 + 8 * F.wave + tt) * NU; qv[tt] = *((const u32x2*)(up + UC_CQ) + F.lane); kv[tt] = *((const unsigned*)(up + UC_CKV) + F.lane); }
#pragma unroll
        for (int tt = 0; tt < 8; ++tt) {
            bf16_t* ar = AQ + (size_t)(T0 + 8 * F.wave + tt) * 384;
            { const u32x2 v = qv[tt];
              const float x0 = __uint_as_float(v.x << 16), x1 = __uint_as_float(v.x & 0xffff0000u), x2 = __uint_as_float(v.y << 16), x3 = __uint_as_float(v.y & 0xffff0000u);
              const float rs = __builtin_amdgcn_rsqf(wave_sum((x0 * x0 + x1 * x1) + (x2 * x2 + x3 * x3)) * (1.f / 256.f) + EPS);
              u32x2 w; w.x = cvt_pk_bf16(x0 * rs, x1 * rs); w.y = cvt_pk_bf16(x2 * rs, x3 * rs); *((u32x2*)ar + F.lane) = w; }
            { const unsigned v = kv[tt];
              const float x0 = __uint_as_float(v << 16), x1 = __uint_as_float(v & 0xffff0000u);
              const float rs = __builtin_amdgcn_rsqf(wave_sum(x0 * x0 + x1 * x1) * (1.f / 128.f) + EPS);
              *((unsigned*)(ar + 256) + F.lane) = cvt_pk_bf16(x0 * rs, x1 * rs); }
        }
    }
    for (int j = 0; j < 2; ++j) {
        const int idx = F.tid + 512 * j, tok = idx >> 4, i = idx & 15, pos = tb + tok; const bf16_t* up = U + (size_t)(T0 + tok) * NU + UC_KR;
        const float x1 = bf2f(up[i]), x2 = bf2f(up[16 + i]), cs = rope[pos * 32 + i], sn = rope[pos * 32 + 16 + i];
        bf16_t* kp = KR + (size_t)(T0 + tok) * 32; kp[i] = f2bf(x1 * cs - x2 * sn); kp[16 + i] = f2bf(x1 * sn + x2 * cs);
    }
}

__device__ __forceinline__ void compress_item(Frame& F, int l, int item) {
    const int i = item >> 6, b = (item >> 4) & 3, gq = item & 15, c0 = 32 * gq, tok0 = 16 * c0;
    const bf16_t* U = (const bf16_t*)(F.ws + WS_U); bf16_t* KC = (bf16_t*)(F.ws + WS_KC);
    LAS unsigned char* Tk = F.lds;
    LAS float* part = (LAS float*)(F.lds + 67584);
    LAS unsigned char* A2 = F.lds + 83968;
    {
        u32x4 tv[9];
#pragma unroll
        for (int k = 0; k < 9; ++k) { int p = F.tid + 512 * k; p = p < 528 * 8 ? p : 528 * 8 - 1; const int r = p >> 3, ch = p & 7;
            const int rr = (tok0 + r < SEQ) ? (tok0 + r) : (SEQ - 1); tv[k] = *(const u32x4*)(U + (size_t)(b * SEQ + rr) * NU + UC_KV + i * 64 + ch * 8); }
#pragma unroll
        for (int k = 0; k < 9; ++k) { const int p = F.tid + 512 * k; const int r = p >> 3, ch = p & 7; u32x4 v = tv[k];
            if (tok0 + r >= SEQ) v = (u32x4){0u, 0u, 0u, 0u};
            if (p < 528 * 8) *(LAS u32x4*)(Tk + r * 128 + ((ch ^ ((r >> 4) & 7)) * 16)) = v; }
    }
    __syncthreads();
    const int r32 = F.lane & 31, hi = F.lane >> 5, cb = F.wave & 3, kh = F.wave >> 2;
    const unsigned char* wl = (const unsigned char*)(F.ws + WS_W + (size_t)l * W_LAYER);
    f32x16 acc = {};
    {
        const bf16_t* bp = (const bf16_t*)(wl + WO_C1) + (size_t)i * 128 * 2048 + (size_t)(cb * 32 + r32) * 2048 + hi * 8;
#pragma unroll 8
        for (int ks = kh * 64; ks < kh * 64 + 64; ++ks) {
            const int ll = ks >> 2, dq = ks & 3, token = 16 * r32 + ll, chunk = dq * 2 + hi;
            const bf16x8 av = *(const LAS bf16x8*)(Tk + token * 128 + ((chunk ^ ((token >> 4) & 7)) * 16));
            const bf16x8 bv = *(const bf16x8*)(bp + ks * 16);
            acc = __builtin_amdgcn_mfma_f32_32x32x16_bf16(av, bv, acc, 0, 0, 0);
        }
    }
    if (kh == 1) {
#pragma unroll
        for (int r = 0; r < 16; ++r) part[cb * 1024 + r * 64 + F.lane] = acc[r];
    }
    __syncthreads();
    if (kh == 0) {
        float bias = 0.f; { const float* cbp = (const float*)(F.ws + WS_CB1) + (size_t)(l * 2 + i) * 16 * 128 + cb * 32 + r32;
#pragma unroll
            for (int kc = 0; kc < 16; ++kc) bias += cbp[kc * 128]; }
#pragma unroll
        for (int r = 0; r < 16; ++r) { float h = acc[r] + part[cb * 1024 + r * 64 + F.lane] + bias; h = h * sigmoidf_(h);
            *(LAS bf16_t*)(A2 + crow(r, hi) * ASTR2 + (cb * 32 + r32) * 2) = f2bf(h); }
    }
    __syncthreads();
    if (F.wave < 2) {
        const f32x16 o = small_mm<128>(A2, ASTR2, (const bf16_t*)(wl + WO_C2) + (size_t)i * 64 * 128 + (size_t)F.wave * 32 * 128, F.lane);
#pragma unroll
        for (int r = 0; r < 16; ++r) { const int row = c0 + crow(r, hi); KC[((size_t)(i * 4 + b) * 512 + row) * 64 + F.wave * 32 + r32] = (row < 511) ? f2bf(o[r]) : (bf16_t)0; }
    }
    __syncthreads();
}

__device__ __forceinline__ void phaseB(Frame F, int l) {
    LAUNDER(F);
    for (int t = F.bid; t < MTOK / 64; t += F.G) conv_tile(F, l, t);
    for (int t = F.bid; t < MTOK / 64; t += F.G) pool_tile(F, l, t);
    for (int t = F.bid; t < MTOK / 64; t += F.G) mla_tile(F, l, t);
    for (int t = F.G - 1 - F.bid; t < 128; t += F.G) compress_item(F, l, t);
}
namespace pg8 {
struct EpiStore {
    static constexpr bool PERM = true, AFTER_DRAIN = false;
    bf16_t* O;
    __device__ __forceinline__ void operator()(const f32x4 (&acc)[2][2][4][2], const Unit& u, int wr, int wc, int fr, int fq) const {
        { int ln_; asm volatile("v_mbcnt_lo_u32_b32 %0, -1, 0\n\tv_mbcnt_hi_u32_b32 %0, -1, %0" : "=v"(ln_)); fr = ln_ & 15; fq = ln_ >> 4; }
        bf16_t* lp = O + (size_t)(u.pm * BM + wr * 64 + fr) * 1024 + u.pn * BM + wc * 32 + 8 * fq;
#pragma unroll
        for (int ai = 0; ai < 2; ++ai)
#pragma unroll
            for (int m = 0; m < 4; ++m)
#pragma unroll
                for (int bj = 0; bj < 2; ++bj) { const f32x4 v0 = acc[ai][bj][m][0], v1 = acc[ai][bj][m][1];
                    u32x4 w; w.x = cvt_pk_bf16(v0[0], v0[1]); w.y = cvt_pk_bf16(v0[2], v0[3]); w.z = cvt_pk_bf16(v1[0], v1[1]); w.w = cvt_pk_bf16(v1[2], v1[3]);
                    *(u32x4*)(lp + (ai * HALF + m * 16) * 1024 + bj * HALF) = w; }
    }
};
}

__device__ __forceinline__ void phaseB2(Frame F, int l) {
    LAUNDER(F);
#ifndef SKIP_QKV
    {
        pg8::Gemm g{(const bf16_t*)(F.ws + WS_AQKV), (const bf16_t*)(F.ws + WS_W + (size_t)l * W_LAYER + WO_QKV), MTOK, 1024, 384};
        pg8::StaticOrder S; S.init(MTOK, 1024, F.G, F.bid);
        pg8::EpiStore E{(bf16_t*)(F.ws + WS_QKVO)};
        pg8::gemm_phase<pg8::EpiStore, pg8::StaticOrder, true, true>(F.lds, g, S, E, F.wave);
    }
#endif
}
namespace att {
constexpr int SLOTB = 20480, VOFF = 12288;
constexpr int L_RING = 0, L_OACC = 4 * SLOTB, L_IMP = L_OACC, L_WS = L_OACC + 65536, L_BT = L_WS + 2048, L_SEL = L_BT + 2304, L_GATE = L_SEL + 1024, L_END = L_GATE + 3072;
static_assert(L_END <= LDS_CTL && 6 * SLOTB <= L_WS, "attention LDS");
constexpr float NEG_INF = -__builtin_inff();

__device__ __forceinline__ float btab(const LAS float* t, int d) { return t[min(max(d, 0), 128)]; }
struct TileSrc { const bf16_t* K; int kpitch; const bf16_t* V; int vpitch; const bf16_t* K2; int k2pitch; };

struct DmaPtr { const bf16_t* k; const bf16_t* v; const bf16_t* k2; };
template <int DQK> __device__ __forceinline__ DmaPtr dma_init(const TileSrc& T, int kv0, int wid, int lane) {
    DmaPtr p; p.k = T.K + (size_t)(kv0 + lane) * T.kpitch + wid * 8;
    p.v = T.V + (size_t)(kv0 + 16 * (wid & 3) + (lane >> 2)) * T.vpitch + (wid >> 2) * 32 + (lane & 3) * 8;
    p.k2 = (DQK == 96) ? T.K2 + (size_t)(kv0 + lane) * T.k2pitch + (wid & 3) * 8 : nullptr; return p;
}
template <int DQK> __device__ __forceinline__ void dma_tile(DmaPtr& p, const TileSrc& T, LAS unsigned char* slot, int wid, int par) {
    __builtin_amdgcn_global_load_lds((const unsigned*)p.k, (LAS unsigned*)(slot + wid * 1024), 16, 0, 0);
    if (DQK == 96) { if ((wid < 4) == (par == 0)) __builtin_amdgcn_global_load_lds((const unsigned*)p.k2, (LAS unsigned*)(slot + ((wid & 3) + 8) * 1024), 16, 0, 0); }
    __builtin_amdgcn_global_load_lds((const unsigned*)p.v, (LAS unsigned*)(slot + VOFF + wid * 1024), 16, 0, 0);
    p.k += (size_t)64 * T.kpitch; p.v += (size_t)64 * T.vpitch; if (DQK == 96) p.k2 += (size_t)64 * T.k2pitch;
}
#define ATT_VMWAIT(n) asm volatile("s_waitcnt vmcnt(" #n ")" ::: "memory")
__device__ __forceinline__ void wait_tiles(int rem, bool three) {
    if (three) { if (rem == 0) ATT_VMWAIT(0); else if (rem == 1) ATT_VMWAIT(3); else ATT_VMWAIT(6); }
    else       { if (rem == 0) ATT_VMWAIT(0); else if (rem == 1) ATT_VMWAIT(2); else ATT_VMWAIT(4); }
}
template <int DQK, int TPB, class Body> __device__ __forceinline__ void tile_loop_n(const TileSrc& T, int NT, int kv_first, Body body, LAS unsigned char* ring, int wid, int lane) {
    constexpr int NSLOT = 2 * TPB;
    DmaPtr dp = dma_init<DQK>(T, kv_first, wid, lane);
#pragma unroll
    for (int k = 0; k < TPB; ++k) if (k < NT) dma_tile<DQK>(dp, T, ring + k * SLOTB, wid, k & 1);
    int sbase = 0;
    for (int i = 0; i < NT; i += TPB) {
        ATT_VMWAIT(0);
        __builtin_amdgcn_s_barrier();
        const int snext = TPB - sbase;
#pragma unroll
        for (int k = 0; k < TPB; ++k) if (i + TPB + k < NT) dma_tile<DQK>(dp, T, ring + (snext + k) * SLOTB, wid, (i + TPB + k) & 1);
#pragma unroll
        for (int k = 0; k < TPB; ++k) if (i + k < NT) body(i + k, ring + (sbase + k) * SLOTB);
        sbase = snext;
    }
    asm volatile("s_waitcnt lgkmcnt(0)" ::: "memory");
    __builtin_amdgcn_s_barrier();
}
template <int DQK, class Body> __device__ __forceinline__ void tile_loop(const TileSrc& T, int NT, int kv_first, Body body, LAS unsigned char* ring, int wid, int lane) {
    tile_loop_n<DQK, 2>(T, NT, kv_first, body, ring, wid, lane);
}

struct Chain { int sbase; bool primed; };
template <int DQK, int DQKN, class Body> __device__ __forceinline__ void tile_loop_c(const TileSrc& T, int NT, int kv_first, Body body, LAS unsigned char* ring, int wid, int lane,
                                                                                     Chain& ch, const TileSrc* Tn, int NTn, int kvn) {
    int sbase = ch.primed ? ch.sbase : 0;
    DmaPtr dp = dma_init<DQK>(T, kv_first + (ch.primed ? 64 * (NT < 2 ? NT : 2) : 0), wid, lane);
    if (!ch.primed) { for (int k = 0; k < 2; ++k) if (k < NT) dma_tile<DQK>(dp, T, ring + k * SLOTB, wid, k); }
    for (int i = 0; i < NT; i += 2) {
        ATT_VMWAIT(0);
        __builtin_amdgcn_s_barrier();
        const int snext = 2 - sbase;
        if (i + 2 < NT) { dma_tile<DQK>(dp, T, ring + snext * SLOTB, wid, 0); if (i + 3 < NT) dma_tile<DQK>(dp, T, ring + (snext + 1) * SLOTB, wid, 1); }
        else if (Tn) { DmaPtr np = dma_init<DQKN>(*Tn, kvn, wid, lane); dma_tile<DQKN>(np, *Tn, ring + snext * SLOTB, wid, 0); if (NTn > 1) dma_tile<DQKN>(np, *Tn, ring + (snext + 1) * SLOTB, wid, 1); }
        body(i, ring + sbase * SLOTB);
        if (i + 1 < NT) body(i + 1, ring + (sbase + 1) * SLOTB);
        sbase = snext;
    }
    if (Tn) { ch.primed = true; ch.sbase = sbase; }
    else { ch.primed = false; asm volatile("s_waitcnt lgkmcnt(0)" ::: "memory"); __builtin_amdgcn_s_barrier(); }
}

template <int DQK, class Front, class Back> __device__ __forceinline__ void stag_loop(const TileSrc& T, int NT, int kv_first, Front front, Back back, LAS unsigned char* ring, int wid, int lane) {
#ifdef STAG_ODD
    const bool late = (wid & 1) != 0;
#else
    const bool late = wid >= 4;
#endif
    DmaPtr dp = dma_init<DQK>(T, kv_first, wid, lane);
    for (int i = 0; i < 2; ++i) if (i < NT) dma_tile<DQK>(dp, T, ring + i * SLOTB, wid, i);
    for (int i = 0; i < NT; ++i) {
        if (i + 1 < NT) { if (DQK == 96 && ((wid < 4) == (((i + 1) & 1) == 0))) ATT_VMWAIT(3); else ATT_VMWAIT(2); } else ATT_VMWAIT(0);
        __builtin_amdgcn_s_barrier();
        if (i + 2 < NT) dma_tile<DQK>(dp, T, ring + ((i + 2) & 3) * SLOTB, wid, i & 1);
        if (late) { if (i > 0) back(i - 1, ring + ((i - 1) & 3) * SLOTB); front(i, ring + (i & 3) * SLOTB); }
        else      { front(i, ring + (i & 3) * SLOTB); back(i, ring + (i & 3) * SLOTB); }
    }
    if (late) back(NT - 1, ring + ((NT - 1) & 3) * SLOTB);
    asm volatile("s_waitcnt lgkmcnt(0)" ::: "memory");
    __builtin_amdgcn_s_barrier();
}

template <int DQK> __device__ __forceinline__ void qk(f32x16& p0, f32x16& p1, const LAS unsigned char* kslot, const bf16x8* qf, float cinit, int r32, int hi) {
#pragma unroll
    for (int r = 0; r < 16; ++r) { p0[r] = cinit; p1[r] = cinit; }
    const LAS unsigned char* kb = kslot + hi * 1024 + r32 * 16;
    bf16x8 kf[DQK / 8];
#pragma unroll
    for (int d0 = 0; d0 < DQK / 16; ++d0) { kf[2 * d0] = *(const LAS bf16x8*)(kb + d0 * 2048); kf[2 * d0 + 1] = *(const LAS bf16x8*)(kb + d0 * 2048 + 512); }
    __builtin_amdgcn_sched_barrier(0);
#pragma unroll
    for (int d0 = 0; d0 < DQK / 16; ++d0) {
        p0 = __builtin_amdgcn_mfma_f32_32x32x16_bf16(kf[2 * d0], qf[d0], p0, 0, 0, 0);
        p1 = __builtin_amdgcn_mfma_f32_32x32x16_bf16(kf[2 * d0 + 1], qf[d0], p1, 0, 0, 0);
    }
}
template <int DQK> __device__ __forceinline__ void qk_c(f32x16& p0, f32x16& p1, const LAS unsigned char* kslot, const bf16x8* qf, const f32x16& c, int r32, int hi) {
    const LAS unsigned char* kb = kslot + hi * 1024 + r32 * 16;
    bf16x8 kf[DQK / 8];
#pragma unroll
    for (int d0 = 0; d0 < DQK / 16; ++d0) { kf[2 * d0] = *(const LAS bf16x8*)(kb + d0 * 2048); kf[2 * d0 + 1] = *(const LAS bf16x8*)(kb + d0 * 2048 + 512); }
    __builtin_amdgcn_sched_barrier(0);
    p0 = __builtin_amdgcn_mfma_f32_32x32x16_bf16(kf[0], qf[0], c, 0, 0, 0);
    p1 = __builtin_amdgcn_mfma_f32_32x32x16_bf16(kf[1], qf[0], c, 0, 0, 0);
#pragma unroll
    for (int d0 = 1; d0 < DQK / 16; ++d0) {
        p0 = __builtin_amdgcn_mfma_f32_32x32x16_bf16(kf[2 * d0], qf[d0], p0, 0, 0, 0);
        p1 = __builtin_amdgcn_mfma_f32_32x32x16_bf16(kf[2 * d0 + 1], qf[d0], p1, 0, 0, 0);
    }
}
__device__ __forceinline__ void mfma_pad(f32x16& p) { asm volatile("s_nop 7\n\ts_nop 7\n\ts_nop 3" : "+v"(p)); }
__device__ __forceinline__ float max3f(float a, float b, float c) { float r; asm("v_max3_f32 %0, %1, %2, %3" : "=v"(r) : "v"(a), "v"(b), "v"(c)); return r; }
__device__ __forceinline__ float half_swap_max(float v) { auto rr = __builtin_amdgcn_permlane32_swap(__float_as_uint(v), __float_as_uint(v), false, false); return fmaxf(__uint_as_float(rr[0]), __uint_as_float(rr[1])); }
__device__ __forceinline__ float half_swap_sum(float v) { auto rr = __builtin_amdgcn_permlane32_swap(__float_as_uint(v), __float_as_uint(v), false, false); return __uint_as_float(rr[0]) + __uint_as_float(rr[1]); }
__device__ __forceinline__ float rowmax(f32x16& p0, f32x16& p1) {
    mfma_pad(p0); mfma_pad(p1);
    float a = max3f(p0[0], p1[0], p0[1]), b = max3f(p1[1], p0[2], p1[2]);
#pragma unroll
    for (int r = 3; r < 15; r += 2) { a = max3f(a, p0[r], p1[r]); b = max3f(b, p0[r + 1], p1[r + 1]); }
    a = max3f(a, p0[15], p1[15]);
    return half_swap_max(fmaxf(a, b));
}
__device__ __forceinline__ void pv(f32x16 (&o)[2], const f32x16& p0, const f32x16& p1, const LAS unsigned char* vslot, int lane) {
    u32x4 pw[4];
#pragma unroll
    for (int e = 0; e < 4; ++e) { pw[0][e] = cvt_pk_bf16(p0[2 * e], p0[2 * e + 1]); pw[1][e] = cvt_pk_bf16(p0[8 + 2 * e], p0[9 + 2 * e]);
                                  pw[2][e] = cvt_pk_bf16(p1[2 * e], p1[2 * e + 1]); pw[3][e] = cvt_pk_bf16(p1[8 + 2 * e], p1[9 + 2 * e]); }
    const int hi = lane >> 5;
    const unsigned vb = (unsigned)(size_t)vslot + ((lane >> 4) & 1) * 32 + (lane & 3) * 8 + (4 * hi + ((lane & 15) >> 2)) * 64;
#pragma unroll
    for (int d0 = 0; d0 < 2; ++d0) {
        s16x4 lo[4], hh[4];
#pragma unroll
        for (int ks = 0; ks < 4; ++ks) {
            asm volatile("ds_read_b64_tr_b16 %0, %1 offset:%c2" : "=&v"(lo[ks]) : "v"(vb), "i"(d0 * 4096 + ks * 1024) : "memory");
            asm volatile("ds_read_b64_tr_b16 %0, %1 offset:%c2" : "=&v"(hh[ks]) : "v"(vb), "i"(d0 * 4096 + ks * 1024 + 512) : "memory");
        }
        asm volatile("s_waitcnt lgkmcnt(0)" ::: "memory"); __builtin_amdgcn_sched_barrier(0);
#pragma unroll
        for (int ks = 0; ks < 4; ++ks) {
            const bf16x8 vf = (bf16x8){lo[ks][0], lo[ks][1], lo[ks][2], lo[ks][3], hh[ks][0], hh[ks][1], hh[ks][2], hh[ks][3]};
            o[d0] = __builtin_amdgcn_mfma_f32_32x32x16_bf16(__builtin_bit_cast(bf16x8, pw[ks]), vf, o[d0], 0, 0, 0);
        }
    }
}
__device__ __forceinline__ void softmax_pv(f32x16& p0, f32x16& p1, float& m, float& l, f32x16 (&o)[2], const LAS unsigned char* vslot, LAS float* wsf, int lane) {
    const int r32 = lane & 31, hi = lane >> 5;
    const float rm = rowmax(p0, p1), mn = fmaxf(m, rm), ms = (mn == NEG_INF) ? 0.f : mn;
    const float alpha = __builtin_amdgcn_exp2f(m - ms);
    const bool need = __any(mn > m) != 0;
    m = mn;
    float sum = 0.f;
#pragma unroll
    for (int r = 0; r < 16; ++r) { p0[r] = __builtin_amdgcn_exp2f(p0[r] - ms); p1[r] = __builtin_amdgcn_exp2f(p1[r] - ms); sum += p0[r] + p1[r]; }
    l = l * alpha + sum;
    if (need) {
        if (hi == 0) wsf[r32] = alpha;
        __builtin_amdgcn_fence(__ATOMIC_RELEASE, "wavefront"); __builtin_amdgcn_wave_barrier();
#pragma unroll
        for (int r = 0; r < 16; ++r) { const float f = wsf[crow(r, hi)]; o[0][r] *= f; o[1][r] *= f; }
    }
    pv(o, p0, p1, vslot, lane);
}
struct SmState { float mref, l; f32x16 negm; bool started; };
__device__ __forceinline__ void sm_init(SmState& s, float c) { s.mref = 0.f; s.l = 0.f; s.started = false;
#pragma unroll
    for (int r = 0; r < 16; ++r) s.negm[r] = c;
    asm volatile("" : "+v"(s.negm)); }
__device__ __forceinline__ void sm_front(f32x16& p0, f32x16& p1, SmState& s, f32x16 (&o)[2], LAS float* wsf, int lane) {
    const int r32 = lane & 31, hi = lane >> 5;
    const float rm = rowmax(p0, p1);
    if (!s.started) {
        const float d = (rm == NEG_INF) ? 0.f : rm; s.mref = d; s.started = true;
#pragma unroll
        for (int r = 0; r < 16; ++r) { p0[r] -= d; p1[r] -= d; s.negm[r] -= d; }
    } else if (__any(rm > 8.0f)) {
        const float d = fmaxf(rm, 0.f), alpha = __builtin_amdgcn_exp2f(-d); s.mref += d; s.l *= alpha;
#pragma unroll
        for (int r = 0; r < 16; ++r) { p0[r] -= d; p1[r] -= d; s.negm[r] -= d; }
        if (hi == 0) wsf[r32] = alpha;
        __builtin_amdgcn_fence(__ATOMIC_RELEASE, "wavefront"); __builtin_amdgcn_wave_barrier();
#pragma unroll
        for (int r = 0; r < 16; ++r) { const float f = wsf[crow(r, hi)]; o[0][r] *= f; o[1][r] *= f; }
    }
}
__device__ __forceinline__ void sm_exp(f32x16& p0, f32x16& p1, SmState& s) {
    float sum = 0.f;
#pragma unroll
    for (int r = 0; r < 16; ++r) { p0[r] = __builtin_amdgcn_exp2f(p0[r]); p1[r] = __builtin_amdgcn_exp2f(p1[r]); sum += p0[r] + p1[r]; }
    s.l += sum;
}
__device__ __forceinline__ void softmax_pv2(f32x16& p0, f32x16& p1, SmState& s, f32x16 (&o)[2], const LAS unsigned char* vslot, LAS float* wsf, int lane) {
    sm_front(p0, p1, s, o, wsf, lane); sm_exp(p0, p1, s); pv(o, p0, p1, vslot, lane);
}
template <int DQK, class Live, class Mask>
__device__ __forceinline__ void pipe_loop(const TileSrc& T, int NT, int kv_first, const bf16x8* qf, SmState& sm, f32x16 (&o)[2], Live live, Mask mask, LAS unsigned char* ring, LAS float* wsf, int wid, int lane) {
    const bool three = (DQK == 96) && (wid < 4); const int r32 = lane & 31, hi = lane >> 5;
    DmaPtr dp = dma_init<DQK>(T, kv_first, wid, lane);
    for (int i = 0; i < 3; ++i) if (i < NT) dma_tile<DQK>(dp, T, ring + i * SLOTB, wid, 0);
    wait_tiles((NT - 1) < 2 ? (NT - 1) : 2, three);
    __builtin_amdgcn_s_barrier();
    f32x16 a0, a1, b0, b1;
    if (live(0)) { qk_c<DQK>(a0, a1, ring, qf, sm.negm, r32, hi); mask(0, a0, a1); }
#define ATT_STEP(i, C0, C1, N0, N1) do { \
        const bool has_n = (i) + 1 < NT; \
        if (has_n) wait_tiles((NT - 2 - (i)) < 1 ? (NT - 2 - (i)) : 1, three); \
        __builtin_amdgcn_s_barrier(); \
        if ((i) + 3 < NT) dma_tile<DQK>(dp, T, ring + (((i) + 3) & 3) * SLOTB, wid, 0); \
        const bool lc = live(i), ln = has_n && live((i) + 1); \
        const LAS unsigned char* sc_ = ring + ((i) & 3) * SLOTB; const LAS unsigned char* sn_ = ring + (((i) + 1) & 3) * SLOTB; \
        if (lc) sm_front(C0, C1, sm, o, wsf, lane); \
        if (lc && ln) { qk_c<DQK>(N0, N1, sn_, qf, sm.negm, r32, hi); sm_exp(C0, C1, sm); mask((i) + 1, N0, N1); pv(o, C0, C1, sc_ + VOFF, lane); } \
        else { if (ln) { qk_c<DQK>(N0, N1, sn_, qf, sm.negm, r32, hi); mask((i) + 1, N0, N1); } \
               if (lc) { sm_exp(C0, C1, sm); pv(o, C0, C1, sc_ + VOFF, lane); } } \
    } while (0)
    for (int i = 0; i < NT; i += 2) {
        ATT_STEP(i, a0, a1, b0, b1);
        if (i + 1 < NT) ATT_STEP(i + 1, b0, b1, a0, a1);
    }
#undef ATT_STEP
    asm volatile("s_waitcnt lgkmcnt(0)" ::: "memory");
    __builtin_amdgcn_s_barrier();
}
__device__ __forceinline__ void scaled_add(LAS float* oacc, const f32x16 (&o)[2], float f, LAS float* wsf, int lane, bool assign) {
    const int r32 = lane & 31, hi = lane >> 5;
    if (hi == 0) wsf[32 + r32] = f;
    __builtin_amdgcn_fence(__ATOMIC_RELEASE, "wavefront"); __builtin_amdgcn_wave_barrier();
#pragma unroll
    for (int r = 0; r < 16; ++r) { const float g = wsf[32 + crow(r, hi)];
        if (assign) { oacc[r * 64 + lane] = o[0][r] * g; oacc[(16 + r) * 64 + lane] = o[1][r] * g; } else { oacc[r * 64 + lane] += o[0][r] * g; oacc[(16 + r) * 64 + lane] += o[1][r] * g; } }
}
__device__ __forceinline__ void store_oacc(const LAS float* oacc, bf16_t* dst, int pitch, int lane) {
    const int r32 = lane & 31, hi = lane >> 5;
#pragma unroll
    for (int r = 0; r < 16; ++r) { bf16_t* rp = dst + (size_t)crow(r, hi) * pitch; rp[r32] = f2bf(oacc[r * 64 + lane]); rp[32 + r32] = f2bf(oacc[(16 + r) * 64 + lane]); }
}

__device__ __forceinline__ void mla_unit(Frame F, int b, int h, int qb, Chain& ch, int qb_next  ) {
    LAUNDER(F);
    TICK(F, 15);
    LAS unsigned char* lds = F.lds; LAS float* wsf = (LAS float*)(lds + L_WS) + F.wave * 64;
    const int wid = F.wave, lane = F.lane, r32 = lane & 31, hi = lane >> 5;
    const bf16_t* QO = (const bf16_t*)(F.ws + WS_QKVO) + (size_t)b * SEQ * 1024;
    TileSrc T; T.K = QO + 384 + h * 128; T.kpitch = 1024; T.V = QO + 384 + h * 128 + 64; T.vpitch = 1024; T.K2 = (const bf16_t*)(F.ws + WS_KR) + (size_t)b * SEQ * 32; T.k2pitch = 32;
    const int q0 = qb * 256, qw0 = q0 + 32 * wid, qrow = qw0 + r32;
    bf16x8 qf[6];
#pragma unroll
    for (int d0 = 0; d0 < 6; ++d0) qf[d0] = *(const bf16x8*)(QO + (size_t)qrow * 1024 + h * 96 + d0 * 16 + hi * 8);
    {
        const float* rp = (const float*)(F.ws + WS_ROPE) + (size_t)qrow * 32 + 8 * hi;
        const f32x4 c0 = *(const f32x4*)rp, c1 = *(const f32x4*)(rp + 4), s0 = *(const f32x4*)(rp + 16), s1 = *(const f32x4*)(rp + 20);
#pragma unroll
        for (int j = 0; j < 8; ++j) { const float cs = j < 4 ? c0[j & 3] : c1[j & 3], sn = j < 4 ? s0[j & 3] : s1[j & 3];
            const float x1 = bf2f((unsigned short)qf[4][j]), x2 = bf2f((unsigned short)qf[5][j]);
            qf[4][j] = (short)f2bf(x1 * cs - x2 * sn); qf[5][j] = (short)f2bf(x1 * sn + x2 * cs); }
    }
    SmState sm; sm_init(sm, 0.f); f32x16 o[2]; o[0] = f32x16{}; o[1] = f32x16{};
    const int NT = (q0 + 256) / 64;
    TICK(F, 8);
#ifdef USE_STAG
    f32x16 p0, p1;
    stag_loop<96>(T, NT, 0,
        [&](int t, const LAS unsigned char* slot) { const int kv0 = 64 * t;
            if (kv0 <= qw0 + 31) {
                qk_c<96>(p0, p1, slot, qf, sm.negm, r32, hi);
                if (kv0 + 63 > qw0) {
#pragma unroll
                    for (int r = 0; r < 16; ++r) { const int kv = kv0 + crow(r, hi); if (kv > qrow) p0[r] = NEG_INF; if (kv + 32 > qrow) p1[r] = NEG_INF; }
                } } },
        [&](int t, const LAS unsigned char* slot) { if (64 * t <= qw0 + 31) softmax_pv2(p0, p1, sm, o, slot + VOFF, wsf, lane); },
        lds + L_RING, wid, lane);
#else
    tile_loop_c<96, 96>(T, NT, 0, [&](int t, const LAS unsigned char* slot) {
        const int kv0 = 64 * t;
        if (kv0 <= qw0 + 31) {
            f32x16 p0, p1; qk_c<96>(p0, p1, slot, qf, sm.negm, r32, hi);
            if (kv0 + 63 > qw0) {
#pragma unroll
                for (int r = 0; r < 16; ++r) { const int kv = kv0 + crow(r, hi); if (kv > qrow) p0[r] = NEG_INF; if (kv + 32 > qrow) p1[r] = NEG_INF; }
            }
            softmax_pv2(p0, p1, sm, o, slot + VOFF, wsf, lane);
        }
    }, lds + L_RING, wid, lane, ch, qb_next >= 0 ? &T : nullptr, qb_next >= 0 ? 4 * (qb_next + 1) : 0, 0);
#endif
    TICK(F, 9);
    const float lt = half_swap_sum(sm.l); const float inv = lt > 0.f ? __builtin_amdgcn_rcpf(lt) : 0.f;
    LAS float* oacc = (LAS float*)(lds + L_OACC) + F.wave * 2048;
    scaled_add(oacc, o, inv, wsf, lane, true);
    store_oacc(oacc, (bf16_t*)(F.ws + WS_CAT) + (size_t)(b * SEQ + qw0) * DMODEL + CC_MLA + h * 64, DMODEL, lane);
    TICK(F, 10);
}

__device__ __forceinline__ void nsa_unit(Frame F, int b, int qt, Chain& ch, int qt_next  ) {
    LAUNDER(F);
    LAS unsigned char* lds = F.lds; LAS float* wsf = (LAS float*)(lds + L_WS) + F.wave * 64;
    LAS float* bt = (LAS float*)(lds + L_BT); LAS float* imp = (LAS float*)(lds + L_IMP); LAS unsigned* sel = (LAS unsigned*)(lds + L_SEL); LAS float* gate = (LAS float*)(lds + L_GATE);
    LAS float* outacc = (LAS float*)(lds + L_OACC) + F.wave * 2048;
    const int wid = F.wave, lane = F.lane, tid = F.tid, r32 = lane & 31, hi = lane >> 5, h = wid & 3, qh = wid >> 2;
    const int t0 = 64 * qt, qi = 32 * qh + r32, t = t0 + qi;
    const bf16_t* U = (const bf16_t*)(F.ws + WS_U) + (size_t)b * SEQ * NU;
    bf16x8 qf[4];
#pragma unroll
    for (int d0 = 0; d0 < 4; ++d0) qf[d0] = *(const bf16x8*)(U + (size_t)t * NU + UC_Q + h * 64 + d0 * 16 + hi * 8);
    TICK(F, 15);
    __syncthreads();
    for (int idx = tid; idx < 64 * 12; idx += 512) { const int q = idx / 12, k = idx - q * 12; gate[idx] = sigmoidf_(bf2f(U[(size_t)(t0 + q) * NU + UC_GATE + k])); }
    __syncthreads();
    const LAS float* bth = bt + h * 132;
    TileSrc Tc, Ts, Tw;
    { const bf16_t* KC = (const bf16_t*)(F.ws + WS_KC);
      Tc.K = KC + (size_t)(0 * 4 + b) * 512 * 64; Tc.kpitch = 64; Tc.V = KC + (size_t)(1 * 4 + b) * 512 * 64; Tc.vpitch = 64; Tc.K2 = nullptr; Tc.k2pitch = 0;
      Ts.K = U + UC_KV + 128; Ts.kpitch = NU; Ts.V = U + UC_KV + 192; Ts.vpitch = NU; Ts.K2 = nullptr; Ts.k2pitch = 0;
      Tw.K = U + UC_KV + 256; Tw.kpitch = NU; Tw.V = U + UC_KV + 320; Tw.vpitch = NU; Tw.K2 = nullptr; Tw.k2pitch = 0; }
    const int j_lo = qt >= 8 ? qt - 8 : 0;
    TICK(F, 1);
    {
        const int hc = r32 >> 3, q8 = r32 & 7, qc = 8 * wid + q8, tc = t0 + qc;
        const LAS float* bthc = bt + hc * 132;
        bf16x8 qfc[4];
#pragma unroll
        for (int d0 = 0; d0 < 4; ++d0) qfc[d0] = *(const bf16x8*)(U + (size_t)tc * NU + UC_Q + hc * 64 + d0 * 16 + hi * 8);
        LAS float* impw = imp + wid * 1024;
        const TileSrc& T = Tc;
        const int NTc = (((t0 + 32) >> 4) >> 6) + 1;
        float m = NEG_INF, l = 0.f;
        tile_loop_c<64, 64>(T, NTc, 0, [&](int ct, const LAS unsigned char* slot) {
            f32x16 p0, p1; qk<64>(p0, p1, slot, qfc, 0.f, r32, hi);
#pragma unroll
            for (int r = 0; r < 16; ++r) { const int c = 64 * ct + crow(r, hi); const int d0 = tc - (16 * c + 31), d1 = d0 - 512;
                const float b0 = btab(bthc, d0), b1 = btab(bthc, d1); p0[r] = (d0 >= 0) ? p0[r] + b0 : NEG_INF; p1[r] = (d1 >= 0) ? p1[r] + b1 : NEG_INF; }
            const float rm = rowmax(p0, p1), mn = fmaxf(m, rm), ms = (mn == NEG_INF) ? 0.f : mn; const float alpha = __builtin_amdgcn_exp2f(m - ms); m = mn; float sum = 0.f;
#pragma unroll
            for (int r = 0; r < 16; ++r) sum += __builtin_amdgcn_exp2f(p0[r] - ms) + __builtin_amdgcn_exp2f(p1[r] - ms);
            l = l * alpha + sum;
        }, lds + L_RING, wid, lane, ch, &T, NTc, 0);
        TICK(F, 2);
        const float lt = half_swap_sum(l), inv = lt > 0.f ? __builtin_amdgcn_rcpf(lt) : 0.f, ms = (m == NEG_INF) ? 0.f : m;
        const bool need_imp = qt >= 16;
        f32x16 o[2]; o[0] = f32x16{}; o[1] = f32x16{};
        float carry = 0.f;
        tile_loop_c<64, 64>(T, NTc, 0, [&](int ct, const LAS unsigned char* slot) {
            f32x16 p0, p1; qk<64>(p0, p1, slot, qfc, 0.f, r32, hi);
#pragma unroll
            for (int r = 0; r < 16; ++r) { const int c = 64 * ct + crow(r, hi); const int d0 = tc - (16 * c + 31), d1 = d0 - 512;
                const float b0 = btab(bthc, d0), b1 = btab(bthc, d1);
                p0[r] = (d0 >= 0) ? __builtin_amdgcn_exp2f(p0[r] + b0 - ms) * inv : 0.f;
                p1[r] = (d1 >= 0) ? __builtin_amdgcn_exp2f(p1[r] + b1 - ms) * inv : 0.f; }
            if (need_imp) {
                float e[8], bq[8];
#pragma unroll
                for (int g = 0; g < 4; ++g) { bq[g] = 0.5f * p0[4 * g + 3]; e[g] = (p0[4 * g] + p0[4 * g + 1]) + (p0[4 * g + 2] + bq[g]);
                                              bq[4 + g] = 0.5f * p1[4 * g + 3]; e[4 + g] = (p1[4 * g] + p1[4 * g + 1]) + (p1[4 * g + 2] + bq[4 + g]); }
                float pb[8];
#pragma unroll
                for (int k = 0; k < 8; ++k) { auto rr = __builtin_amdgcn_permlane32_swap(__float_as_uint(bq[k]), __float_as_uint(bq[k]), false, false); pb[k] = __uint_as_float(hi ? rr[0] : rr[1]); }
#pragma unroll
                for (int k = 0; k < 8; ++k) { const float inc = hi ? pb[k] : (k > 0 ? pb[k > 0 ? k - 1 : 0] : carry); float v = e[k] + inc;
                    v += dpp_f<0x128>(v);
                    { auto rr = __builtin_amdgcn_permlane16_swap(__float_as_uint(v), __float_as_uint(v), false, false); v = __uint_as_float(rr[0]) + __uint_as_float(rr[1]); }
                    if (hc == 0) impw[(16 * ct + 8 * (k >> 2) + 2 * (k & 3) + hi) * 8 + q8] = v; }
                carry = pb[7];
            }
            pv(o, p0, p1, slot + VOFF, lane);
        }, lds + L_RING, wid, lane, ch, &Ts, qt + 1, 0);
        TICK(F, 3);
        {
            const int jc = qt;
#ifdef PROBE_TOPK
            for (int rp_ = 0; rp_ < 2; ++rp_)
#endif
            for (int qq = 0; qq < 8; ++qq) {
                const int q = 8 * wid + qq; unsigned long long m0, m1;
                if (!need_imp) { m0 = (1ull << (jc + 1)) - 1ull; m1 = 0ull; }
                else {
                    const int ja = lane, jb2 = lane + 64;
                    const bool c0 = (ja >= 1 && ja <= jc - 2), c1 = (jb2 <= jc - 2);
                    const float v0 = c0 ? impw[ja * 8 + qq] : 0.f, v1 = c1 ? impw[jb2 * 8 + qq] : 0.f;
                    const unsigned u0 = c0 ? (__float_as_uint(v0) + 1u) : 0u, u1 = c1 ? (__float_as_uint(v1) + 1u) : 0u;
                    unsigned thr = 0u;
                    for (int bit = 31; bit >= 0; --bit) { const unsigned tr = thr | (1u << bit);
                        const int cnt = __popcll(__ballot(u0 >= tr)) + __popcll(__ballot(u1 >= tr)); if (cnt >= 13) thr = tr; }
                    const unsigned long long g0 = __ballot(u0 > thr), g1 = __ballot(u1 > thr), e0 = __ballot(u0 == thr), e1 = __ballot(u1 == thr);
                    const int need = 13 - (__popcll(g0) + __popcll(g1));
                    const unsigned long long lt_mask = (1ull << lane) - 1ull;
                    const int rk0 = __popcll(e0 & lt_mask), rk1 = __popcll(e0) + __popcll(e1 & lt_mask);
                    const bool s0 = (u0 > thr) || (u0 == thr && rk0 < need) || ja == 0 || ja == jc || ja == jc - 1;
                    const bool s1 = (u1 > thr) || (u1 == thr && rk1 < need) || jb2 == jc || jb2 == jc - 1;
                    m0 = __ballot(s0); m1 = __ballot(s1);
                }
                if (lane == 0) { sel[q * 4 + 0] = (unsigned)m0; sel[q * 4 + 1] = (unsigned)(m0 >> 32); sel[q * 4 + 2] = (unsigned)m1; sel[q * 4 + 3] = (unsigned)(m1 >> 32); }
            }
        }
        __syncthreads();
        {
            if (hi == 0) wsf[32 + r32] = gate[qc * 12 + hc * 3 + 0];
            __builtin_amdgcn_fence(__ATOMIC_RELEASE, "wavefront"); __builtin_amdgcn_wave_barrier();
            LAS float* ob = (LAS float*)(lds + L_OACC);
#pragma unroll
            for (int r = 0; r < 16; ++r) { const int row = crow(r, hi), hh = row >> 3, q5 = 8 * (wid & 3) + (row & 7); const float g = wsf[32 + row];
                LAS float* dst = ob + (hh + 4 * (wid >> 2)) * 2048 + ((q5 & 3) + 4 * (q5 >> 3)) * 64 + ((q5 >> 2) & 1) * 32 + r32;
                dst[0] = o[0][r] * g; dst[16 * 64] = o[1][r] * g; }
        }
        __syncthreads();
        TICK(F, 4);
    }
    const int rep = 0;
    {
        const TileSrc& T = Ts;
        const int NT = qt + 1; const float cfar = bth[128];
        SmState sm; sm_init(sm, cfar); f32x16 o[2]; o[0] = f32x16{}; o[1] = f32x16{};
#ifdef USE_PIPE_SEL
        pipe_loop<64>(T, NT, 0, qf, sm, o,
            [&](int jt) { const bool selb = ((sel[qi * 4 + (jt >> 5)] >> (jt & 31)) & 1u) != 0u; return __any(selb) != 0; },
            [&](int jt, f32x16& p0, f32x16& p1) {
                const bool selb = ((sel[qi * 4 + (jt >> 5)] >> (jt & 31)) & 1u) != 0u;
                if (jt >= qt - 2) {
#pragma unroll
                    for (int r = 0; r < 16; ++r) { const int d0 = t - (64 * jt + crow(r, hi)), d1 = d0 - 32;
                        const float b0 = btab(bth, d0) - cfar, b1 = btab(bth, d1) - cfar; p0[r] = (selb && d0 >= 0) ? p0[r] + b0 : NEG_INF; p1[r] = (selb && d1 >= 0) ? p1[r] + b1 : NEG_INF; }
                } else if (!selb) {
#pragma unroll
                    for (int r = 0; r < 16; ++r) { p0[r] = NEG_INF; p1[r] = NEG_INF; }
                } },
            lds + L_RING, wsf, wid, lane);
#else
        tile_loop_c<64, 64>(T, NT, 0, [&](int jt, const LAS unsigned char* slot) {
            const bool selb = ((sel[qi * 4 + (jt >> 5)] >> (jt & 31)) & 1u) != 0u;
            if (__any(selb)) {
                f32x16 p0, p1;
                if (jt >= qt - 2 || __all(selb)) qk_c<64>(p0, p1, slot, qf, sm.negm, r32, hi);
                else { f32x16 cm;
#pragma unroll
                    for (int r = 0; r < 16; ++r) cm[r] = selb ? sm.negm[r] : NEG_INF;
                    qk_c<64>(p0, p1, slot, qf, cm, r32, hi); }
                if (jt >= qt - 2) {
#pragma unroll
                    for (int r = 0; r < 16; ++r) { const int d0 = t - (64 * jt + crow(r, hi)), d1 = d0 - 32;
                        const float b0 = btab(bth, d0) - cfar, b1 = btab(bth, d1) - cfar; p0[r] = (selb && d0 >= 0) ? p0[r] + b0 : NEG_INF; p1[r] = (selb && d1 >= 0) ? p1[r] + b1 : NEG_INF; }
                }
                softmax_pv2(p0, p1, sm, o, slot + VOFF, wsf, lane);
            }
        }, lds + L_RING, wid, lane, ch, &Tw, qt - j_lo + 1, 64 * j_lo);
#endif
        const float lt = half_swap_sum(sm.l);
        scaled_add(outacc, o, (lt > 0.f && rep == 0) ? gate[qi * 12 + h * 3 + 1] * __builtin_amdgcn_rcpf(lt) : 0.f, wsf, lane, false);
        TICK(F, 5);
    }
    const int rep2 = 0;
    {
        const TileSrc& T = Tw;
        const float cfar = bth[128];
        SmState sm; sm_init(sm, cfar); f32x16 o[2]; o[0] = f32x16{}; o[1] = f32x16{};
        tile_loop_c<64, 64>(T, qt - j_lo + 1, 64 * j_lo, [&](int it, const LAS unsigned char* slot) {
            const int jt = j_lo + it;
            f32x16 p0, p1; qk_c<64>(p0, p1, slot, qf, sm.negm, r32, hi);
            if ((jt >= qt - 2) || (jt == qt - 8)) {
#pragma unroll
                for (int r = 0; r < 16; ++r) { const int d0 = t - (64 * jt + crow(r, hi)), d1 = d0 - 32;
                    const float b0 = btab(bth, d0) - cfar, b1 = btab(bth, d1) - cfar; p0[r] = (d0 >= 0 && d0 < 512) ? p0[r] + b0 : NEG_INF; p1[r] = (d1 >= 0 && d1 < 512) ? p1[r] + b1 : NEG_INF; }
            }
            softmax_pv2(p0, p1, sm, o, slot + VOFF, wsf, lane);
        }, lds + L_RING, wid, lane, ch, qt_next >= 0 ? &Tc : nullptr, qt_next >= 0 ? ((((64 * qt_next + 32) >> 4) >> 6) + 1) : 0, 0);
        const float lt = half_swap_sum(sm.l);
        scaled_add(outacc, o, (lt > 0.f && rep2 == 0) ? gate[qi * 12 + h * 3 + 2] * __builtin_amdgcn_rcpf(lt) : 0.f, wsf, lane, false);
        TICK(F, 6);
    }
    store_oacc(outacc, (bf16_t*)(F.ws + WS_CAT) + (size_t)(b * SEQ + t0 + 32 * qh) * DMODEL + CC_NSA + h * 64, DMODEL, lane);
    __syncthreads();
    TICK(F, 7);
}

__device__ __forceinline__ void phaseC(Frame F) {
    LAUNDER(F);
    { LAS float* bt = (LAS float*)(F.lds + L_BT); const float* tab = IN(F, 21);
      for (int idx = F.tid; idx < 4 * 132; idx += 512) { const int h = idx / 132, d = idx - h * 132; bt[idx] = (d <= 128) ? tab[BUCKET[d] * 4 + h] * LOG2E : 0.f; }
      __syncthreads(); }
    for (int p = F.vcu; p < 256; p += F.G) {
        { const int bh = p >> 4, s = p & 15; Chain ch{0, false}; mla_unit(F, bh >> 2, bh & 3, 31 - s, ch, s); mla_unit(F, bh >> 2, bh & 3, s, ch, -1); }
        { const int b = p >> 6, s = p & 63; Chain ch{0, false}; nsa_unit(F, b, 127 - s, ch, s); nsa_unit(F, b, s, ch, -1); }
    }
}
}
constexpr int NTHREADS = 512;

template <class Sched> __device__ __forceinline__ void build_rs(Frame& F, const Sched& S) {
    LAS float* rs = (LAS float*)(F.lds + LDS_RS); const float* ss = (const float*)(F.ws + WS_SS); pg8::Unit u;
    for (int i = 0; S.next(i, u); ++i) {
        if (F.tid < 256) { const int row = u.pm * 256 + F.tid; const f32x4* p = (const f32x4*)(ss + (size_t)row * 16); const f32x4 v0 = p[0], v1 = p[1], v2 = p[2], v3 = p[3];
            const float s = (((v0[0] + v0[1]) + (v0[2] + v0[3])) + ((v1[0] + v1[1]) + (v1[2] + v1[3]))) + (((v2[0] + v2[1]) + (v2[2] + v2[3])) + ((v3[0] + v3[1]) + (v3[2] + v3[3])));
            rs[i * 256 + F.tid] = __builtin_amdgcn_rsqf(s * (1.f / DMODEL) + EPS); }
    }
    __syncthreads();
}
__device__ __forceinline__ void phaseA(Frame F, int l) {
    LAUNDER(F);
    pg8::Gemm g{(const bf16_t*)(F.ws + WS_HB), (const bf16_t*)(F.ws + WS_W + (size_t)l * W_LAYER + WO_WIN), MTOK, NU, DMODEL};
    pg8::StaticOrder S; S.init(MTOK, NU, F.G, F.bid);
    build_rs(F, S);
    pg8::EpiRowScale<0> E{(bf16_t*)(F.ws + WS_U), NU, (const LAS float*)(F.lds + LDS_RS)};
    pg8::gemm_phase<pg8::EpiRowScale<0>, pg8::StaticOrder, true, true>(F.lds, g, S, E, F.wave);
}
__device__ __forceinline__ void phaseRes(Frame F, size_t a_off, size_t b_off, int K, size_t hb_off = WS_HB, size_t ss_off = WS_SS) {
    LAUNDER(F);
    const bf16_t* A = (const bf16_t*)(F.ws + a_off); const bf16_t* Bt = (const bf16_t*)(F.ws + b_off);
    pg8::Gemm g{A, Bt, MTOK, DMODEL, K};
    pg8::StaticOrder S; S.init(MTOK, DMODEL, F.G, F.bid);
    pg8::EpiResidual E{(bf16_t*)(F.ws + hb_off), (float*)(F.ws + ss_off)};
    pg8::gemm_phase<pg8::EpiResidual, pg8::StaticOrder, true, true>(F.lds, g, S, E, F.wave);
}
__device__ __forceinline__ void phaseE(Frame F, int l) {
    LAUNDER(F);
    pg8::Gemm g{(const bf16_t*)(F.ws + WS_HB), (const bf16_t*)(F.ws + WS_W + (size_t)l * W_LAYER + WO_W1), MTOK, DFF, DMODEL};
    pg8::StaticOrder S; S.init(MTOK, DFF, F.G, F.bid);
    build_rs(F, S);
    pg8::EpiRowScale<1> E{(bf16_t*)(F.ws + WS_Z), DFF, (const LAS float*)(F.lds + LDS_RS)};
    pg8::gemm_phase<pg8::EpiRowScale<1>, pg8::StaticOrder, true, true>(F.lds, g, S, E, F.wave);
}
__device__ __forceinline__ void phaseG(Frame F) {
    LAUNDER(F);
    const float* ss = (const float*)(F.ws + WS_SS); const int gw = F.bid * 8 + F.wave, NGW = F.G * 8;
    const f32x4* gp = (const f32x4*)IN(F, 22) + F.lane; float* outp = (float*)IN(F, 23); const bf16_t* hb = (const bf16_t*)(F.ws + WS_HB);
    f32x4 g4[4];
#pragma unroll
    for (int j = 0; j < 4; ++j) g4[j] = gp[64 * j];
    for (int m0 = gw * 4; m0 < MTOK; m0 += NGW * 4) {
        float sv[4]; u32x2 hv[4][4];
#pragma unroll
        for (int q = 0; q < 4; ++q) { sv[q] = (F.lane < 16) ? ss[(size_t)(m0 + q) * 16 + F.lane] : 0.f; const u32x2* hr = (const u32x2*)(hb + (size_t)(m0 + q) * DMODEL) + F.lane;
#pragma unroll
            for (int j = 0; j < 4; ++j) hv[q][j] = hr[64 * j]; }
#pragma unroll
        for (int q = 0; q < 4; ++q) { const float r = __builtin_amdgcn_rsqf(wave_sum(sv[q]) * (1.f / DMODEL) + EPS); f32x4* orow = (f32x4*)(outp + (size_t)(m0 + q) * DMODEL) + F.lane;
#pragma unroll
            for (int j = 0; j < 4; ++j) { const u32x2 v = hv[q][j];
                const f32x4 x = (f32x4){__uint_as_float(v.x << 16), __uint_as_float(v.x & 0xffff0000u), __uint_as_float(v.y << 16), __uint_as_float(v.y & 0xffff0000u)};
                __builtin_nontemporal_store(x * r * g4[j], orow + 64 * j); } }
    }
}

__global__ void __launch_bounds__(NTHREADS, 2) mega_fwd(Args a) {
    extern __shared__ __attribute__((aligned(16))) unsigned char lds_raw[];
    if (a.pad1 != 0) cg::this_grid().sync();
    Frame F;
    F.lds = (LAS unsigned char*)lds_raw; F.tid = threadIdx.x; F.lane = F.tid & 63; F.wave = __builtin_amdgcn_readfirstlane(F.tid >> 6);
    F.G = gridDim.x; F.bid = blockIdx.x; F.vcu = (F.G % 8 == 0) ? (F.bid % 8) * (F.G / 8) + F.bid / 8 : F.bid; F.ws = (GAS unsigned char*)a.ws;
    if (F.tid < 128) ((LAS unsigned*)(F.lds + LDS_CTL))[F.tid] = 0u;
    __syncthreads();
#ifdef PROBE_CLK
    if (F.tid == 0) ((volatile unsigned long long*)(a.ws + WS_TAB + 1024))[F.bid] = __builtin_amdgcn_s_memrealtime();
#endif
    const XcdBarrier bar = xcd_barrier_post((unsigned*)(a.ws + WS_BAR), (volatile LAS unsigned*)(F.lds + LDS_CTL), F.tid == 0);
#define SEAM() xcd_barrier(bar, F.wave)
    CLK_S(0); prologue(a, F); CLK_S(1);
    SEAM();
    static_assert(NLAYER == 2, "layer bodies are written out twice");
    { constexpr int l = 0;
        CLK_S(2); phaseA(F, l); CLK_S(3);
        SEAM();
        CLK_S(4); phaseB(F, l); CLK_S(5);
        SEAM();
        CLK_S(6); phaseB2(F, l); CLK_S(7);
        SEAM();
        CLK_S(8); att::phaseC(F); CLK_S(9);
        SEAM();
        CLK_S(10); phaseRes(F, WS_CAT, WS_W + (size_t)l * W_LAYER + WO_WOUT, DMODEL); CLK_S(11);
        SEAM();
        CLK_S(12); phaseE(F, l); CLK_S(13);
        SEAM();
        CLK_S(14); phaseRes(F, WS_Z, WS_W + (size_t)l * W_LAYER + WO_W2, DFF); CLK_S(15);
        SEAM();
    }
#ifdef PROBE_IDLE
    { const unsigned long long r0_ = __builtin_amdgcn_s_memrealtime(); while (__builtin_amdgcn_s_memrealtime() - r0_ < PROBE_IDLE * 100ull) __builtin_amdgcn_s_sleep(32); }
#endif
    { constexpr int l = 1;
        CLK_S(16); phaseA(F, l); CLK_S(17);
        SEAM();
        CLK_S(18); phaseB(F, l); CLK_S(19);
        SEAM();
        CLK_S(20); phaseB2(F, l); CLK_S(21);
        SEAM();
        CLK_S(22); att::phaseC(F); CLK_S(23);
        SEAM();
        CLK_S(24); phaseRes(F, WS_CAT, WS_W + (size_t)l * W_LAYER + WO_WOUT, DMODEL); CLK_S(25);
        SEAM();
        CLK_S(26); phaseE(F, l); CLK_S(27);
        SEAM();
        CLK_S(28); phaseRes(F, WS_Z, WS_W + (size_t)l * W_LAYER + WO_W2, DFF); CLK_S(29);
        SEAM();
    }
    CLK_S(30); phaseG(F); CLK_S(31);
#ifdef PROBE_CLK
    __syncthreads();
    if (F.bid == PROBE_CLK && F.wave == 0) {
        volatile unsigned long long* _c = (volatile unsigned long long*)((unsigned char*)F.ws + 131072 + F.bid * 1024);
#define W_C(w) ((volatile unsigned long long*)((unsigned char*)F.ws + 131072 + (w) * 1024))
        unsigned long long bmax_ = 0ull, bmin_ = ~0ull, bsum_ = 0ull, xmax_ = 0ull, emax_ = 0ull, emin_ = ~0ull;
#ifdef PROBE_PH
#ifndef PROBE_IA
#define PROBE_IA (2 * PROBE_PH)
#define PROBE_IB (2 * PROBE_PH + 1)
#endif
        for (int w_ = 0; w_ < (int)gridDim.x; ++w_) { const unsigned long long b_ = W_C(w_)[PROBE_IB] - W_C(w_)[PROBE_IA], e_ = W_C(w_)[PROBE_IB]; bsum_ += b_; if (b_ > bmax_) { bmax_ = b_; xmax_ = (unsigned long long)w_; } bmin_ = b_ < bmin_ ? b_ : bmin_; emax_ = e_ > emax_ ? e_ : emax_; emin_ = e_ < emin_ ? e_ : emin_; }
#endif
#define B_MAX() (bmax_ / 100ull)
#define B_MIN() (bmin_ / 100ull)
#define B_AVG() (bsum_ / (100ull * gridDim.x))
#define B_XMAX() (xmax_)
#define E_SPREAD() ((emax_ - emin_) / 100ull)
        unsigned long long n80_ = 0ull, n100_ = 0ull, n120_ = 0ull;
#ifdef PROBE_PH
        for (int w_ = 0; w_ < (int)gridDim.x; ++w_) { const unsigned long long b_ = (W_C(w_)[2 * PROBE_PH + 1] - W_C(w_)[2 * PROBE_PH]) / 100ull; n80_ += b_ > 80ull; n100_ += b_ > 100ull; n120_ += b_ > 120ull; }
#endif
        unsigned long long org_ = ~0ull, last_ = 0ull; for (int w_ = 0; w_ < (int)gridDim.x; ++w_) { const unsigned long long t_ = ((volatile unsigned long long*)(a.ws + WS_TAB + 1024))[w_]; org_ = t_ < org_ ? t_ : org_; last_ = t_ > last_ ? t_ : last_; }
#define T_SKEW() ((last_ - org_) / 100ull)
#define T_START(i) ((_c[2 * (i)] - org_) / 100ull)
#define T_BUSY(i) ((_c[2 * (i) + 1] - _c[2 * (i)]) / 100ull)
#define T_MHZ10(i) (((_c[32 + 2 * (i) + 1] - _c[32 + 2 * (i)]) * 10ull) / (_c[2 * (i) + 1] - _c[2 * (i)]))
#define T_WALL(i) ((_c[2 * (i) + 2] - _c[2 * (i)]) / 100ull)
        unsigned long long v0 = PROBE_R0, v1 = PROBE_R1; if (v0 > 63ull) v0 = 63ull; if (v1 > 63ull) v1 = 63ull;
        const unsigned long long us = 40ull * (v0 + 64ull * v1);
        const unsigned long long r0 = __builtin_amdgcn_s_memrealtime();
        while (__builtin_amdgcn_s_memrealtime() - r0 < us * 100ull) __builtin_amdgcn_s_sleep(8);
    }
#endif
#ifdef STAMP_ID
    __syncthreads();
    if (F.bid == 0 && F.tid == 0) { volatile LAS unsigned long long* _a = (volatile LAS unsigned long long*)(F.lds + LDS_BYTES - 512 + 64); a.out[0] = (float)_a[1 + STAMP_ID] * 0.01f; }
#endif
}

extern "C" void kernel_launch(void* const* d_in, const int* in_sizes, int n_in, void* d_out, int out_size, void* d_ws, size_t ws_size, hipStream_t stream) {
    static int grid = 0;
    if (grid == 0) {
        if (n_in != 23 || out_size != MTOK * DMODEL || ws_size < WS_END) { fprintf(stderr, "kernel_launch: unexpected shapes: n_in %d out %d ws %zu (need >= %zu)\n", n_in, out_size, ws_size, (size_t)WS_END); grid = -1; return; }
        int dev = 0, cus = 0, per_cu = 0;
        if (hipGetDevice(&dev) != hipSuccess || hipDeviceGetAttribute(&cus, hipDeviceAttributeMultiprocessorCount, dev) != hipSuccess) { grid = -1; return; }
        if (hipFuncSetAttribute((const void*)mega_fwd, hipFuncAttributeMaxDynamicSharedMemorySize, LDS_BYTES) != hipSuccess) { fprintf(stderr, "kernel_launch: hipFuncSetAttribute failed\n"); grid = -1; return; }
        if (hipOccupancyMaxActiveBlocksPerMultiprocessor(&per_cu, (const void*)mega_fwd, NTHREADS, LDS_BYTES) != hipSuccess || per_cu < 1) { fprintf(stderr, "kernel_launch: occupancy query says %d blocks/CU\n", per_cu); grid = -1; return; }
        grid = cus;
        if (grid != 256) fprintf(stderr, "kernel_launch: note: %d CUs (built for 256)\n", grid);
    }
    if (grid < 0) return;
    if (hipMemsetAsync((char*)d_ws + WS_BAR, 0, 16384, stream) != hipSuccess) { fprintf(stderr, "kernel_launch: hipMemsetAsync failed\n"); return; }
    Args a{};
    for (int i = 0; i < 23; ++i) a.in[i] = (const float*)d_in[i];
    a.out = (float*)d_out; a.ws = (unsigned char*)d_ws;
    void* args[] = {&a};
    const hipError_t e = hipLaunchCooperativeKernel((const void*)mega_fwd, dim3(grid), dim3(NTHREADS), args, LDS_BYTES, stream);
    if (e != hipSuccess) fprintf(stderr, "kernel_launch: cooperative launch failed: %s (grid %d)\n", hipGetErrorString(e), grid);
}
```

```cpp
#include <hip/hip_runtime.h>
#include <hip/hip_cooperative_groups.h>
#include <cstdio>
#include <cstdint>
namespace cg = cooperative_groups;
namespace pg8 {
#define PG8_LAS __attribute__((address_space(3)))
typedef unsigned short bf16_t;
typedef short bf16x8 __attribute__((ext_vector_type(8)));
typedef float f32x4 __attribute__((ext_vector_type(4)));
typedef unsigned u32x4 __attribute__((ext_vector_type(4)));
typedef unsigned u32x2 __attribute__((ext_vector_type(2)));
constexpr int BM = 256, BK = 64, HALF = 128, HTB = HALF * BK * 2  , STAGE_BYTES = 8 * HTB, NXCD = 8, WGM = 8;

__host__ __device__ __forceinline__ int lds_byte(int r, int c) { const int st = (r >> 4) * 2 + (c >> 5), rr = r & 15, cc = c & 31, ob = rr * 64 + cc * 2; return st * 1024 + (ob ^ (((ob >> 9) & 1) << 5)); }
__host__ __device__ __forceinline__ void stage_rc(int b, int& R, int& C) { const int st = b / 1024, sb = b % 1024, swz = sb ^ (((sb >> 9) & 1) << 5); R = (st >> 1) * 16 + swz / 64; C = (st & 1) * 32 + (swz % 64) / 2; }
__host__ __device__ __forceinline__ int perm32(int rho) { const int n = rho >> 4, i = rho & 15; return 8 * (i >> 2) + 4 * n + (i & 3); }

struct Unit { int pm, pn, ui, kt0, nkt; };
struct Gemm { const bf16_t* A; const bf16_t* Bt; int M, N, K; int lda; };

struct StaticOrder {
    int nM, nN, nwg, G, c; bool rev = false;
    __host__ __device__ void init(int M, int N, int G_, int c_) { nM = M / BM; nN = N / BM; nwg = nM * nN; G = G_; c = c_; }
    __host__ __device__ bool next(int i, Unit& u) const {
        if ((long)i * G + c >= nwg) return false;
        const long L = (long)((rev && nwg % G == 0) ? nwg / G - 1 - i : i) * G + c;
        int wgid = (int)L; { const int q = nwg / NXCD, r = nwg % NXCD, xcd = wgid % NXCD, off = wgid / NXCD; wgid = (xcd < r ? xcd * (q + 1) : r * (q + 1) + (xcd - r) * q) + off; }
        const int nig = WGM * nN, gid = wgid / nig, fm = gid * WGM, gsz = (nM - fm) < WGM ? (nM - fm) : WGM;
        u.pm = fm + ((wgid % nig) % gsz); u.pn = (wgid % nig) / gsz; u.ui = i; u.kt0 = 0; u.nkt = 0; return true;
    }
    __device__ __forceinline__ void a_ready(const Unit&) const {}
    __device__ __forceinline__ void done(const Unit&) const {}
};

struct ListOrder : StaticOrder {
    __host__ __device__ bool next(int i, Unit& u) const {
        if (G == 256 && nwg == 512) {
            if (c < 128) { if (i >= 3) return false; u.pm = c; u.pn = i; } else { if (i >= 1) return false; u.pm = c - 128; u.pn = 3; }
            u.ui = i;
            if (u.pn == 0) { u.kt0 = 0; u.nkt = 4; } else if (u.pn == 1) { u.kt0 = 0; u.nkt = 6; } else { u.kt0 = 4; u.nkt = 2; }
            return true;
        }
        return StaticOrder::next(i, u);
    }
};

typedef float f32x2 __attribute__((ext_vector_type(2)));
typedef __bf16 bf16x2_t __attribute__((ext_vector_type(2)));
__device__ __forceinline__ unsigned cvt_pk_bf16(float lo, float hi) { f32x2 v = {lo, hi}; bf16x2_t b = __builtin_convertvector(v, bf16x2_t); return __builtin_bit_cast(unsigned, b); }

template <int ACT> struct EpiRowScale {
    static constexpr bool PERM = true, AFTER_DRAIN = false;
    bf16_t* O; int ldc; const PG8_LAS float* rs;
    __device__ __forceinline__ void operator()(const f32x4 (&acc)[2][2][4][2], const Unit& u, int wr, int wc, int fr, int fq) const {
        { int ln_; asm volatile("v_mbcnt_lo_u32_b32 %0, -1, 0\n\tv_mbcnt_hi_u32_b32 %0, -1, %0" : "=v"(ln_)); fr = ln_ & 15; fq = ln_ >> 4; }
        const int rl0 = wr * 64 + fr, col0 = u.pn * BM + wc * 32 + 8 * fq;
#pragma unroll
        for (int ai = 0; ai < 2; ++ai)
#pragma unroll
            for (int m = 0; m < 4; ++m) { const int rl = rl0 + ai * HALF + m * 16; const float s = rs[u.ui * 256 + rl];
                bf16_t* rowp = O + (size_t)(u.pm * BM + rl) * ldc + col0;
#pragma unroll
                for (int bj = 0; bj < 2; ++bj) { f32x4 v0 = acc[ai][bj][m][0] * s, v1 = acc[ai][bj][m][1] * s;
                    if (ACT == 1) {
#pragma unroll
                        for (int e = 0; e < 4; ++e) { float a = fmaxf(v0[e], 0.f), b = fmaxf(v1[e], 0.f); v0[e] = a * a; v1[e] = b * b; } }
                    u32x4 w; w.x = cvt_pk_bf16(v0[0], v0[1]); w.y = cvt_pk_bf16(v0[2], v0[3]); w.z = cvt_pk_bf16(v1[0], v1[1]); w.w = cvt_pk_bf16(v1[2], v1[3]);
                    *(u32x4*)(rowp + bj * HALF) = w; } }
    }
};
struct EpiResidual {
    static constexpr bool PERM = true, AFTER_DRAIN = false;
    bf16_t* hb; float* ss;
    __device__ __forceinline__ void operator()(const f32x4 (&acc)[2][2][4][2], const Unit& u, int wr, int wc, int fr, int fq) const {
        { int ln_; asm volatile("v_mbcnt_lo_u32_b32 %0, -1, 0\n\tv_mbcnt_hi_u32_b32 %0, -1, %0" : "=v"(ln_)); fr = ln_ & 15; fq = ln_ >> 4; }
        const int col0 = u.pn * BM + wc * 32 + 8 * fq;
        bf16_t* hb0 = hb + (size_t)(u.pm * BM + wr * 64 + fr) * 1024 + col0;
        u32x4 bv[2][4][2];
#pragma unroll
        for (int ai = 0; ai < 2; ++ai)
#pragma unroll
            for (int m = 0; m < 4; ++m)
#pragma unroll
                for (int bj = 0; bj < 2; ++bj) bv[ai][m][bj] = *(const u32x4*)(hb0 + (size_t)(ai * HALF + m * 16) * 1024 + bj * HALF);
        __builtin_amdgcn_sched_barrier(0);
#pragma unroll
        for (int ai = 0; ai < 2; ++ai)
#pragma unroll
            for (int m = 0; m < 4; ++m) { const int row = u.pm * BM + wr * 64 + fr + ai * HALF + m * 16; float q = 0.f;
#pragma unroll
                for (int bj = 0; bj < 2; ++bj) { u32x4* hp = (u32x4*)(hb0 + (size_t)(ai * HALF + m * 16) * 1024 + bj * HALF); const u32x4 b = bv[ai][m][bj]; const f32x4 a0 = acc[ai][bj][m][0], a1 = acc[ai][bj][m][1];
                    u32x4 w;
                    w.x = cvt_pk_bf16(__uint_as_float(b.x << 16) + a0[0], __uint_as_float(b.x & 0xffff0000u) + a0[1]);
                    w.y = cvt_pk_bf16(__uint_as_float(b.y << 16) + a0[2], __uint_as_float(b.y & 0xffff0000u) + a0[3]);
                    w.z = cvt_pk_bf16(__uint_as_float(b.z << 16) + a1[0], __uint_as_float(b.z & 0xffff0000u) + a1[1]);
                    w.w = cvt_pk_bf16(__uint_as_float(b.w << 16) + a1[2], __uint_as_float(b.w & 0xffff0000u) + a1[3]);
                    *hp = w;
#pragma unroll
                    for (int e = 0; e < 4; ++e) { const float r0 = __uint_as_float(w[e] << 16), r1 = __uint_as_float(w[e] & 0xffff0000u); q += r0 * r0 + r1 * r1; } }
                q += __shfl_xor(q, 16); q += __shfl_xor(q, 32);
                if (fq == 0) ss[(size_t)row * 16 + u.pn * 4 + wc] = q; }
    }
};

template <class Epi, class Sched, bool ALIGN_EPI = false, bool SP2 = false>
__device__ __forceinline__ void gemm_phase(PG8_LAS unsigned char* lds, const Gemm g, const Sched& S, const Epi& E, int wave_id) {
    int lane_; asm volatile("v_mbcnt_lo_u32_b32 %0, -1, 0\n\tv_mbcnt_hi_u32_b32 %0, -1, %0" : "=v"(lane_));
    const int wid = wave_id, lane = lane_, tid = wid * 64 + lane, wr = wid >> 2, wc = wid & 3, fr = lane & 15, fq = lane >> 4;
    const int K = g.K, nt = K / BK, lda = g.lda ? g.lda : g.K;
    unsigned voffA[2], voffB[2];
#pragma unroll
    for (int i = 0; i < 2; ++i) { int R, C; stage_rc(tid * 16 + i * 8192, R, C); const int Rb = Epi::PERM ? ((R & ~31) + perm32(R & 31)) : R;
        voffA[i] = (unsigned)(R * lda + C) * 2u; voffB[i] = (unsigned)(Rb * K + C) * 2u; }
    const size_t kstep = (size_t)(BK * 2);
    const size_t hstep = (size_t)HALF * K * 2;
    const size_t tstep = 2 * hstep;
    const size_t ahstep = (size_t)HALF * lda * 2, atstep = 2 * ahstep;
    const unsigned ldsw = (unsigned)wid * 1024u;
    const int aoff = lds_byte(wr * 64 + fr, fq * 8), boff = lds_byte(wc * 32 + fr, fq * 8);
#define PG8_SA(b, h) (((b) * 2 + (h)) * HTB)
#define PG8_SB(b, h) ((4 + (b) * 2 + (h)) * HTB)
#define PG8_STAGE(bufoff, gbase, voff) do { _Pragma("unroll") for (int _i = 0; _i < 2; ++_i) \
        __builtin_amdgcn_global_load_lds((const unsigned*)((const char*)(gbase) + (voff)[_i]), (PG8_LAS unsigned*)(lds + (bufoff) + ldsw + _i * 8192), 16, 0, 0); } while (0)
#define PG8_LDA(dst, b, h) do { _Pragma("unroll") for (int m = 0; m < 4; ++m) _Pragma("unroll") for (int k = 0; k < 2; ++k) dst[m][k] = *(const PG8_LAS bf16x8*)(lds + PG8_SA(b, h) + aoff + m * 2048 + k * 1024); } while (0)
#define PG8_LDB(dst, b, h) do { _Pragma("unroll") for (int n = 0; n < 2; ++n) _Pragma("unroll") for (int k = 0; k < 2; ++k) dst[n][k] = *(const PG8_LAS bf16x8*)(lds + PG8_SB(b, h) + boff + n * 2048 + k * 1024); } while (0)
#define PG8_MMA(ai, bj, At, Bt) do { __builtin_amdgcn_s_setprio(1); _Pragma("unroll") for (int m = 0; m < 4; ++m) _Pragma("unroll") for (int n = 0; n < 2; ++n) _Pragma("unroll") for (int k = 0; k < 2; ++k) \
        acc[ai][bj][m][n] = __builtin_amdgcn_mfma_f32_16x16x32_bf16(Bt[n][k], At[m][k], acc[ai][bj][m][n], 0, 0, 0); __builtin_amdgcn_s_setprio(0); } while (0)
#define PG8_WAIT_V(n) asm volatile("s_waitcnt vmcnt(" #n ")" ::: "memory")
#define PG8_WAIT_L(n) asm volatile("s_waitcnt lgkmcnt(" #n ")" ::: "memory")
#define PG8_BAR __builtin_amdgcn_s_barrier()
#define PG8_SCHED __builtin_amdgcn_sched_barrier(0)
    Unit cur, nxt; int ui = 0;
    if (!S.next(0, cur)) return;
    f32x4 acc[2][2][4][2];
#pragma unroll
    for (int a = 0; a < 2; ++a)
#pragma unroll
        for (int b = 0; b < 2; ++b)
#pragma unroll
            for (int m = 0; m < 4; ++m)
#pragma unroll
                for (int n = 0; n < 2; ++n) acc[a][b][m][n] = (f32x4){0.f, 0.f, 0.f, 0.f};
    bf16x8 At[4][2], B0[2][2], B1[2][2];
    const char* cA = (const char*)g.A + (size_t)cur.pm * atstep + (size_t)cur.kt0 * kstep; const char* cB = (const char*)g.Bt + (size_t)cur.pn * tstep + (size_t)cur.kt0 * kstep;
    int cnt = cur.nkt ? cur.nkt : nt;
    S.a_ready(cur);
    if constexpr (SP2) {
        PG8_STAGE(PG8_SB(0, 0), cB, voffB); PG8_STAGE(PG8_SB(0, 1), cB + hstep, voffB); PG8_STAGE(PG8_SA(0, 0), cA, voffA); PG8_STAGE(PG8_SA(0, 1), cA + ahstep, voffA);
        if (wr == 1) PG8_BAR;
        PG8_WAIT_V(2); PG8_BAR;
        PG8_STAGE(PG8_SB(1, 0), cB + kstep, voffB); PG8_STAGE(PG8_SA(1, 0), cA + kstep, voffA); PG8_STAGE(PG8_SB(1, 1), cB + hstep + kstep, voffB);
        PG8_WAIT_V(6); PG8_BAR;
    } else {
        PG8_STAGE(PG8_SB(0, 0), cB, voffB); PG8_STAGE(PG8_SA(0, 0), cA, voffA); PG8_STAGE(PG8_SB(0, 1), cB + hstep, voffB); PG8_STAGE(PG8_SA(0, 1), cA + ahstep, voffA);
        if (wr == 1) PG8_BAR;
        PG8_WAIT_V(4); PG8_BAR;
        PG8_STAGE(PG8_SB(1, 0), cB + kstep, voffB); PG8_STAGE(PG8_SA(1, 0), cA + kstep, voffA); PG8_STAGE(PG8_SB(1, 1), cB + hstep + kstep, voffB);
        PG8_WAIT_V(6); PG8_BAR;
    }
    for (;;) {
        const bool has_next = S.next(ui + 1, nxt);
        const char* nA = has_next ? (const char*)g.A + (size_t)nxt.pm * atstep + (size_t)nxt.kt0 * kstep : cA; const char* nB = has_next ? (const char*)g.Bt + (size_t)nxt.pn * tstep + (size_t)nxt.kt0 * kstep : cB;
        for (int t = 0; t < cnt; t += 2) {
            const bool last = (t == cnt - 2);
            const char* a1 = cA + (size_t)(t + 1) * kstep;
            const char* a2 = last ? nA : cA + (size_t)(t + 2) * kstep; const char* b2 = last ? nB : cB + (size_t)(t + 2) * kstep;
            const char* a3 = a2 + kstep; const char* b3 = b2 + kstep;
            if (last && has_next) S.a_ready(nxt);
            if constexpr (SP2) {
            PG8_LDB(B0, 0, 0); PG8_LDB(B1, 0, 1); PG8_SCHED; PG8_LDA(At, 0, 0); PG8_STAGE(PG8_SA(1, 1), a1 + ahstep, voffA);
            PG8_WAIT_V(8); PG8_WAIT_L(0); PG8_BAR; PG8_MMA(0, 0, At, B0); PG8_MMA(0, 1, At, B1); PG8_BAR; PG8_SCHED;
            PG8_LDA(At, 0, 1); PG8_STAGE(PG8_SB(0, 0), b2, voffB); PG8_STAGE(PG8_SB(0, 1), b2 + hstep, voffB); PG8_STAGE(PG8_SA(0, 0), a2, voffA);
            PG8_WAIT_V(8); PG8_WAIT_L(0); PG8_BAR; PG8_MMA(1, 0, At, B0); PG8_MMA(1, 1, At, B1); PG8_BAR; PG8_SCHED;
            PG8_LDB(B0, 1, 0); PG8_LDB(B1, 1, 1); PG8_SCHED; PG8_LDA(At, 1, 0); PG8_STAGE(PG8_SA(0, 1), a2 + ahstep, voffA);
            PG8_WAIT_V(8); PG8_WAIT_L(0); PG8_BAR; PG8_MMA(0, 0, At, B0); PG8_MMA(0, 1, At, B1); PG8_BAR; PG8_SCHED;
            PG8_LDA(At, 1, 1); PG8_STAGE(PG8_SB(1, 0), b3, voffB); PG8_STAGE(PG8_SB(1, 1), b3 + hstep, voffB); PG8_STAGE(PG8_SA(1, 0), a3, voffA);
            PG8_WAIT_V(8); PG8_WAIT_L(0); PG8_BAR; PG8_MMA(1, 0, At, B0); PG8_MMA(1, 1, At, B1); PG8_BAR; PG8_SCHED;
            } else {
            PG8_LDB(B0, 0, 0); PG8_SCHED; PG8_LDA(At, 0, 0); PG8_STAGE(PG8_SA(1, 1), a1 + ahstep, voffA);
            PG8_WAIT_L(8); PG8_BAR; PG8_WAIT_L(0); PG8_MMA(0, 0, At, B0); PG8_BAR; PG8_SCHED;
            PG8_LDB(B1, 0, 1); PG8_STAGE(PG8_SB(0, 0), b2, voffB);
            PG8_BAR; PG8_WAIT_L(0); PG8_MMA(0, 1, At, B1); PG8_BAR;
            PG8_LDA(At, 0, 1); PG8_STAGE(PG8_SA(0, 0), a2, voffA);
            PG8_BAR; PG8_WAIT_L(0); PG8_MMA(1, 0, At, B0); PG8_BAR; PG8_SCHED;
            PG8_STAGE(PG8_SB(0, 1), b2 + hstep, voffB);
            PG8_WAIT_V(6); PG8_BAR; PG8_MMA(1, 1, At, B1); PG8_BAR;
            PG8_LDB(B0, 1, 0); PG8_SCHED; PG8_LDA(At, 1, 0); PG8_STAGE(PG8_SA(0, 1), a2 + ahstep, voffA);
            PG8_WAIT_L(8); PG8_BAR; PG8_WAIT_L(0); PG8_MMA(0, 0, At, B0); PG8_BAR; PG8_SCHED;
            PG8_LDB(B1, 1, 1); PG8_STAGE(PG8_SB(1, 0), b3, voffB);
            PG8_BAR; PG8_WAIT_L(0); PG8_MMA(0, 1, At, B1); PG8_BAR;
            PG8_LDA(At, 1, 1); PG8_STAGE(PG8_SA(1, 0), a3, voffA);
            PG8_BAR; PG8_WAIT_L(0); PG8_MMA(1, 0, At, B0); PG8_BAR; PG8_SCHED;
            PG8_STAGE(PG8_SB(1, 1), b3 + hstep, voffB);
            PG8_WAIT_V(6); PG8_BAR; PG8_MMA(1, 1, At, B1); PG8_BAR;
            }
        }
        if constexpr (ALIGN_EPI) { if (wr == 0) PG8_BAR; }
        if constexpr (!Epi::AFTER_DRAIN) { E(acc, cur, wr, wc, fr, fq); S.done(cur); }
        if (!has_next) break;
#pragma unroll
        for (int a = 0; a < 2; ++a)
#pragma unroll
            for (int b = 0; b < 2; ++b)
#pragma unroll
                for (int m = 0; m < 4; ++m)
#pragma unroll
                    for (int n = 0; n < 2; ++n) acc[a][b][m][n] = (f32x4){0.f, 0.f, 0.f, 0.f};
        cur = nxt; cA = nA; cB = nB; ++ui; cnt = cur.nkt ? cur.nkt : nt;
        if constexpr (ALIGN_EPI) { if (wr == 1) PG8_BAR; }
    }
    PG8_WAIT_V(0);
    if constexpr (!ALIGN_EPI) { if (wr == 0) PG8_BAR; }
    PG8_BAR;
#undef PG8_SA
#undef PG8_SB
#undef PG8_STAGE
#undef PG8_LDA
#undef PG8_LDB
#undef PG8_MMA
#undef PG8_WAIT_V
#undef PG8_WAIT_L
#undef PG8_BAR
#undef PG8_SCHED
}
}
#define LAS __attribute__((address_space(3)))
using pg8::bf16_t; using pg8::bf16x8; using pg8::f32x4; using pg8::u32x4; using pg8::u32x2; using pg8::cvt_pk_bf16;
typedef float f32x16 __attribute__((ext_vector_type(16)));
typedef short s16x4 __attribute__((ext_vector_type(4)));

constexpr int NB = 4, SEQ = 8192, MTOK = NB * SEQ, DMODEL = 1024, DIN = 1836, NU = 2048, DFF = 4096, NLAYER = 2;
constexpr float EPS = 1e-6f, LOG2E = 1.4426950408889634f;
constexpr float NSA_QSCALE = 0.125f * LOG2E;
constexpr float MLA_QSCALE = 0.10206207261596575f * LOG2E;
constexpr int UC_A = 0, UC_G = 256, UC_Q = 512, UC_KV = 768, UC_CQ = 1152, UC_CKV = 1408, UC_POOL = 1536, UC_KR = 1792, UC_GATE = 1824;
constexpr int CC_CONV = 0, CC_NSA = 256, CC_MLA = 512, CC_POOL = 768;

constexpr size_t MiB = 1u << 20;
constexpr size_t WS_W = 448 * MiB, W_LAYER = 25 * MiB;
constexpr size_t WO_WIN = 0, WO_WOUT = 4 * MiB, WO_W1 = 6 * MiB, WO_W2 = 14 * MiB, WO_SMALL = 22 * MiB;
constexpr size_t WO_C1 = WO_SMALL, WO_C2 = WO_SMALL + 1048576, WO_QKV = WO_SMALL + 1081344  , WO_CP = WO_SMALL + 1867776  ;
static_assert(WO_CP + 524288 <= W_LAYER, "weight map");
constexpr size_t WS_TAB = 4096, WS_ROPE = 52 * MiB, WS_CB1 = 53 * MiB  , WS_SS = 498 * MiB  , WS_HB = 384 * MiB  , WS_KC = 120 * MiB;
constexpr size_t WS_U = 256 * MiB, WS_CAT = 128 * MiB, WS_QKVO = 192 * MiB  , WS_KR = 121 * MiB  , WS_Z = 128 * MiB,
                 WS_AQKV = 384 * MiB  , WS_ACP = 408 * MiB  , WS_END = 500 * MiB;

constexpr int LDS_BYTES = 163840;
constexpr int LDS_RS = 131072;

__device__ const unsigned char BUCKET[129] = {0,1,2,3,4,5,6,7,8,9,10,11,12,13,14,15,16,16,16,17,17,18,18,18,19,19,19,20,20,20,20,21,21,21,21,22,22,22,22,22,23,23,23,23,23,23,24,24,24,24,24,24,25,25,25,25,25,25,25,26,26,26,26,26,26,26,26,27,27,27,27,27,27,27,27,27,27,28,28,28,28,28,28,28,28,28,28,29,29,29,29,29,29,29,29,29,29,29,29,30,30,30,30,30,30,30,30,30,30,30,30,30,30,31,31,31,31,31,31,31,31,31,31,31,31,31,31,31,31};

__device__ __forceinline__ float bf2f(unsigned short x) { return __uint_as_float((unsigned)x << 16); }
__device__ __forceinline__ unsigned short f2bf(float f) { return (unsigned short)(cvt_pk_bf16(f, 0.f) & 0xffffu); }
template <int CTRL> __device__ __forceinline__ float dpp_f(float v) { return __builtin_bit_cast(float, __builtin_amdgcn_update_dpp(0, __builtin_bit_cast(int, v), CTRL, 0xf, 0xf, true)); }
__device__ __forceinline__ float wave_sum(float v) {
    v += dpp_f<0xB1>(v);
    v += dpp_f<0x4E>(v);
    v += dpp_f<0x141>(v);
    v += dpp_f<0x140>(v);
    { auto r = __builtin_amdgcn_permlane16_swap(__float_as_uint(v), __float_as_uint(v), false, false); v = __uint_as_float(r[0]) + __uint_as_float(r[1]); }
    { auto r = __builtin_amdgcn_permlane32_swap(__float_as_uint(v), __float_as_uint(v), false, false); v = __uint_as_float(r[0]) + __uint_as_float(r[1]); }
    return v;
}
__device__ __forceinline__ float sigmoidf_(float x) { return __builtin_amdgcn_rcpf(1.0f + __builtin_amdgcn_exp2f(-1.4426950408889634f * x)); }
__device__ __forceinline__ int crow(int r, int hi) { return (r & 3) + 8 * (r >> 2) + 4 * hi; }

struct Args { const float* in[23]; float* out; unsigned char* ws; int pad0, pad1; };

#define GAS __attribute__((address_space(1)))
struct Frame {
    LAS unsigned char* lds;
    int tid, lane, wave, G, bid, vcu;
    GAS unsigned char* ws;
};

__device__ __forceinline__ int hw_lane() { int x; asm volatile("v_mbcnt_lo_u32_b32 %0, -1, 0\n\tv_mbcnt_hi_u32_b32 %0, -1, %0" : "=v"(x)); return x; }
#define LAUNDER(F) do { unsigned long long _w = (unsigned long long)(F).ws; asm volatile("" : "+s"(_w)); (F).ws = (GAS unsigned char*)_w; \
    unsigned _l = (unsigned)(size_t)(F).lds; asm volatile("" : "+s"(_l)); (F).lds = (LAS unsigned char*)(size_t)_l; \
    int _ln = hw_lane(); (F).lane = _ln; (F).tid = (F).wave * 64 + _ln; } while (0)

#ifdef STAMP_ID
#define TICK(F, k) do { if ((F).bid == 0 && (F).wave == 0) { const unsigned long long _t = __builtin_amdgcn_s_memrealtime(); volatile LAS unsigned long long* _a = (volatile LAS unsigned long long*)((F).lds + LDS_BYTES - 512 + 64); \
    if (hw_lane() == 0) { _a[1 + (k)] += _t - _a[0]; _a[0] = _t; } } } while (0)
#else
#define TICK(F, k) do { } while (0)
#endif

__device__ __forceinline__ const float* IN(const Frame& F, int k) { return (const float*)(const GAS float*)(((const float* const*)(F.ws + WS_TAB))[k]); }

template <int K> __device__ __forceinline__ f32x16 small_mm(const LAS unsigned char* A, int lda_b, const bf16_t* BT, int lane) {
    const int r32 = lane & 31, hi = lane >> 5; f32x16 acc = {};
    const LAS unsigned char* ap = A + r32 * lda_b + hi * 16; const bf16_t* bp = BT + (size_t)r32 * K + hi * 8;
    bf16x8 bv[K / 16];
#pragma unroll
    for (int ks = 0; ks < K / 16; ++ks) bv[ks] = *(const bf16x8*)(bp + ks * 16);
#pragma unroll
    for (int ks = 0; ks < K / 16; ++ks) {
        const bf16x8 a = *(const LAS bf16x8*)(ap + ks * 32);
        acc = __builtin_amdgcn_mfma_f32_32x32x16_bf16(a, bv[ks], acc, 0, 0, 0);
    }
    return acc;
}
#define XB_TMO      128
#define XB_XCNT(j)  (256  + 64 * (j))
#define XB_XSUB(j)  (1280 + 64 * (j))
#define XB_XGEN(j)  (2304 + 64 * (j))
#define XB_TOP      3328
#define XB_TOPGEN   3392
#define XCD_BAR_WORDS 3456
#define XB_SPIN_CAP (1u << 18)
constexpr size_t WS_BAR = 65536;
constexpr int LDS_CTL = LDS_BYTES - 512;

__device__ __forceinline__ unsigned xb_ld(unsigned* p)              { return __hip_atomic_load(p, __ATOMIC_RELAXED, __HIP_MEMORY_SCOPE_AGENT); }
__device__ __forceinline__ unsigned xb_add(unsigned* p, unsigned v) { return __hip_atomic_fetch_add(p, v, __ATOMIC_RELAXED, __HIP_MEMORY_SCOPE_AGENT); }
__device__ __forceinline__ unsigned xb_xcc_id() { return (unsigned)__builtin_amdgcn_s_getreg((3 << 11) | 20) & 0xFu; }
#define XB_SPIN(cond, bar) do { unsigned _sp = 0; while (cond) { __builtin_amdgcn_s_sleep(1); \
    if ((++_sp & 255u) == 0u) { if (xb_ld(&(bar)[XB_TMO])) break; if (_sp > XB_SPIN_CAP) { atomicAdd(&(bar)[XB_TMO], 1u); break; } } } } while (0)

struct XcdBarrier { unsigned* bar; unsigned x; volatile LAS unsigned* st; };

__device__ __forceinline__ XcdBarrier xcd_barrier_post(unsigned* bar, volatile LAS unsigned* st, bool leader) {
    XcdBarrier b; b.bar = bar; b.x = xb_xcc_id(); b.st = st;
    if (leader) (void)xb_add(&bar[XB_XCNT(b.x)], 1u);
    return b;
}
__device__ __forceinline__ void xcd_barrier_complete(unsigned* bar, unsigned x, unsigned& nloc, unsigned& nx) {
    const unsigned G = gridDim.x * gridDim.y * gridDim.z;
    unsigned sum, cnt, mine, sp = 0u;
    for (;;) {
        sum = 0u; cnt = 0u; mine = 0u;
#pragma unroll 1
        for (unsigned j = 0; j < 16; ++j) { const unsigned c = xb_ld(&bar[XB_XCNT(j)]); sum += c; cnt += (c > 0u) ? 1u : 0u; mine = (j == x) ? c : mine; }
        if (sum == G) break;
        __builtin_amdgcn_s_sleep(1);
        if ((++sp & 255u) == 0u) { if (xb_ld(&bar[XB_TMO])) break; if (sp > XB_SPIN_CAP) { atomicAdd(&bar[XB_TMO], 1u); break; } }
    }
    nloc = mine > 0u ? mine : 1u; nx = cnt > 0u ? cnt : 1u;
}
__device__ __forceinline__ void xcd_barrier(const XcdBarrier& b, int wave_id) {
    asm volatile("s_waitcnt vmcnt(0)" ::: "memory");
    __syncthreads();
    if (wave_id == 0 && hw_lane() == 0) {
        unsigned* bar; { unsigned long long _b = (unsigned long long)b.bar; asm volatile("" : "+s"(_b)); bar = (unsigned*)_b; }
        __builtin_amdgcn_s_waitcnt(0);
        unsigned nloc = b.st[0], nx = b.st[1];
        if (nloc == 0u) { xcd_barrier_complete(bar, b.x, nloc, nx); b.st[0] = nloc; b.st[1] = nx; }
        const unsigned old = xb_add(&bar[XB_XSUB(b.x)], 1u);
        const unsigned gen = old / nloc;
        if (old + 1u == (gen + 1u) * nloc) {
            __builtin_amdgcn_fence(__ATOMIC_RELEASE, "agent");
            asm volatile("s_waitcnt vmcnt(0)" ::: "memory");
            const unsigned og = xb_add(&bar[XB_TOP], 1u);
            const unsigned tg = og / nx;
            if (og + 1u == (tg + 1u) * nx) xb_add(&bar[XB_TOPGEN], 1u);
            else XB_SPIN(xb_ld(&bar[XB_TOPGEN]) == tg, bar);
            __builtin_amdgcn_fence(__ATOMIC_ACQUIRE, "agent");
            xb_add(&bar[XB_XGEN(b.x)], 1u);
            asm volatile("s_waitcnt vmcnt(0)" ::: "memory");
        } else {
            XB_SPIN(xb_ld(&bar[XB_XGEN(b.x)]) == gen, bar);
            __builtin_amdgcn_fence(__ATOMIC_ACQUIRE, "agent");
            asm volatile("s_waitcnt vmcnt(0)" ::: "memory");
        }
    }
    __syncthreads();
}

#ifdef PROBE_CLK
#define CLK_S(k) do { if (F.wave == 0) { volatile unsigned long long* _c = (volatile unsigned long long*)((unsigned char*)F.ws + 131072 + F.bid * 1024); const unsigned long long _r = __builtin_amdgcn_s_memrealtime(), _t = __builtin_amdgcn_s_memtime(); if (hw_lane() == 0) { _c[(k)] = _r; _c[32 + (k)] = _t; } } } while (0)
#define CLK_X(k) do { if (F.wave == 0) { volatile unsigned long long* _c = (volatile unsigned long long*)((unsigned char*)F.ws + 131072 + F.bid * 1024); const unsigned long long _r = __builtin_amdgcn_s_memrealtime(); if (hw_lane() == 0) _c[64 + (k)] = _r; } } while (0)
#else
#define CLK_X(k) do { } while (0)
#define CLK_S(k) do { } while (0)
#endif
__device__ __forceinline__ int win_src(int n) {
    if (n < 1152) return n;
    if (n < 1408) return n - 1152 + 1164;
    if (n < 1536) return n - 1408 + 1420;
    if (n < 1792) return n - 1536 + 1580;
    if (n < 1824) return n - 1792 + 1548;
    if (n < 1836) return n - 1824 + 1152;
    return -1;
}
template <int MODE> __device__ __forceinline__ void transpose_item(const float* W, int K, int ldn, bf16_t* WT, const float* ks, float cs0, LAS float* scr, int item, int nblk, int lane, int ldw = 0, const float* ncs = nullptr) {
    if (ldw == 0) ldw = K;
    const int kb = item / nblk, nb = item % nblk, k0 = 64 * kb, n0 = 32 * nb;
    {
        const int n4 = (lane & 7) * 4; f32x4 nsc = {cs0, cs0, cs0, cs0};
        int sc4 = n0 + n4;
        if (MODE == 1) { sc4 = win_src(n0 + n4); const float q = (n0 + n4 >= UC_Q && n0 + n4 < UC_KV) ? NSA_QSCALE : 1.0f; nsc = (f32x4){q, q, q, q}; }
        if (ncs) { const f32x4 t = *(const f32x4*)(ncs + n0 + n4); nsc = nsc * t; }
        f32x4 v[8];
#pragma unroll
        for (int i = 0; i < 8; ++i) v[i] = (sc4 >= 0) ? __builtin_nontemporal_load((const f32x4*)(W + (size_t)(k0 + (lane >> 3) + 8 * i) * ldn + sc4)) : (f32x4){0.f, 0.f, 0.f, 0.f};
#pragma unroll
        for (int i = 0; i < 8; ++i) { const int kk = (lane >> 3) + 8 * i; f32x4 x = v[i] * nsc; if (ks) x = x * ks[k0 + kk];
            LAS float* d = scr + kk * 33 + n4; d[0] = x[0]; d[1] = x[1]; d[2] = x[2]; d[3] = x[3]; }
    }
    asm volatile("s_waitcnt lgkmcnt(0)" ::: "memory");
    const int c = lane & 7;
#pragma unroll
    for (int j = 0; j < 4; ++j) { const int n = (lane >> 3) + 8 * j; const LAS float* s = scr + (8 * c) * 33 + n;
        u32x4 o; o.x = cvt_pk_bf16(s[0 * 33], s[1 * 33]); o.y = cvt_pk_bf16(s[2 * 33], s[3 * 33]); o.z = cvt_pk_bf16(s[4 * 33], s[5 * 33]); o.w = cvt_pk_bf16(s[6 * 33], s[7 * 33]);
        *(u32x4*)(WT + (size_t)(n0 + n) * ldw + k0 + 8 * c) = o; }
    asm volatile("s_waitcnt lgkmcnt(0)" ::: "memory");
}

__device__ __forceinline__ void fold_item(int kind, int k8, int nblk, const float* pw, const float* poolw, const float* pscale, const float* Wout, bf16_t* WoutT, int lane) {
    const int n = 64 * nblk + lane; float acc[8];
#pragma unroll
    for (int i = 0; i < 8; ++i) acc[i] = 0.f;
    int kdst, J; const float* arow; const float* wsrc; const float* sc = nullptr;
    if (kind == 0) { kdst = 8 * k8; J = 256; arow = pw + (size_t)kdst * 256; wsrc = Wout + n; }
    else { const int g = k8 >> 3, c0 = 8 * (k8 & 7); kdst = 768 + 64 * g + c0; J = 64; arow = poolw + (size_t)(g * 64 + c0) * 64; wsrc = Wout + (size_t)(768 + 64 * g) * DMODEL + n; sc = pscale + 64 * g; }
#pragma unroll 1
    for (int j0 = 0; j0 < J; j0 += 32) {
        float av[4], w[32];
#pragma unroll
        for (int q = 0; q < 4; ++q) av[q] = arow[(lane >> 3) * J + j0 + (lane & 7) + 8 * q];
#pragma unroll
        for (int jj = 0; jj < 32; ++jj) { w[jj] = wsrc[(size_t)(j0 + jj) * DMODEL]; if (sc) w[jj] *= sc[j0 + jj]; }
#pragma unroll
        for (int i = 0; i < 8; ++i)
#pragma unroll
            for (int jj = 0; jj < 32; ++jj) acc[i] += __builtin_bit_cast(float, __builtin_amdgcn_readlane(__builtin_bit_cast(int, av[jj >> 3]), 8 * i + (jj & 7))) * w[jj];
    }
    u32x4 o; o.x = cvt_pk_bf16(acc[0], acc[1]); o.y = cvt_pk_bf16(acc[2], acc[3]); o.z = cvt_pk_bf16(acc[4], acc[5]); o.w = cvt_pk_bf16(acc[6], acc[7]);
    *(u32x4*)(WoutT + (size_t)n * DMODEL + kdst) = o;
}

__device__ __forceinline__ void zero_item(bf16_t* WT, int ldw, int kb, int nb, int lane) {
#pragma unroll
    for (int j = 0; j < 4; ++j) { const int n = (lane >> 3) + 8 * j; *(u32x4*)(WT + (size_t)(32 * nb + n) * ldw + 64 * kb + 8 * (lane & 7)) = (u32x4){0u, 0u, 0u, 0u}; }
}

__device__ __forceinline__ void prologue(const Args& a, Frame F) {
    LAUNDER(F);
    if (F.bid == 0 && F.tid == 0) { const float** tab = (const float**)(F.ws + WS_TAB);
#pragma unroll
        for (int k = 0; k < 23; ++k) tab[k] = a.in[k];
        tab[23] = a.out; }
    LAS float* scr = (LAS float*)(F.lds + F.wave * 16384);
    const int gw = F.bid * 8 + F.wave, NGW = F.G * 8;
    constexpr int I_WIN = 16 * 64, I_WOUT = 8 * 32, I_W1 = 16 * 128, I_W2 = 64 * 32, I_QKV = 6 * 32, I_FOLD = 2 * 32 * 16, I_C1 = 32 * 4, I_C2 = 2 * 2;
    auto item = [&](int kind, int idx) {
        if (kind == 0) { if (idx >= NLAYER * I_FOLD) return; const int l = idx / I_FOLD, g_ = idx % I_FOLD, r = ((g_ & 1) << 9) | (g_ >> 1);
            unsigned char* wl = (unsigned char*)(F.ws + WS_W + (size_t)l * W_LAYER);
            fold_item(r >> 9, (r >> 4) & 31, r & 15, a.in[9] + (size_t)l * 256 * 256, a.in[17] + (size_t)l * 4 * 64 * 64, a.in[18] + l * 256, a.in[2] + (size_t)l * DMODEL * DMODEL, (bf16_t*)(wl + WO_WOUT), F.lane); }
        else if (kind == 1) { if (idx >= NLAYER * I_WIN) return; const int l = idx / I_WIN, r = idx % I_WIN; unsigned char* wl = (unsigned char*)(F.ws + WS_W + (size_t)l * W_LAYER);
            transpose_item<1>(a.in[1] + (size_t)l * DMODEL * DIN, DMODEL, DIN, (bf16_t*)(wl + WO_WIN), a.in[3] + l * DMODEL, 1.f, scr, r, 64, F.lane); }
        else if (kind == 2) { if (idx >= NLAYER * I_W1) return; const int l = idx / I_W1, r = idx % I_W1; unsigned char* wl = (unsigned char*)(F.ws + WS_W + (size_t)l * W_LAYER);
            transpose_item<0>(a.in[19] + (size_t)l * DMODEL * DFF, DMODEL, DFF, (bf16_t*)(wl + WO_W1), a.in[4] + l * DMODEL, 1.f, scr, r, 128, F.lane); }
        else if (kind == 3) { if (idx >= NLAYER * I_W2) return; const int l = idx / I_W2, r = idx % I_W2; unsigned char* wl = (unsigned char*)(F.ws + WS_W + (size_t)l * W_LAYER);
            transpose_item<0>(a.in[20] + (size_t)l * DFF * DMODEL, DFF, DMODEL, (bf16_t*)(wl + WO_W2), nullptr, 1.f, scr, r, 32, F.lane); }
        else {
            constexpr int I_MISC = I_WOUT + I_QKV + 2 * I_C1 + 2 * I_C2;
            if (idx >= NLAYER * I_MISC) return; const int l = idx / I_MISC; int r = idx % I_MISC; unsigned char* wl = (unsigned char*)(F.ws + WS_W + (size_t)l * W_LAYER);
            if (r < I_WOUT) {
                transpose_item<0>(a.in[2] + (size_t)l * DMODEL * DMODEL, DMODEL, DMODEL, (bf16_t*)(wl + WO_WOUT), nullptr, 1.f, scr, r + 4 * 32, 32, F.lane); return; } r -= I_WOUT;
            if (r < I_QKV) {
                const int kb = r / 32, nb = r % 32; bf16_t* WT = (bf16_t*)(wl + WO_QKV);
                if (nb < 12 && kb < 4) transpose_item<0>(a.in[14] + (size_t)l * 256 * 384, 256, 384, WT, a.in[13] + l * 256, MLA_QSCALE, scr, kb * 12 + nb, 12, F.lane, 384);
                else if (nb >= 12 && nb < 28 && kb >= 4) transpose_item<0>(a.in[16] + (size_t)l * 128 * 512, 128, 512, WT + (size_t)384 * 384 + 256, a.in[15] + l * 128, 1.f, scr, (kb - 4) * 16 + (nb - 12), 16, F.lane, 384);
                else zero_item(WT, 384, kb, nb, F.lane);
                return; } r -= I_QKV;
            if (r < 2 * I_C1) { const int i = r / I_C1; transpose_item<0>(a.in[11] + (size_t)(l * 2 + i) * 2048 * 128, 2048, 128, (bf16_t*)(wl + WO_C1) + (size_t)i * 128 * 2048, nullptr, 1.f, scr, r % I_C1, 4, F.lane); return; } r -= 2 * I_C1;
            { const int i = r / I_C2; transpose_item<0>(a.in[12] + (size_t)(l * 2 + i) * 128 * 64, 128, 64, (bf16_t*)(wl + WO_C2) + (size_t)i * 64 * 128, nullptr, 1.f, scr, r % I_C2, 2, F.lane); }
        }
    };
#pragma unroll 1
    for (int step = 0; step < 2; ++step) {
    if (((F.wave & 1) != 0) != (step == 0)) {
    for (int g = gw; g < 2048; g += NGW) {
        item(0, g); item(1, g); item(2, g); item(2, g + 2048); item(3, g); item(3, g + 2048); item(4, g);
    }
    } else
    {
        const float* x = a.in[0]; bf16_t* hb = (bf16_t*)(F.ws + WS_HB); float* ss = (float*)(F.ws + WS_SS);
        LAS unsigned* ctr = (LAS unsigned*)(F.lds + LDS_CTL + 64);
        const int nchunk = (MTOK / 4 - F.bid + F.G - 1) / F.G;
        for (;;) {
            unsigned cch = 0; if (F.lane == 0) cch = __hip_atomic_fetch_add(ctr, 1u, __ATOMIC_RELAXED, __HIP_MEMORY_SCOPE_WORKGROUP);
            cch = (unsigned)__builtin_amdgcn_readfirstlane((int)cch);
            if ((int)cch >= nchunk) break;
            const int m0 = (F.bid + (int)cch * F.G) * 4;
            f32x4 v[4][4];
#pragma unroll
            for (int r = 0; r < 4; ++r) { const f32x4* xr = (const f32x4*)(x + (size_t)(m0 + r) * DMODEL) + F.lane;
#pragma unroll
                for (int j = 0; j < 4; ++j) v[r][j] = __builtin_nontemporal_load(xr + 64 * j); }
#pragma unroll
            for (int r = 0; r < 4; ++r) { u32x2* hr = (u32x2*)(hb + (size_t)(m0 + r) * DMODEL) + F.lane; float s = 0.f;
#pragma unroll
                for (int j = 0; j < 4; ++j) { u32x2 w; w.x = cvt_pk_bf16(v[r][j][0], v[r][j][1]); w.y = cvt_pk_bf16(v[r][j][2], v[r][j][3]); hr[64 * j] = w;
                    const float r0 = __uint_as_float(w.x << 16), r1 = __uint_as_float(w.x & 0xffff0000u), r2 = __uint_as_float(w.y << 16), r3 = __uint_as_float(w.y & 0xffff0000u); s += (r0 * r0 + r1 * r1) + (r2 * r2 + r3 * r3); }
                s = wave_sum(s);
                if (F.lane < 16) ss[(size_t)(m0 + r) * 16 + F.lane] = (F.lane == 0) ? s : 0.f; }
        }
    }
    }
    CLK_X(1);
    {
        float* rope = (float*)(F.ws + WS_ROPE);
        for (int idx = F.bid * 512 + F.tid; idx < SEQ * 16; idx += F.G * 512) {
            const int pos = idx >> 4, f = idx & 15;
            const float inv_freq = powf(10000.0f, -(float)(2 * f) / 32.0f);
            const float ang = (float)pos * inv_freq;
            const double ad = (double)ang; const double kq = rint(ad * 0.15915494309189535);
            const float rr = (float)(ad - kq * 6.283185307179586);
            rope[pos * 32 + f] = cosf(rr); rope[pos * 32 + 16 + f] = sinf(rr);
        }
    }
    CLK_X(2);
    if (F.bid < 64) {
        const int li = F.bid >> 4, kc = F.bid & 15; const float* pos = a.in[10] + (size_t)li * 2048; const float* w1 = a.in[11] + (size_t)li * 2048 * 128;
        const int n = F.tid & 127, kq = F.tid >> 7; float s = 0.f;
        float wv[32], pv[32];
#pragma unroll
        for (int k = 0; k < 32; ++k) { wv[k] = w1[(size_t)(kc * 128 + kq * 32 + k) * 128 + n]; pv[k] = pos[kc * 128 + kq * 32 + k]; }
#pragma unroll
        for (int k = 0; k < 32; ++k) s += pv[k] * wv[k];
        LAS float* red = (LAS float*)(F.lds + 8 * 16384);
        red[F.tid] = s; __syncthreads();
        if (F.tid < 128) ((float*)(F.ws + WS_CB1))[(li * 16 + kc) * 128 + F.tid] = (red[F.tid] + red[128 + F.tid]) + (red[256 + F.tid] + red[384 + F.tid]);
        __syncthreads();
    }
    CLK_X(3);
    if (F.bid == 4) { bf16_t* kc = (bf16_t*)(F.ws + WS_KC); for (int i = F.tid; i < 8 * 64; i += 512) kc[((size_t)(i >> 6) * 512 + 511) * 64 + (i & 63)] = 0; }
}
constexpr int ASTR = 528;
constexpr int ASTR2 = 272;

__device__ __forceinline__ void conv_tile(Frame& F, int l, int tile) {
    const int T0 = tile * 64, tb = T0 & (SEQ - 1);
    const bf16_t* U = (const bf16_t*)(F.ws + WS_U); bf16_t* CAT = (bf16_t*)(F.ws + WS_CAT);
    LAS bf16_t* glu = (LAS bf16_t*)F.lds;
    LAS float* cv = (LAS float*)(F.lds + 49152);
    typedef float f32x2v __attribute__((ext_vector_type(2)));
    const int cp = F.tid & 127, tq = F.tid >> 7; f32x2v w2[31];
    { const float* dw = IN(F, 5) + (size_t)l * 31 * 256 + 2 * cp;
#pragma unroll
      for (int k = 0; k < 31; ++k) w2[k] = *(const f32x2v*)(dw + k * 256); }
    const f32x2v bias2 = *(const f32x2v*)(IN(F, 6) + l * 256 + 2 * cp);
    const f32x4 g4 = *((const f32x4*)(IN(F, 7) + l * 256) + F.lane), b4 = *((const f32x4*)(IN(F, 8) + l * 256) + F.lane);
    {
        u32x4 av[6], gv[6];
#pragma unroll
        for (int k = 0; k < 6; ++k) { int p = F.tid + 512 * k; p = p < 94 * 32 ? p : 94 * 32 - 1; const int r = p >> 5, c8 = (p & 31) * 8;
            const int rr = (tb - 30 + r >= 0) ? (T0 - 30 + r) : T0; const bf16_t* up = U + (size_t)rr * NU + c8;
            av[k] = *(const u32x4*)(up + UC_A); gv[k] = *(const u32x4*)(up + UC_G); }
#pragma unroll
        for (int k = 0; k < 6; ++k) { const int p = F.tid + 512 * k; const int r = p >> 5, c8 = (p & 31) * 8; const bool inb = (tb - 30 + r >= 0); u32x4 o;
#pragma unroll
            for (int e = 0; e < 4; ++e) {
                const float a0 = __uint_as_float(av[k][e] << 16), a1 = __uint_as_float(av[k][e] & 0xffff0000u), g0 = __uint_as_float(gv[k][e] << 16), g1 = __uint_as_float(gv[k][e] & 0xffff0000u);
                o[e] = inb ? cvt_pk_bf16(a0 * sigmoidf_(g0), a1 * sigmoidf_(g1)) : 0u; }
            if (p < 94 * 32) *(LAS u32x4*)(glu + r * 256 + c8) = o; }
    }
    __syncthreads();
    {
        const LAS unsigned* gl = (const LAS unsigned*)glu + cp;
        LAS f32x2v* cv2 = (LAS f32x2v*)cv + cp;
#pragma unroll 1
        for (int j = 0; j < 2; ++j) {
            const int r0 = 16 * tq + 8 * j; f32x2v x[38];
#pragma unroll
            for (int i = 0; i < 38; ++i) { const unsigned u = gl[(r0 + i) * 128]; x[i] = (f32x2v){__uint_as_float(u << 16), __uint_as_float(u & 0xffff0000u)}; }
#pragma unroll
            for (int tt = 0; tt < 8; ++tt) { f32x2v acc = bias2;
#pragma unroll
                for (int k = 0; k < 31; ++k) acc = __builtin_elementwise_fma(w2[k], x[tt + k], acc);
                cv2[(r0 + tt) * 128] = acc; }
        }
    }
    __syncthreads();
    {
        for (int tt = 0; tt < 8; ++tt) {
            const int row = 8 * F.wave + tt; const f32x4 x = *((const LAS f32x4*)(cv + row * 256) + F.lane);
            const float mean = wave_sum((x[0] + x[1]) + (x[2] + x[3])) * (1.f / 256.f); const f32x4 d = x - mean;
            const float var = wave_sum((d[0] * d[0] + d[1] * d[1]) + (d[2] * d[2] + d[3] * d[3])) * (1.f / 256.f); const float rstd = __builtin_amdgcn_rsqf(var + EPS);
            f32x4 y = d * rstd * g4 + b4;
#pragma unroll
            for (int e = 0; e < 4; ++e) y[e] = y[e] * sigmoidf_(y[e]);
            u32x2 wv; wv.x = cvt_pk_bf16(y[0], y[1]); wv.y = cvt_pk_bf16(y[2], y[3]);
            *((u32x2*)(CAT + (size_t)(T0 + row) * DMODEL + CC_CONV) + F.lane) = wv;
        }
    }
    __syncthreads();
}

__device__ __forceinline__ void pool_tile(Frame& F, int l, int tile) {
    const int T0 = tile * 64, tb = T0 & (SEQ - 1);
    const bf16_t* U = (const bf16_t*)(F.ws + WS_U); bf16_t* CAT = (bf16_t*)(F.ws + WS_CAT);
    LAS float* P = (LAS float*)F.lds;
    {
        u32x4 pvv[5];
#pragma unroll
        for (int k = 0; k < 5; ++k) { int p = F.tid + 512 * k; p = p < 79 * 32 ? p : 79 * 32 - 1; const int r = p >> 5, c8 = (p & 31) * 8;
            const int rr = (tb - 15 + r >= 0) ? (T0 - 15 + r) : T0; pvv[k] = *(const u32x4*)(U + (size_t)rr * NU + UC_POOL + c8); }
#pragma unroll
        for (int k = 0; k < 5; ++k) { const int p = F.tid + 512 * k; const int r = p >> 5, c8 = (p & 31) * 8; const bool inb = (tb - 15 + r >= 0); const u32x4 v = pvv[k];
            f32x4 lo = (f32x4){__uint_as_float(v[0] << 16), __uint_as_float(v[0] & 0xffff0000u), __uint_as_float(v[1] << 16), __uint_as_float(v[1] & 0xffff0000u)};
            f32x4 hi4 = (f32x4){__uint_as_float(v[2] << 16), __uint_as_float(v[2] & 0xffff0000u), __uint_as_float(v[3] << 16), __uint_as_float(v[3] & 0xffff0000u)};
            if (!inb) { lo = (f32x4){0.f, 0.f, 0.f, 0.f}; hi4 = lo; }
            if (p < 79 * 32) { *(LAS f32x4*)(P + r * 256 + c8) = lo; *(LAS f32x4*)(P + r * 256 + c8 + 4) = hi4; } }
    }
    __syncthreads();
    {
        const int c = F.tid & 255, half = F.tid >> 8, w = 2 << (c >> 6); const float invw = 1.0f / (float)w;
        float s = 0.f;
        for (int j = 1; j < w; ++j) s += P[(15 + 32 * half - j) * 256 + c];
        for (int i = 0; i < 32; ++i) {
            const int row = 32 * half + i, tpos = tb + row; const float xc = P[(15 + row) * 256 + c];
            s += xc;
            const float d = s * ((tpos + 1 < w) ? __builtin_amdgcn_rcpf((float)(tpos + 1)) : invw) - xc;
            s -= P[(15 + row - (w - 1)) * 256 + c];
            CAT[(size_t)(T0 + row) * DMODEL + CC_POOL + c] = f2bf(d);
        }
    }
    __syncthreads();
}

__device__ __forceinline__ void mla_tile(Frame& F, int l, int tile) {
    const int T0 = tile * 64, tb = T0 & (SEQ - 1);
    const bf16_t* U = (const bf16_t*)(F.ws + WS_U); const float* rope = (const float*)(F.ws + WS_ROPE);
    bf16_t* KR = (bf16_t*)(F.ws + WS_KR);
    unsigned short r1[2], r2[2]; float rc[2], rsn[2];
#pragma unroll
    for (int j = 0; j < 2; ++j) { const int idx = F.tid + 512 * j, tok = idx >> 4, i = idx & 15, pos = tb + tok; const bf16_t* up = U + (size_t)(T0 + tok) * NU + UC_KR;
        r1[j] = up[i]; r2[j] = up[16 + i]; rc[j] = rope[pos * 32 + i]; rsn[j] = rope[pos * 32 + 16 + i]; }
#pragma unroll
    for (int j = 0; j < 2; ++j) {
        const int idx = F.tid + 512 * j, tok = idx >> 4, i = idx & 15;
        const float x1 = bf2f(r1[j]), x2 = bf2f(r2[j]), cs = rc[j], sn = rsn[j];
        bf16_t* kp = KR + (size_t)(T0 + tok) * 32; kp[i] = f2bf(x1 * cs - x2 * sn); kp[16 + i] = f2bf(x1 * sn + x2 * cs);
    }
}

__device__ __forceinline__ void compress_item(Frame& F, int l, int item) {
    const int i = item >> 6, b = (item >> 4) & 3, gq = item & 15, c0 = 32 * gq, tok0 = 16 * c0;
    const bf16_t* U = (const bf16_t*)(F.ws + WS_U); bf16_t* KC = (bf16_t*)(F.ws + WS_KC);
    LAS unsigned char* Tk = F.lds;
    LAS float* part = (LAS float*)(F.lds + 67584);
    LAS unsigned char* A2 = F.lds + 83968;
    {
        u32x4 tv[9];
#pragma unroll
        for (int k = 0; k < 9; ++k) { int p = F.tid + 512 * k; p = p < 528 * 8 ? p : 528 * 8 - 1; const int r = p >> 3, ch = p & 7;
            const int rr = (tok0 + r < SEQ) ? (tok0 + r) : (SEQ - 1); tv[k] = *(const u32x4*)(U + (size_t)(b * SEQ + rr) * NU + UC_KV + i * 64 + ch * 8); }
#pragma unroll
        for (int k = 0; k < 9; ++k) { const int p = F.tid + 512 * k; const int r = p >> 3, ch = p & 7; u32x4 v = tv[k];
            if (tok0 + r >= SEQ) v = (u32x4){0u, 0u, 0u, 0u};
            if (p < 528 * 8) *(LAS u32x4*)(Tk + r * 128 + ((ch ^ ((r >> 4) & 7)) * 16)) = v; }
    }
    __syncthreads();
    const int r32 = F.lane & 31, hi = F.lane >> 5, cb = F.wave & 3, kh = F.wave >> 2;
    const unsigned char* wl = (const unsigned char*)(F.ws + WS_W + (size_t)l * W_LAYER);
    f32x16 acc = {};
    {
        const bf16_t* bp = (const bf16_t*)(wl + WO_C1) + (size_t)i * 128 * 2048 + (size_t)(cb * 32 + r32) * 2048 + hi * 8;
#pragma unroll 8
        for (int ks = kh * 64; ks < kh * 64 + 64; ++ks) {
            const int ll = ks >> 2, dq = ks & 3, token = 16 * r32 + ll, chunk = dq * 2 + hi;
            const bf16x8 av = *(const LAS bf16x8*)(Tk + token * 128 + ((chunk ^ ((token >> 4) & 7)) * 16));
            const bf16x8 bv = *(const bf16x8*)(bp + ks * 16);
            acc = __builtin_amdgcn_mfma_f32_32x32x16_bf16(av, bv, acc, 0, 0, 0);
        }
    }
    if (kh == 1) {
#pragma unroll
        for (int r = 0; r < 16; ++r) part[cb * 1024 + r * 64 + F.lane] = acc[r];
    }
    __syncthreads();
    if (kh == 0) {
        float bias = 0.f; { const float* cbp = (const float*)(F.ws + WS_CB1) + (size_t)(l * 2 + i) * 16 * 128 + cb * 32 + r32;
#pragma unroll
            for (int kc = 0; kc < 16; ++kc) bias += cbp[kc * 128]; }
#pragma unroll
        for (int r = 0; r < 16; ++r) { float h = acc[r] + part[cb * 1024 + r * 64 + F.lane] + bias; h = h * sigmoidf_(h);
            *(LAS bf16_t*)(A2 + crow(r, hi) * ASTR2 + (cb * 32 + r32) * 2) = f2bf(h); }
    }
    __syncthreads();
    if (F.wave < 2) {
        const f32x16 o = small_mm<128>(A2, ASTR2, (const bf16_t*)(wl + WO_C2) + (size_t)i * 64 * 128 + (size_t)F.wave * 32 * 128, F.lane);
#pragma unroll
        for (int r = 0; r < 16; ++r) { const int row = c0 + crow(r, hi); KC[((size_t)(i * 4 + b) * 512 + row) * 64 + F.wave * 32 + r32] = (row < 511) ? f2bf(o[r]) : (bf16_t)0; }
    }
    __syncthreads();
}

namespace pg8 {
struct EpiStore {
    static constexpr bool PERM = true, AFTER_DRAIN = false;
    bf16_t* O;
    __device__ __forceinline__ void operator()(const f32x4 (&acc)[2][2][4][2], const Unit& u, int wr, int wc, int fr, int fq) const {
        { int ln_; asm volatile("v_mbcnt_lo_u32_b32 %0, -1, 0\n\tv_mbcnt_hi_u32_b32 %0, -1, %0" : "=v"(ln_)); fr = ln_ & 15; fq = ln_ >> 4; }
        bf16_t* lp = O + (size_t)(u.pm * BM + wr * 64 + fr) * 1024 + u.pn * BM + wc * 32 + 8 * fq;
#pragma unroll
        for (int ai = 0; ai < 2; ++ai)
#pragma unroll
            for (int m = 0; m < 4; ++m)
#pragma unroll
                for (int bj = 0; bj < 2; ++bj) { const f32x4 v0 = acc[ai][bj][m][0], v1 = acc[ai][bj][m][1];
                    u32x4 w; w.x = cvt_pk_bf16(v0[0], v0[1]); w.y = cvt_pk_bf16(v0[2], v0[3]); w.z = cvt_pk_bf16(v1[0], v1[1]); w.w = cvt_pk_bf16(v1[2], v1[3]);
                    *(u32x4*)(lp + (ai * HALF + m * 16) * 1024 + bj * HALF) = w; }
    }
};
struct EpiQKV {
    static constexpr bool PERM = true, AFTER_DRAIN = false;
    bf16_t* O; const PG8_LAS float* rs;
    __device__ __forceinline__ void operator()(const f32x4 (&acc)[2][2][4][2], const Unit& u, int wr, int wc, int fr, int fq) const {
        { int ln_; asm volatile("v_mbcnt_lo_u32_b32 %0, -1, 0\n\tv_mbcnt_hi_u32_b32 %0, -1, %0" : "=v"(ln_)); fr = ln_ & 15; fq = ln_ >> 4; }
        const int rl0 = wr * 64 + fr;
        bf16_t* lp = O + (size_t)(u.pm * BM + rl0) * 1024 + u.pn * BM + wc * 32 + 8 * fq;
#pragma unroll
        for (int ai = 0; ai < 2; ++ai)
#pragma unroll
            for (int m = 0; m < 4; ++m) { const int rl = rl0 + ai * HALF + m * 16; const float sq = rs[u.ui * 256 + rl], sk = rs[(4 + u.ui) * 256 + rl];
#pragma unroll
                for (int bj = 0; bj < 2; ++bj) { const float s = (u.pn * 2 + bj < 3) ? sq : sk; const f32x4 v0 = acc[ai][bj][m][0] * s, v1 = acc[ai][bj][m][1] * s;
                    u32x4 w; w.x = cvt_pk_bf16(v0[0], v0[1]); w.y = cvt_pk_bf16(v0[2], v0[3]); w.z = cvt_pk_bf16(v1[0], v1[1]); w.w = cvt_pk_bf16(v1[2], v1[3]);
                    *(u32x4*)(lp + (ai * HALF + m * 16) * 1024 + bj * HALF) = w; } }
    }
};
}

template <class Sched> __device__ __forceinline__ void build_rs_qkv(Frame& F, const Sched& S) {
    LAS float* rs = (LAS float*)(F.lds + LDS_RS); const bf16_t* U = (const bf16_t*)(F.ws + WS_U); pg8::Unit u;
    const int rsub = F.lane >> 4, c = F.lane & 15;
    auto sq8 = [](const u32x4 v) { float s = 0.f;
#pragma unroll
        for (int e = 0; e < 4; ++e) { const float a = __uint_as_float(v[e] << 16), b = __uint_as_float(v[e] & 0xffff0000u); s += a * a + b * b; } return s; };
    for (int i = 0; i < 4 && S.next(i, u); ++i) {
        u32x4 a0[8], a1[8], b0[8];
#pragma unroll
        for (int it = 0; it < 8; ++it) { const bf16_t* up = U + (size_t)(u.pm * 256 + 32 * F.wave + 4 * it + rsub) * NU;
            a0[it] = *(const u32x4*)(up + UC_CQ + 8 * c); a1[it] = *(const u32x4*)(up + UC_CQ + 128 + 8 * c); b0[it] = *(const u32x4*)(up + UC_CKV + 8 * c); }
#pragma unroll
        for (int it = 0; it < 8; ++it) { float q = sq8(a0[it]) + sq8(a1[it]), k = sq8(b0[it]);
            q += dpp_f<0xB1>(q); k += dpp_f<0xB1>(k); q += dpp_f<0x4E>(q); k += dpp_f<0x4E>(k); q += dpp_f<0x141>(q); k += dpp_f<0x141>(k); q += dpp_f<0x140>(q); k += dpp_f<0x140>(k);
            if (c == 0) { const int r = 32 * F.wave + 4 * it + rsub; rs[i * 256 + r] = __builtin_amdgcn_rsqf(q * (1.f / 256.f) + EPS); rs[(4 + i) * 256 + r] = __builtin_amdgcn_rsqf(k * (1.f / 128.f) + EPS); } }
    }
    __syncthreads();
}

__device__ __forceinline__ void phaseB(Frame F, int l) {
    LAUNDER(F);
    for (int t = F.bid; t < MTOK / 64; t += F.G) conv_tile(F, l, t);
    for (int t = F.bid; t < MTOK / 64; t += F.G) pool_tile(F, l, t);
    for (int t = F.bid; t < MTOK / 64; t += F.G) mla_tile(F, l, t);
    for (int t = F.G - 1 - F.bid; t < 128; t += F.G) compress_item(F, l, t);
    __syncthreads();
    {
        pg8::Gemm g{(const bf16_t*)(F.ws + WS_U) + UC_CQ, (const bf16_t*)(F.ws + WS_W + (size_t)l * W_LAYER + WO_QKV), MTOK, 1024, 384, NU};
        pg8::ListOrder S; S.init(MTOK, 1024, F.G, F.bid);
        build_rs_qkv(F, S);
        pg8::EpiQKV E{(bf16_t*)(F.ws + WS_QKVO), (const LAS float*)(F.lds + LDS_RS)};
        pg8::gemm_phase<pg8::EpiQKV, pg8::ListOrder, true, true>(F.lds, g, S, E, F.wave);
    }
}
namespace att {
constexpr int SLOTB = 20480, VOFF = 12288;
constexpr int L_RING = 0, L_OACC = 4 * SLOTB, L_IMP = L_OACC, L_WS = L_OACC + 65536, L_BT = L_WS + 2048, L_SEL = L_BT + 2304, L_GATE = L_SEL + 1024, L_END = L_GATE + 3072;
static_assert(L_END <= LDS_CTL && 6 * SLOTB <= L_WS, "attention LDS");
constexpr float NEG_INF = -__builtin_inff();

__device__ __forceinline__ float btab(const LAS float* t, int d) { return t[min(max(d, 0), 128)]; }
struct TileSrc { const bf16_t* K; int kpitch; const bf16_t* V; int vpitch; const bf16_t* K2; int k2pitch; };

struct DmaPtr { const bf16_t* k; const bf16_t* v; const bf16_t* k2; };
template <int DQK> __device__ __forceinline__ DmaPtr dma_init(const TileSrc& T, int kv0, int wid, int lane) {
    DmaPtr p; p.k = T.K + (size_t)(kv0 + lane) * T.kpitch + wid * 8;
    p.v = T.V + (size_t)(kv0 + 16 * (wid & 3) + (lane >> 2)) * T.vpitch + (wid >> 2) * 32 + (lane & 3) * 8;
    p.k2 = (DQK == 96) ? T.K2 + (size_t)(kv0 + lane) * T.k2pitch + (wid & 3) * 8 : nullptr; return p;
}
template <int DQK> __device__ __forceinline__ void dma_tile(DmaPtr& p, const TileSrc& T, LAS unsigned char* slot, int wid, int par) {
    __builtin_amdgcn_global_load_lds((const unsigned*)p.k, (LAS unsigned*)(slot + wid * 1024), 16, 0, 0);
    if (DQK == 96) { if ((wid < 4) == (par == 0)) __builtin_amdgcn_global_load_lds((const unsigned*)p.k2, (LAS unsigned*)(slot + ((wid & 3) + 8) * 1024), 16, 0, 0); }
    __builtin_amdgcn_global_load_lds((const unsigned*)p.v, (LAS unsigned*)(slot + VOFF + wid * 1024), 16, 0, 0);
    p.k += (size_t)64 * T.kpitch; p.v += (size_t)64 * T.vpitch; if (DQK == 96) p.k2 += (size_t)64 * T.k2pitch;
}
#define ATT_VMWAIT(n) asm volatile("s_waitcnt vmcnt(" #n ")" ::: "memory")
__device__ __forceinline__ void wait_tiles(int rem, bool three) {
    if (three) { if (rem == 0) ATT_VMWAIT(0); else if (rem == 1) ATT_VMWAIT(3); else ATT_VMWAIT(6); }
    else       { if (rem == 0) ATT_VMWAIT(0); else if (rem == 1) ATT_VMWAIT(2); else ATT_VMWAIT(4); }
}
template <int DQK, int TPB, class Body> __device__ __forceinline__ void tile_loop_n(const TileSrc& T, int NT, int kv_first, Body body, LAS unsigned char* ring, int wid, int lane) {
    constexpr int NSLOT = 2 * TPB;
    DmaPtr dp = dma_init<DQK>(T, kv_first, wid, lane);
#pragma unroll
    for (int k = 0; k < TPB; ++k) if (k < NT) dma_tile<DQK>(dp, T, ring + k * SLOTB, wid, k & 1);
    int sbase = 0;
    for (int i = 0; i < NT; i += TPB) {
        ATT_VMWAIT(0);
        __builtin_amdgcn_s_barrier();
        const int snext = TPB - sbase;
#pragma unroll
        for (int k = 0; k < TPB; ++k) if (i + TPB + k < NT) dma_tile<DQK>(dp, T, ring + (snext + k) * SLOTB, wid, (i + TPB + k) & 1);
#pragma unroll
        for (int k = 0; k < TPB; ++k) if (i + k < NT) body(i + k, ring + (sbase + k) * SLOTB);
        sbase = snext;
    }
    asm volatile("s_waitcnt lgkmcnt(0)" ::: "memory");
    __builtin_amdgcn_s_barrier();
}
template <int DQK, class Body> __device__ __forceinline__ void tile_loop(const TileSrc& T, int NT, int kv_first, Body body, LAS unsigned char* ring, int wid, int lane) {
    tile_loop_n<DQK, 2>(T, NT, kv_first, body, ring, wid, lane);
}

struct Chain { int sbase; bool primed; };
template <int DQK, int DQKN, class Body> __device__ __forceinline__ void tile_loop_c(const TileSrc& T, int NT, int kv_first, Body body, LAS unsigned char* ring, int wid, int lane,
                                                                                     Chain& ch, const TileSrc* Tn, int NTn, int kvn) {
    int sbase = ch.primed ? ch.sbase : 0;
    DmaPtr dp = dma_init<DQK>(T, kv_first + (ch.primed ? 64 * (NT < 2 ? NT : 2) : 0), wid, lane);
    if (!ch.primed) { for (int k = 0; k < 2; ++k) if (k < NT) dma_tile<DQK>(dp, T, ring + k * SLOTB, wid, k); }
    for (int i = 0; i < NT; i += 2) {
        ATT_VMWAIT(0);
        __builtin_amdgcn_s_barrier();
        const int snext = 2 - sbase;
        if (i + 2 < NT) { dma_tile<DQK>(dp, T, ring + snext * SLOTB, wid, 0); if (i + 3 < NT) dma_tile<DQK>(dp, T, ring + (snext + 1) * SLOTB, wid, 1); }
        else if (Tn) { DmaPtr np = dma_init<DQKN>(*Tn, kvn, wid, lane); dma_tile<DQKN>(np, *Tn, ring + snext * SLOTB, wid, 0); if (NTn > 1) dma_tile<DQKN>(np, *Tn, ring + (snext + 1) * SLOTB, wid, 1); }
        body(i, ring + sbase * SLOTB);
        if (i + 1 < NT) body(i + 1, ring + (sbase + 1) * SLOTB);
        sbase = snext;
    }
    if (Tn) { ch.primed = true; ch.sbase = sbase; }
    else { ch.primed = false; asm volatile("s_waitcnt lgkmcnt(0)" ::: "memory"); __builtin_amdgcn_s_barrier(); }
}

template <int DQK, class Front, class Back> __device__ __forceinline__ void stag_loop(const TileSrc& T, int NT, int kv_first, Front front, Back back, LAS unsigned char* ring, int wid, int lane) {
#ifdef STAG_ODD
    const bool late = (wid & 1) != 0;
#else
    const bool late = wid >= 4;
#endif
    DmaPtr dp = dma_init<DQK>(T, kv_first, wid, lane);
    for (int i = 0; i < 2; ++i) if (i < NT) dma_tile<DQK>(dp, T, ring + i * SLOTB, wid, i);
    for (int i = 0; i < NT; ++i) {
        if (i + 1 < NT) { if (DQK == 96 && ((wid < 4) == (((i + 1) & 1) == 0))) ATT_VMWAIT(3); else ATT_VMWAIT(2); } else ATT_VMWAIT(0);
        __builtin_amdgcn_s_barrier();
        if (i + 2 < NT) dma_tile<DQK>(dp, T, ring + ((i + 2) & 3) * SLOTB, wid, i & 1);
        if (late) { if (i > 0) back(i - 1, ring + ((i - 1) & 3) * SLOTB); front(i, ring + (i & 3) * SLOTB); }
        else      { front(i, ring + (i & 3) * SLOTB); back(i, ring + (i & 3) * SLOTB); }
    }
    if (late) back(NT - 1, ring + ((NT - 1) & 3) * SLOTB);
    asm volatile("s_waitcnt lgkmcnt(0)" ::: "memory");
    __builtin_amdgcn_s_barrier();
}

template <int DQK> __device__ __forceinline__ void qk(f32x16& p0, f32x16& p1, const LAS unsigned char* kslot, const bf16x8* qf, float cinit, int r32, int hi) {
#pragma unroll
    for (int r = 0; r < 16; ++r) { p0[r] = cinit; p1[r] = cinit; }
    const LAS unsigned char* kb = kslot + hi * 1024 + r32 * 16;
    bf16x8 kf[DQK / 8];
#pragma unroll
    for (int d0 = 0; d0 < DQK / 16; ++d0) { kf[2 * d0] = *(const LAS bf16x8*)(kb + d0 * 2048); kf[2 * d0 + 1] = *(const LAS bf16x8*)(kb + d0 * 2048 + 512); }
    __builtin_amdgcn_sched_barrier(0);
#pragma unroll
    for (int d0 = 0; d0 < DQK / 16; ++d0) {
        p0 = __builtin_amdgcn_mfma_f32_32x32x16_bf16(kf[2 * d0], qf[d0], p0, 0, 0, 0);
        p1 = __builtin_amdgcn_mfma_f32_32x32x16_bf16(kf[2 * d0 + 1], qf[d0], p1, 0, 0, 0);
    }
}
template <int DQK> __device__ __forceinline__ void qk_c(f32x16& p0, f32x16& p1, const LAS unsigned char* kslot, const bf16x8* qf, const f32x16& c, int r32, int hi) {
    const LAS unsigned char* kb = kslot + hi * 1024 + r32 * 16;
    bf16x8 kf[DQK / 8];
#pragma unroll
    for (int d0 = 0; d0 < DQK / 16; ++d0) { kf[2 * d0] = *(const LAS bf16x8*)(kb + d0 * 2048); kf[2 * d0 + 1] = *(const LAS bf16x8*)(kb + d0 * 2048 + 512); }
    __builtin_amdgcn_sched_barrier(0);
    p0 = __builtin_amdgcn_mfma_f32_32x32x16_bf16(kf[0], qf[0], c, 0, 0, 0);
    p1 = __builtin_amdgcn_mfma_f32_32x32x16_bf16(kf[1], qf[0], c, 0, 0, 0);
#pragma unroll
    for (int d0 = 1; d0 < DQK / 16; ++d0) {
        p0 = __builtin_amdgcn_mfma_f32_32x32x16_bf16(kf[2 * d0], qf[d0], p0, 0, 0, 0);
        p1 = __builtin_amdgcn_mfma_f32_32x32x16_bf16(kf[2 * d0 + 1], qf[d0], p1, 0, 0, 0);
    }
}
__device__ __forceinline__ void mfma_pad(f32x16& p) { asm volatile("s_nop 7\n\ts_nop 7\n\ts_nop 3" : "+v"(p)); }
__device__ __forceinline__ float max3f(float a, float b, float c) { float r; asm("v_max3_f32 %0, %1, %2, %3" : "=v"(r) : "v"(a), "v"(b), "v"(c)); return r; }
__device__ __forceinline__ float half_swap_max(float v) { auto rr = __builtin_amdgcn_permlane32_swap(__float_as_uint(v), __float_as_uint(v), false, false); return fmaxf(__uint_as_float(rr[0]), __uint_as_float(rr[1])); }
__device__ __forceinline__ float half_swap_sum(float v) { auto rr = __builtin_amdgcn_permlane32_swap(__float_as_uint(v), __float_as_uint(v), false, false); return __uint_as_float(rr[0]) + __uint_as_float(rr[1]); }
__device__ __forceinline__ float rowmax(f32x16& p0, f32x16& p1) {
    mfma_pad(p0); mfma_pad(p1);
    float a = max3f(p0[0], p1[0], p0[1]), b = max3f(p1[1], p0[2], p1[2]);
#pragma unroll
    for (int r = 3; r < 15; r += 2) { a = max3f(a, p0[r], p1[r]); b = max3f(b, p0[r + 1], p1[r + 1]); }
    a = max3f(a, p0[15], p1[15]);
    return half_swap_max(fmaxf(a, b));
}
__device__ __forceinline__ void pv(f32x16 (&o)[2], const f32x16& p0, const f32x16& p1, const LAS unsigned char* vslot, int lane) {
    u32x4 pw[4];
#pragma unroll
    for (int e = 0; e < 4; ++e) { pw[0][e] = cvt_pk_bf16(p0[2 * e], p0[2 * e + 1]); pw[1][e] = cvt_pk_bf16(p0[8 + 2 * e], p0[9 + 2 * e]);
                                  pw[2][e] = cvt_pk_bf16(p1[2 * e], p1[2 * e + 1]); pw[3][e] = cvt_pk_bf16(p1[8 + 2 * e], p1[9 + 2 * e]); }
    const int hi = lane >> 5;
    const unsigned vb = (unsigned)(size_t)vslot + ((lane >> 4) & 1) * 32 + (lane & 3) * 8 + (4 * hi + ((lane & 15) >> 2)) * 64;
#pragma unroll
    for (int d0 = 0; d0 < 2; ++d0) {
        s16x4 lo[4], hh[4];
#pragma unroll
        for (int ks = 0; ks < 4; ++ks) {
            asm volatile("ds_read_b64_tr_b16 %0, %1 offset:%c2" : "=&v"(lo[ks]) : "v"(vb), "i"(d0 * 4096 + ks * 1024) : "memory");
            asm volatile("ds_read_b64_tr_b16 %0, %1 offset:%c2" : "=&v"(hh[ks]) : "v"(vb), "i"(d0 * 4096 + ks * 1024 + 512) : "memory");
        }
        asm volatile("s_waitcnt lgkmcnt(0)" ::: "memory"); __builtin_amdgcn_sched_barrier(0);
#pragma unroll
        for (int ks = 0; ks < 4; ++ks) {
            const bf16x8 vf = (bf16x8){lo[ks][0], lo[ks][1], lo[ks][2], lo[ks][3], hh[ks][0], hh[ks][1], hh[ks][2], hh[ks][3]};
            o[d0] = __builtin_amdgcn_mfma_f32_32x32x16_bf16(__builtin_bit_cast(bf16x8, pw[ks]), vf, o[d0], 0, 0, 0);
        }
    }
}
__device__ __forceinline__ void softmax_pv(f32x16& p0, f32x16& p1, float& m, float& l, f32x16 (&o)[2], const LAS unsigned char* vslot, LAS float* wsf, int lane) {
    const int r32 = lane & 31, hi = lane >> 5;
    const float rm = rowmax(p0, p1), mn = fmaxf(m, rm), ms = (mn == NEG_INF) ? 0.f : mn;
    const float alpha = __builtin_amdgcn_exp2f(m - ms);
    const bool need = __any(mn > m) != 0;
    m = mn;
    float sum = 0.f;
#pragma unroll
    for (int r = 0; r < 16; ++r) { p0[r] = __builtin_amdgcn_exp2f(p0[r] - ms); p1[r] = __builtin_amdgcn_exp2f(p1[r] - ms); sum += p0[r] + p1[r]; }
    l = l * alpha + sum;
    if (need) {
        if (hi == 0) wsf[r32] = alpha;
        __builtin_amdgcn_fence(__ATOMIC_RELEASE, "wavefront"); __builtin_amdgcn_wave_barrier();
#pragma unroll
        for (int r = 0; r < 16; ++r) { const float f = wsf[crow(r, hi)]; o[0][r] *= f; o[1][r] *= f; }
    }
    pv(o, p0, p1, vslot, lane);
}
struct SmState { float mref, l; f32x16 negm; bool started; };
__device__ __forceinline__ void sm_init(SmState& s, float c) { s.mref = 0.f; s.l = 0.f; s.started = false;
#pragma unroll
    for (int r = 0; r < 16; ++r) s.negm[r] = c;
    asm volatile("" : "+v"(s.negm)); }
__device__ __forceinline__ void sm_front(f32x16& p0, f32x16& p1, SmState& s, f32x16 (&o)[2], LAS float* wsf, int lane) {
    const int r32 = lane & 31, hi = lane >> 5;
    const float rm = rowmax(p0, p1);
    if (!s.started) {
        const float d = (rm == NEG_INF) ? 0.f : rm; s.mref = d; s.started = true;
#pragma unroll
        for (int r = 0; r < 16; ++r) { p0[r] -= d; p1[r] -= d; s.negm[r] -= d; }
    } else if (__any(rm > 8.0f)) {
        const float d = fmaxf(rm, 0.f), alpha = __builtin_amdgcn_exp2f(-d); s.mref += d; s.l *= alpha;
#pragma unroll
        for (int r = 0; r < 16; ++r) { p0[r] -= d; p1[r] -= d; s.negm[r] -= d; }
        if (hi == 0) wsf[r32] = alpha;
        __builtin_amdgcn_fence(__ATOMIC_RELEASE, "wavefront"); __builtin_amdgcn_wave_barrier();
#pragma unroll
        for (int r = 0; r < 16; ++r) { const float f = wsf[crow(r, hi)]; o[0][r] *= f; o[1][r] *= f; }
    }
}
__device__ __forceinline__ void sm_exp(f32x16& p0, f32x16& p1, SmState& s) {
    float sum = 0.f;
#pragma unroll
    for (int r = 0; r < 16; ++r) { p0[r] = __builtin_amdgcn_exp2f(p0[r]); p1[r] = __builtin_amdgcn_exp2f(p1[r]); sum += p0[r] + p1[r]; }
    s.l += sum;
}
__device__ __forceinline__ void softmax_pv2(f32x16& p0, f32x16& p1, SmState& s, f32x16 (&o)[2], const LAS unsigned char* vslot, LAS float* wsf, int lane) {
    sm_front(p0, p1, s, o, wsf, lane); sm_exp(p0, p1, s); pv(o, p0, p1, vslot, lane);
}
template <int DQK, class Live, class Mask>
__device__ __forceinline__ void pipe_loop(const TileSrc& T, int NT, int kv_first, const bf16x8* qf, SmState& sm, f32x16 (&o)[2], Live live, Mask mask, LAS unsigned char* ring, LAS float* wsf, int wid, int lane) {
    const bool three = (DQK == 96) && (wid < 4); const int r32 = lane & 31, hi = lane >> 5;
    DmaPtr dp = dma_init<DQK>(T, kv_first, wid, lane);
    for (int i = 0; i < 3; ++i) if (i < NT) dma_tile<DQK>(dp, T, ring + i * SLOTB, wid, 0);
    wait_tiles((NT - 1) < 2 ? (NT - 1) : 2, three);
    __builtin_amdgcn_s_barrier();
    f32x16 a0, a1, b0, b1;
    if (live(0)) { qk_c<DQK>(a0, a1, ring, qf, sm.negm, r32, hi); mask(0, a0, a1); }
#define ATT_STEP(i, C0, C1, N0, N1) do { \
        const bool has_n = (i) + 1 < NT; \
        if (has_n) wait_tiles((NT - 2 - (i)) < 1 ? (NT - 2 - (i)) : 1, three); \
        __builtin_amdgcn_s_barrier(); \
        if ((i) + 3 < NT) dma_tile<DQK>(dp, T, ring + (((i) + 3) & 3) * SLOTB, wid, 0); \
        const bool lc = live(i), ln = has_n && live((i) + 1); \
        const LAS unsigned char* sc_ = ring + ((i) & 3) * SLOTB; const LAS unsigned char* sn_ = ring + (((i) + 1) & 3) * SLOTB; \
        if (lc) sm_front(C0, C1, sm, o, wsf, lane); \
        if (lc && ln) { qk_c<DQK>(N0, N1, sn_, qf, sm.negm, r32, hi); sm_exp(C0, C1, sm); mask((i) + 1, N0, N1); pv(o, C0, C1, sc_ + VOFF, lane); } \
        else { if (ln) { qk_c<DQK>(N0, N1, sn_, qf, sm.negm, r32, hi); mask((i) + 1, N0, N1); } \
               if (lc) { sm_exp(C0, C1, sm); pv(o, C0, C1, sc_ + VOFF, lane); } } \
    } while (0)
    for (int i = 0; i < NT; i += 2) {
        ATT_STEP(i, a0, a1, b0, b1);
        if (i + 1 < NT) ATT_STEP(i + 1, b0, b1, a0, a1);
    }
#undef ATT_STEP
    asm volatile("s_waitcnt lgkmcnt(0)" ::: "memory");
    __builtin_amdgcn_s_barrier();
}
__device__ __forceinline__ void scaled_add(LAS float* oacc, const f32x16 (&o)[2], float f, LAS float* wsf, int lane, bool assign) {
    const int r32 = lane & 31, hi = lane >> 5;
    if (hi == 0) wsf[32 + r32] = f;
    __builtin_amdgcn_fence(__ATOMIC_RELEASE, "wavefront"); __builtin_amdgcn_wave_barrier();
#pragma unroll
    for (int r = 0; r < 16; ++r) { const float g = wsf[32 + crow(r, hi)];
        if (assign) { oacc[r * 64 + lane] = o[0][r] * g; oacc[(16 + r) * 64 + lane] = o[1][r] * g; } else { oacc[r * 64 + lane] += o[0][r] * g; oacc[(16 + r) * 64 + lane] += o[1][r] * g; } }
}
__device__ __forceinline__ void store_oacc(const LAS float* oacc, bf16_t* dst, int pitch, int lane) {
    const int r32 = lane & 31, hi = lane >> 5;
#pragma unroll
    for (int r = 0; r < 16; ++r) { bf16_t* rp = dst + (size_t)crow(r, hi) * pitch; rp[r32] = f2bf(oacc[r * 64 + lane]); rp[32 + r32] = f2bf(oacc[(16 + r) * 64 + lane]); }
}

__device__ __forceinline__ void mla_unit(Frame F, int b, int h, int qb, Chain& ch, int qb_next  ) {
    LAUNDER(F);
    TICK(F, 15);
    LAS unsigned char* lds = F.lds; LAS float* wsf = (LAS float*)(lds + L_WS) + F.wave * 64;
    const int wid = F.wave, lane = F.lane, r32 = lane & 31, hi = lane >> 5;
    const bf16_t* QO = (const bf16_t*)(F.ws + WS_QKVO) + (size_t)b * SEQ * 1024;
    TileSrc T; T.K = QO + 384 + h * 128; T.kpitch = 1024; T.V = QO + 384 + h * 128 + 64; T.vpitch = 1024; T.K2 = (const bf16_t*)(F.ws + WS_KR) + (size_t)b * SEQ * 32; T.k2pitch = 32;
    const int q0 = qb * 256, qw0 = q0 + 32 * wid, qrow = qw0 + r32;
    bf16x8 qf[6];
#pragma unroll
    for (int d0 = 0; d0 < 6; ++d0) qf[d0] = *(const bf16x8*)(QO + (size_t)qrow * 1024 + h * 96 + d0 * 16 + hi * 8);
    {
        const float* rp = (const float*)(F.ws + WS_ROPE) + (size_t)qrow * 32 + 8 * hi;
        const f32x4 c0 = *(const f32x4*)rp, c1 = *(const f32x4*)(rp + 4), s0 = *(const f32x4*)(rp + 16), s1 = *(const f32x4*)(rp + 20);
#pragma unroll
        for (int j = 0; j < 8; ++j) { const float cs = j < 4 ? c0[j & 3] : c1[j & 3], sn = j < 4 ? s0[j & 3] : s1[j & 3];
            const float x1 = bf2f((unsigned short)qf[4][j]), x2 = bf2f((unsigned short)qf[5][j]);
            qf[4][j] = (short)f2bf(x1 * cs - x2 * sn); qf[5][j] = (short)f2bf(x1 * sn + x2 * cs); }
    }
    SmState sm; sm_init(sm, 0.f); f32x16 o[2]; o[0] = f32x16{}; o[1] = f32x16{};
    const int NT = (q0 + 256) / 64;
    TICK(F, 8);
#ifdef USE_STAG
    f32x16 p0, p1;
    stag_loop<96>(T, NT, 0,
        [&](int t, const LAS unsigned char* slot) { const int kv0 = 64 * t;
            if (kv0 <= qw0 + 31) {
                qk_c<96>(p0, p1, slot, qf, sm.negm, r32, hi);
                if (kv0 + 63 > qw0) {
#pragma unroll
                    for (int r = 0; r < 16; ++r) { const int kv = kv0 + crow(r, hi); if (kv > qrow) p0[r] = NEG_INF; if (kv + 32 > qrow) p1[r] = NEG_INF; }
                } } },
        [&](int t, const LAS unsigned char* slot) { if (64 * t <= qw0 + 31) softmax_pv2(p0, p1, sm, o, slot + VOFF, wsf, lane); },
        lds + L_RING, wid, lane);
#else
    tile_loop_c<96, 96>(T, NT, 0, [&](int t, const LAS unsigned char* slot) {
        const int kv0 = 64 * t;
        if (kv0 <= qw0 + 31) {
            f32x16 p0, p1; qk_c<96>(p0, p1, slot, qf, sm.negm, r32, hi);
            if (kv0 + 63 > qw0) {
#pragma unroll
                for (int r = 0; r < 16; ++r) { const int kv = kv0 + crow(r, hi); if (kv > qrow) p0[r] = NEG_INF; if (kv + 32 > qrow) p1[r] = NEG_INF; }
            }
            softmax_pv2(p0, p1, sm, o, slot + VOFF, wsf, lane);
        }
    }, lds + L_RING, wid, lane, ch, qb_next >= 0 ? &T : nullptr, qb_next >= 0 ? 4 * (qb_next + 1) : 0, 0);
#endif
    TICK(F, 9);
    const float lt = half_swap_sum(sm.l); const float inv = lt > 0.f ? __builtin_amdgcn_rcpf(lt) : 0.f;
    LAS float* oacc = (LAS float*)(lds + L_OACC) + F.wave * 2048;
    scaled_add(oacc, o, inv, wsf, lane, true);
    store_oacc(oacc, (bf16_t*)(F.ws + WS_CAT) + (size_t)(b * SEQ + qw0) * DMODEL + CC_MLA + h * 64, DMODEL, lane);
    TICK(F, 10);
}

__device__ __forceinline__ void nsa_unit(Frame F, int b, int qt, Chain& ch, int qt_next  , unsigned* claim_ctr = nullptr  , volatile LAS unsigned* claim_out = nullptr) {
    LAUNDER(F);
    LAS unsigned char* lds = F.lds; LAS float* wsf = (LAS float*)(lds + L_WS) + F.wave * 64;
    LAS float* bt = (LAS float*)(lds + L_BT); LAS float* imp = (LAS float*)(lds + L_IMP); LAS unsigned* sel = (LAS unsigned*)(lds + L_SEL); LAS float* gate = (LAS float*)(lds + L_GATE);
    LAS float* outacc = (LAS float*)(lds + L_OACC) + F.wave * 2048;
    const int wid = F.wave, lane = F.lane, tid = F.tid, r32 = lane & 31, hi = lane >> 5, h = wid & 3, qh = wid >> 2;
    const int t0 = 64 * qt, qi = 32 * qh + r32, t = t0 + qi;
    const bf16_t* U = (const bf16_t*)(F.ws + WS_U) + (size_t)b * SEQ * NU;
    bf16x8 qf[4];
#pragma unroll
    for (int d0 = 0; d0 < 4; ++d0) qf[d0] = *(const bf16x8*)(U + (size_t)t * NU + UC_Q + h * 64 + d0 * 16 + hi * 8);
    TICK(F, 15);
    __syncthreads();
    for (int idx = tid; idx < 64 * 12; idx += 512) { const int q = idx / 12, k = idx - q * 12; gate[idx] = sigmoidf_(bf2f(U[(size_t)(t0 + q) * NU + UC_GATE + k])); }
    __syncthreads();
    const LAS float* bth = bt + h * 132;
    TileSrc Tc, Ts, Tw;
    { const bf16_t* KC = (const bf16_t*)(F.ws + WS_KC);
      Tc.K = KC + (size_t)(0 * 4 + b) * 512 * 64; Tc.kpitch = 64; Tc.V = KC + (size_t)(1 * 4 + b) * 512 * 64; Tc.vpitch = 64; Tc.K2 = nullptr; Tc.k2pitch = 0;
      Ts.K = U + UC_KV + 128; Ts.kpitch = NU; Ts.V = U + UC_KV + 192; Ts.vpitch = NU; Ts.K2 = nullptr; Ts.k2pitch = 0;
      Tw.K = U + UC_KV + 256; Tw.kpitch = NU; Tw.V = U + UC_KV + 320; Tw.vpitch = NU; Tw.K2 = nullptr; Tw.k2pitch = 0; }
    const int j_lo = qt >= 8 ? qt - 8 : 0;
    TICK(F, 1);
    {
        const int hc = r32 >> 3, q8 = r32 & 7, qc = 8 * wid + q8, tc = t0 + qc;
        const LAS float* bthc = bt + hc * 132;
        bf16x8 qfc[4];
#pragma unroll
        for (int d0 = 0; d0 < 4; ++d0) qfc[d0] = *(const bf16x8*)(U + (size_t)tc * NU + UC_Q + hc * 64 + d0 * 16 + hi * 8);
        LAS float* impw = imp + wid * 1024;
        const TileSrc& T = Tc;
        const int NTc = (((t0 + 32) >> 4) >> 6) + 1;
        float m = NEG_INF, l = 0.f;
        tile_loop_c<64, 64>(T, NTc, 0, [&](int ct, const LAS unsigned char* slot) {
            f32x16 p0, p1; qk<64>(p0, p1, slot, qfc, 0.f, r32, hi);
#pragma unroll
            for (int r = 0; r < 16; ++r) { const int c = 64 * ct + crow(r, hi); const int d0 = tc - (16 * c + 31), d1 = d0 - 512;
                const float b0 = btab(bthc, d0), b1 = btab(bthc, d1); p0[r] = (d0 >= 0) ? p0[r] + b0 : NEG_INF; p1[r] = (d1 >= 0) ? p1[r] + b1 : NEG_INF; }
            const float rm = rowmax(p0, p1), mn = fmaxf(m, rm), ms = (mn == NEG_INF) ? 0.f : mn; const float alpha = __builtin_amdgcn_exp2f(m - ms); m = mn; float sum = 0.f;
#pragma unroll
            for (int r = 0; r < 16; ++r) sum += __builtin_amdgcn_exp2f(p0[r] - ms) + __builtin_amdgcn_exp2f(p1[r] - ms);
            l = l * alpha + sum;
        }, lds + L_RING, wid, lane, ch, &T, NTc, 0);
        TICK(F, 2);
        const float lt = half_swap_sum(l), inv = lt > 0.f ? __builtin_amdgcn_rcpf(lt) : 0.f, ms = (m == NEG_INF) ? 0.f : m;
        const bool need_imp = qt >= 16;
        f32x16 o[2]; o[0] = f32x16{}; o[1] = f32x16{};
        float carry = 0.f;
        tile_loop_c<64, 64>(T, NTc, 0, [&](int ct, const LAS unsigned char* slot) {
            f32x16 p0, p1; qk<64>(p0, p1, slot, qfc, 0.f, r32, hi);
#pragma unroll
            for (int r = 0; r < 16; ++r) { const int c = 64 * ct + crow(r, hi); const int d0 = tc - (16 * c + 31), d1 = d0 - 512;
                const float b0 = btab(bthc, d0), b1 = btab(bthc, d1);
                p0[r] = (d0 >= 0) ? __builtin_amdgcn_exp2f(p0[r] + b0 - ms) * inv : 0.f;
                p1[r] = (d1 >= 0) ? __builtin_amdgcn_exp2f(p1[r] + b1 - ms) * inv : 0.f; }
            if (need_imp) {
                float e[8], bq[8];
#pragma unroll
                for (int g = 0; g < 4; ++g) { bq[g] = 0.5f * p0[4 * g + 3]; e[g] = (p0[4 * g] + p0[4 * g + 1]) + (p0[4 * g + 2] + bq[g]);
                                              bq[4 + g] = 0.5f * p1[4 * g + 3]; e[4 + g] = (p1[4 * g] + p1[4 * g + 1]) + (p1[4 * g + 2] + bq[4 + g]); }
                float pb[8];
#pragma unroll
                for (int k = 0; k < 8; ++k) { auto rr = __builtin_amdgcn_permlane32_swap(__float_as_uint(bq[k]), __float_as_uint(bq[k]), false, false); pb[k] = __uint_as_float(hi ? rr[0] : rr[1]); }
#pragma unroll
                for (int k = 0; k < 8; ++k) { const float inc = hi ? pb[k] : (k > 0 ? pb[k > 0 ? k - 1 : 0] : carry); float v = e[k] + inc;
                    v += dpp_f<0x128>(v);
                    { auto rr = __builtin_amdgcn_permlane16_swap(__float_as_uint(v), __float_as_uint(v), false, false); v = __uint_as_float(rr[0]) + __uint_as_float(rr[1]); }
                    if (hc == 0) impw[(16 * ct + 8 * (k >> 2) + 2 * (k & 3) + hi) * 8 + q8] = v; }
                carry = pb[7];
            }
            pv(o, p0, p1, slot + VOFF, lane);
        }, lds + L_RING, wid, lane, ch, &Ts, qt + 1, 0);
        TICK(F, 3);
        {
            const int jc = qt;
#ifdef PROBE_TOPK
            for (int rp_ = 0; rp_ < 2; ++rp_)
#endif
            for (int qq = 0; qq < 8; ++qq) {
                const int q = 8 * wid + qq; unsigned long long m0, m1;
                if (!need_imp) { m0 = (1ull << (jc + 1)) - 1ull; m1 = 0ull; }
                else {
                    const int ja = lane, jb2 = lane + 64;
                    const bool c0 = (ja >= 1 && ja <= jc - 2), c1 = (jb2 <= jc - 2);
                    const float v0 = c0 ? impw[ja * 8 + qq] : 0.f, v1 = c1 ? impw[jb2 * 8 + qq] : 0.f;
                    const unsigned u0 = c0 ? (__float_as_uint(v0) + 1u) : 0u, u1 = c1 ? (__float_as_uint(v1) + 1u) : 0u;
                    unsigned thr = 0u;
                    for (int bit = 31; bit >= 0; --bit) { const unsigned tr = thr | (1u << bit);
                        const int cnt = __popcll(__ballot(u0 >= tr)) + __popcll(__ballot(u1 >= tr)); if (cnt >= 13) thr = tr; }
                    const unsigned long long g0 = __ballot(u0 > thr), g1 = __ballot(u1 > thr), e0 = __ballot(u0 == thr), e1 = __ballot(u1 == thr);
                    const int need = 13 - (__popcll(g0) + __popcll(g1));
                    const unsigned long long lt_mask = (1ull << lane) - 1ull;
                    const int rk0 = __popcll(e0 & lt_mask), rk1 = __popcll(e0) + __popcll(e1 & lt_mask);
                    const bool s0 = (u0 > thr) || (u0 == thr && rk0 < need) || ja == 0 || ja == jc || ja == jc - 1;
                    const bool s1 = (u1 > thr) || (u1 == thr && rk1 < need) || jb2 == jc || jb2 == jc - 1;
                    m0 = __ballot(s0); m1 = __ballot(s1);
                }
                if (lane == 0) { sel[q * 4 + 0] = (unsigned)m0; sel[q * 4 + 1] = (unsigned)(m0 >> 32); sel[q * 4 + 2] = (unsigned)m1; sel[q * 4 + 3] = (unsigned)(m1 >> 32); }
            }
        }
        __syncthreads();
        {
            if (hi == 0) wsf[32 + r32] = gate[qc * 12 + hc * 3 + 0];
            __builtin_amdgcn_fence(__ATOMIC_RELEASE, "wavefront"); __builtin_amdgcn_wave_barrier();
            LAS float* ob = (LAS float*)(lds + L_OACC);
#pragma unroll
            for (int r = 0; r < 16; ++r) { const int row = crow(r, hi), hh = row >> 3, q5 = 8 * (wid & 3) + (row & 7); const float g = wsf[32 + row];
                LAS float* dst = ob + (hh + 4 * (wid >> 2)) * 2048 + ((q5 & 3) + 4 * (q5 >> 3)) * 64 + ((q5 >> 2) & 1) * 32 + r32;
                dst[0] = o[0][r] * g; dst[16 * 64] = o[1][r] * g; }
        }
        __syncthreads();
        TICK(F, 4);
    }
    const int rep = 0;
    {
        const TileSrc& T = Ts;
        const int NT = qt + 1; const float cfar = bth[128];
        SmState sm; sm_init(sm, cfar); f32x16 o[2]; o[0] = f32x16{}; o[1] = f32x16{};
#ifdef USE_PIPE_SEL
        pipe_loop<64>(T, NT, 0, qf, sm, o,
            [&](int jt) { const bool selb = ((sel[qi * 4 + (jt >> 5)] >> (jt & 31)) & 1u) != 0u; return __any(selb) != 0; },
            [&](int jt, f32x16& p0, f32x16& p1) {
                const bool selb = ((sel[qi * 4 + (jt >> 5)] >> (jt & 31)) & 1u) != 0u;
                if (jt >= qt - 2) {
#pragma unroll
                    for (int r = 0; r < 16; ++r) { const int d0 = t - (64 * jt + crow(r, hi)), d1 = d0 - 32;
                        const float b0 = btab(bth, d0) - cfar, b1 = btab(bth, d1) - cfar; p0[r] = (selb && d0 >= 0) ? p0[r] + b0 : NEG_INF; p1[r] = (selb && d1 >= 0) ? p1[r] + b1 : NEG_INF; }
                } else if (!selb) {
#pragma unroll
                    for (int r = 0; r < 16; ++r) { p0[r] = NEG_INF; p1[r] = NEG_INF; }
                } },
            lds + L_RING, wsf, wid, lane);
#else
        tile_loop_c<64, 64>(T, NT, 0, [&](int jt, const LAS unsigned char* slot) {
            const bool selb = ((sel[qi * 4 + (jt >> 5)] >> (jt & 31)) & 1u) != 0u;
            if (__any(selb)) {
                f32x16 p0, p1;
                if (jt >= qt - 2 || __all(selb)) qk_c<64>(p0, p1, slot, qf, sm.negm, r32, hi);
                else { f32x16 cm;
#pragma unroll
                    for (int r = 0; r < 16; ++r) cm[r] = selb ? sm.negm[r] : NEG_INF;
                    qk_c<64>(p0, p1, slot, qf, cm, r32, hi); }
                if (jt >= qt - 2) {
#pragma unroll
                    for (int r = 0; r < 16; ++r) { const int d0 = t - (64 * jt + crow(r, hi)), d1 = d0 - 32;
                        const float b0 = btab(bth, d0) - cfar, b1 = btab(bth, d1) - cfar; p0[r] = (selb && d0 >= 0) ? p0[r] + b0 : NEG_INF; p1[r] = (selb && d1 >= 0) ? p1[r] + b1 : NEG_INF; }
                }
                softmax_pv2(p0, p1, sm, o, slot + VOFF, wsf, lane);
            }
        }, lds + L_RING, wid, lane, ch, &Tw, qt - j_lo + 1, 64 * j_lo);
#endif
        const float lt = half_swap_sum(sm.l);
        scaled_add(outacc, o, (lt > 0.f && rep == 0) ? gate[qi * 12 + h * 3 + 1] * __builtin_amdgcn_rcpf(lt) : 0.f, wsf, lane, false);
        TICK(F, 5);
    }
    unsigned pend = 0u; if (claim_ctr != nullptr && tid == 0) pend = __hip_atomic_fetch_add(claim_ctr, 1u, __ATOMIC_RELAXED, __HIP_MEMORY_SCOPE_AGENT);
    const int rep2 = 0;
    {
        const TileSrc& T = Tw;
        const float cfar = bth[128];
        SmState sm; sm_init(sm, cfar); f32x16 o[2]; o[0] = f32x16{}; o[1] = f32x16{};
        tile_loop_c<64, 64>(T, qt - j_lo + 1, 64 * j_lo, [&](int it, const LAS unsigned char* slot) {
            const int jt = j_lo + it;
            f32x16 p0, p1; qk_c<64>(p0, p1, slot, qf, sm.negm, r32, hi);
            if ((jt >= qt - 2) || (jt == qt - 8)) {
#pragma unroll
                for (int r = 0; r < 16; ++r) { const int d0 = t - (64 * jt + crow(r, hi)), d1 = d0 - 32;
                    const float b0 = btab(bth, d0) - cfar, b1 = btab(bth, d1) - cfar; p0[r] = (d0 >= 0 && d0 < 512) ? p0[r] + b0 : NEG_INF; p1[r] = (d1 >= 0 && d1 < 512) ? p1[r] + b1 : NEG_INF; }
            }
            softmax_pv2(p0, p1, sm, o, slot + VOFF, wsf, lane);
        }, lds + L_RING, wid, lane, ch, qt_next >= 0 ? &Tc : nullptr, qt_next >= 0 ? ((((64 * qt_next + 32) >> 4) >> 6) + 1) : 0, 0);
        const float lt = half_swap_sum(sm.l);
        scaled_add(outacc, o, (lt > 0.f && rep2 == 0) ? gate[qi * 12 + h * 3 + 2] * __builtin_amdgcn_rcpf(lt) : 0.f, wsf, lane, false);
        TICK(F, 6);
    }
    store_oacc(outacc, (bf16_t*)(F.ws + WS_CAT) + (size_t)(b * SEQ + t0 + 32 * qh) * DMODEL + CC_NSA + h * 64, DMODEL, lane);
    if (claim_ctr != nullptr && tid == 0) claim_out[0] = pend;
    __syncthreads();
    TICK(F, 7);
}

__device__ __forceinline__ void phaseC(Frame F, int l) {
    LAUNDER(F);
    { LAS float* bt = (LAS float*)(F.lds + L_BT); const float* tab = IN(F, 21);
      for (int idx = F.tid; idx < 4 * 132; idx += 512) { const int h = idx / 132, d = idx - h * 132; bt[idx] = (d <= 128) ? tab[BUCKET[d] * 4 + h] * LOG2E : 0.f; }
      __syncthreads(); }
    if (F.G != 256) {
        for (int p = F.vcu; p < 256; p += F.G) {
            { const int bh = p >> 4, s = p & 15; Chain ch{0, false}; mla_unit(F, bh >> 2, bh & 3, 31 - s, ch, s); mla_unit(F, bh >> 2, bh & 3, s, ch, -1); }
            { const int b = p >> 6, s = p & 63; Chain ch{0, false}; nsa_unit(F, b, 127 - s, ch, s); nsa_unit(F, b, s, ch, -1); }
        }
        return;
    }
    const int p = F.vcu;
    unsigned* ctr = (unsigned*)(F.ws + WS_BAR + 15360 + 512 * l);
    volatile LAS unsigned* nb = (volatile LAS unsigned*)(F.lds + LDS_CTL + 72);
    { const int bh = p >> 4, s = p & 15; Chain ch{0, false}; mla_unit(F, bh >> 2, bh & 3, 31 - s, ch, s); mla_unit(F, bh >> 2, bh & 3, s, ch, -1); }
    { const int b = p >> 6, s = p & 63; Chain ch{0, false}; nsa_unit(F, b, 127 - s, ch, -1, ctr, nb); }
    const unsigned i = nb[0];
    if (i < 256u) { Chain ch{0, false}; nsa_unit(F, (int)(i & 3u), 63 - (int)(i >> 2), ch, -1); }
}
}
constexpr int NTHREADS = 512;

template <class Sched> __device__ __forceinline__ void build_rs(Frame& F, const Sched& S) {
    LAS float* rs = (LAS float*)(F.lds + LDS_RS); const float* ss = (const float*)(F.ws + WS_SS);
    const int r = F.tid & 255, hs = F.tid >> 8;
    f32x4 v[4][4]; bool ok[4];
#pragma unroll
    for (int k = 0; k < 4; ++k) { pg8::Unit u; ok[k] = S.next(2 * k + hs, u); const f32x4* p = (const f32x4*)(ss + (size_t)((ok[k] ? u.pm : 0) * 256 + r) * 16);
#pragma unroll
        for (int j = 0; j < 4; ++j) v[k][j] = p[j]; }
#pragma unroll
    for (int k = 0; k < 4; ++k) if (ok[k]) {
        const float s = (((v[k][0][0] + v[k][0][1]) + (v[k][0][2] + v[k][0][3])) + ((v[k][1][0] + v[k][1][1]) + (v[k][1][2] + v[k][1][3]))) + (((v[k][2][0] + v[k][2][1]) + (v[k][2][2] + v[k][2][3])) + ((v[k][3][0] + v[k][3][1]) + (v[k][3][2] + v[k][3][3])));
        rs[(2 * k + hs) * 256 + r] = __builtin_amdgcn_rsqf(s * (1.f / DMODEL) + EPS); }
    __syncthreads();
}
__device__ __forceinline__ void phaseA(Frame F, int l) {
    LAUNDER(F);
    pg8::Gemm g{(const bf16_t*)(F.ws + WS_HB), (const bf16_t*)(F.ws + WS_W + (size_t)l * W_LAYER + WO_WIN), MTOK, NU, DMODEL};
    pg8::StaticOrder S; S.init(MTOK, NU, F.G, F.bid);
    build_rs(F, S);
    pg8::EpiRowScale<0> E{(bf16_t*)(F.ws + WS_U), NU, (const LAS float*)(F.lds + LDS_RS)};
    pg8::gemm_phase<pg8::EpiRowScale<0>, pg8::StaticOrder, true, true>(F.lds, g, S, E, F.wave);
}
__device__ __forceinline__ void phaseRes(Frame F, size_t a_off, size_t b_off, int K, size_t hb_off = WS_HB, size_t ss_off = WS_SS) {
    LAUNDER(F);
    const bf16_t* A = (const bf16_t*)(F.ws + a_off); const bf16_t* Bt = (const bf16_t*)(F.ws + b_off);
    pg8::Gemm g{A, Bt, MTOK, DMODEL, K};
    pg8::StaticOrder S; S.init(MTOK, DMODEL, F.G, F.bid); S.rev = (K == DFF);
    pg8::EpiResidual E{(bf16_t*)(F.ws + hb_off), (float*)(F.ws + ss_off)};
    pg8::gemm_phase<pg8::EpiResidual, pg8::StaticOrder, true, true>(F.lds, g, S, E, F.wave);
}
__device__ __forceinline__ void phaseE(Frame F, int l) {
    LAUNDER(F);
    pg8::Gemm g{(const bf16_t*)(F.ws + WS_HB), (const bf16_t*)(F.ws + WS_W + (size_t)l * W_LAYER + WO_W1), MTOK, DFF, DMODEL};
    pg8::StaticOrder S; S.init(MTOK, DFF, F.G, F.bid);
    build_rs(F, S);
    pg8::EpiRowScale<1> E{(bf16_t*)(F.ws + WS_Z), DFF, (const LAS float*)(F.lds + LDS_RS)};
    pg8::gemm_phase<pg8::EpiRowScale<1>, pg8::StaticOrder, true, true>(F.lds, g, S, E, F.wave);
}
__device__ __forceinline__ void phaseG(Frame F) {
    LAUNDER(F);
    const float* ss = (const float*)(F.ws + WS_SS); const int gw = F.bid * 8 + F.wave, NGW = F.G * 8;
    const f32x4* gp = (const f32x4*)IN(F, 22) + F.lane; float* outp = (float*)IN(F, 23); const bf16_t* hb = (const bf16_t*)(F.ws + WS_HB);
    f32x4 g4[4];
#pragma unroll
    for (int j = 0; j < 4; ++j) g4[j] = gp[64 * j];
    for (int m0 = gw * 4; m0 < MTOK; m0 += NGW * 4) {
        float sv[4]; u32x2 hv[4][4];
#pragma unroll
        for (int q = 0; q < 4; ++q) { sv[q] = (F.lane < 16) ? ss[(size_t)(m0 + q) * 16 + F.lane] : 0.f; const u32x2* hr = (const u32x2*)(hb + (size_t)(m0 + q) * DMODEL) + F.lane;
#pragma unroll
            for (int j = 0; j < 4; ++j) hv[q][j] = hr[64 * j]; }
#pragma unroll
        for (int q = 0; q < 4; ++q) { const float r = __builtin_amdgcn_rsqf(wave_sum(sv[q]) * (1.f / DMODEL) + EPS); f32x4* orow = (f32x4*)(outp + (size_t)(m0 + q) * DMODEL) + F.lane;
#pragma unroll
            for (int j = 0; j < 4; ++j) { const u32x2 v = hv[q][j];
                const f32x4 x = (f32x4){__uint_as_float(v.x << 16), __uint_as_float(v.x & 0xffff0000u), __uint_as_float(v.y << 16), __uint_as_float(v.y & 0xffff0000u)};
                __builtin_nontemporal_store(x * r * g4[j], orow + 64 * j); } }
    }
}

__global__ void __launch_bounds__(NTHREADS, 2) mega_fwd(Args a) {
    extern __shared__ __attribute__((aligned(16))) unsigned char lds_raw[];
    if (a.pad1 != 0) cg::this_grid().sync();
    Frame F;
    F.lds = (LAS unsigned char*)lds_raw; F.tid = threadIdx.x; F.lane = F.tid & 63; F.wave = __builtin_amdgcn_readfirstlane(F.tid >> 6);
    F.G = gridDim.x; F.bid = blockIdx.x; F.vcu = (F.G % 8 == 0) ? (F.bid % 8) * (F.G / 8) + F.bid / 8 : F.bid; F.ws = (GAS unsigned char*)a.ws;
    if (F.tid < 128) ((LAS unsigned*)(F.lds + LDS_CTL))[F.tid] = 0u;
    __syncthreads();
#ifdef PROBE_CLK
    if (F.tid == 0) ((volatile unsigned long long*)(a.ws + WS_TAB + 1024))[F.bid] = __builtin_amdgcn_s_memrealtime();
#endif
    const XcdBarrier bar = xcd_barrier_post((unsigned*)(a.ws + WS_BAR), (volatile LAS unsigned*)(F.lds + LDS_CTL), F.tid == 0);
#define SEAM() xcd_barrier(bar, F.wave)
    CLK_S(0); prologue(a, F); CLK_S(1);
    SEAM();
    static_assert(NLAYER == 2, "layer bodies are written out twice");
    { constexpr int l = 0;
        CLK_S(2); phaseA(F, l); CLK_S(3);
        SEAM();
        CLK_S(4); phaseB(F, l); CLK_S(5);
        SEAM();
        CLK_S(8); att::phaseC(F, l); CLK_S(9);
        SEAM();
        CLK_S(10); phaseRes(F, WS_CAT, WS_W + (size_t)l * W_LAYER + WO_WOUT, DMODEL); CLK_S(11);
        SEAM();
        CLK_S(12); phaseE(F, l); CLK_S(13);
        SEAM();
        CLK_S(14); phaseRes(F, WS_Z, WS_W + (size_t)l * W_LAYER + WO_W2, DFF); CLK_S(15);
        SEAM();
    }
#ifdef PROBE_IDLE
    { const unsigned long long r0_ = __builtin_amdgcn_s_memrealtime(); while (__builtin_amdgcn_s_memrealtime() - r0_ < PROBE_IDLE * 100ull) __builtin_amdgcn_s_sleep(32); }
#endif
    { constexpr int l = 1;
        CLK_S(16); phaseA(F, l); CLK_S(17);
        SEAM();
        CLK_S(18); phaseB(F, l); CLK_S(19);
        SEAM();
        CLK_S(22); att::phaseC(F, l); CLK_S(23);
        SEAM();
        CLK_S(24); phaseRes(F, WS_CAT, WS_W + (size_t)l * W_LAYER + WO_WOUT, DMODEL); CLK_S(25);
        SEAM();
        CLK_S(26); phaseE(F, l); CLK_S(27);
        SEAM();
        CLK_S(28); phaseRes(F, WS_Z, WS_W + (size_t)l * W_LAYER + WO_W2, DFF); CLK_S(29);
        SEAM();
    }
    CLK_S(30); phaseG(F); CLK_S(31);
#ifdef PROBE_CLK
    __syncthreads();
    if (F.bid == PROBE_CLK && F.wave == 0) {
        volatile unsigned long long* _c = (volatile unsigned long long*)((unsigned char*)F.ws + 131072 + F.bid * 1024);
#define W_C(w) ((volatile unsigned long long*)((unsigned char*)F.ws + 131072 + (w) * 1024))
        unsigned long long bmax_ = 0ull, bmin_ = ~0ull, bsum_ = 0ull, xmax_ = 0ull, emax_ = 0ull, emin_ = ~0ull;
#ifdef PROBE_PH
#ifndef PROBE_IA
#define PROBE_IA (2 * PROBE_PH)
#define PROBE_IB (2 * PROBE_PH + 1)
#endif
        for (int w_ = 0; w_ < (int)gridDim.x; ++w_) { const unsigned long long b_ = W_C(w_)[PROBE_IB] - W_C(w_)[PROBE_IA], e_ = W_C(w_)[PROBE_IB]; bsum_ += b_; if (b_ > bmax_) { bmax_ = b_; xmax_ = (unsigned long long)w_; } bmin_ = b_ < bmin_ ? b_ : bmin_; emax_ = e_ > emax_ ? e_ : emax_; emin_ = e_ < emin_ ? e_ : emin_; }
#endif
        unsigned long long xavg_max_ = 0ull, xavg_min_ = ~0ull;
#ifdef PROBE_PH
        for (int x_ = 0; x_ < 8; ++x_) { unsigned long long a_ = 0ull; for (int w_ = x_; w_ < (int)gridDim.x; w_ += 8) a_ += W_C(w_)[PROBE_IB] - W_C(w_)[PROBE_IA]; a_ /= (gridDim.x / 8); xavg_max_ = a_ > xavg_max_ ? a_ : xavg_max_; xavg_min_ = a_ < xavg_min_ ? a_ : xavg_min_; }
#endif
#define XAVG_MAX() (xavg_max_ / 100ull)
#define XAVG_MIN() (xavg_min_ / 100ull)
#define B_MAX() (bmax_ / 100ull)
#define B_MIN() (bmin_ / 100ull)
#define B_AVG() (bsum_ / (100ull * gridDim.x))
#define B_XMAX() (xmax_)
#define E_SPREAD() ((emax_ - emin_) / 100ull)
        unsigned long long n80_ = 0ull, n100_ = 0ull, n120_ = 0ull;
#ifdef PROBE_PH
        for (int w_ = 0; w_ < (int)gridDim.x; ++w_) { const unsigned long long b_ = (W_C(w_)[2 * PROBE_PH + 1] - W_C(w_)[2 * PROBE_PH]) / 100ull; n80_ += b_ > 80ull; n100_ += b_ > 100ull; n120_ += b_ > 120ull; }
#endif
        unsigned long long org_ = ~0ull, last_ = 0ull; for (int w_ = 0; w_ < (int)gridDim.x; ++w_) { const unsigned long long t_ = ((volatile unsigned long long*)(a.ws + WS_TAB + 1024))[w_]; org_ = t_ < org_ ? t_ : org_; last_ = t_ > last_ ? t_ : last_; }
#define T_SKEW() ((last_ - org_) / 100ull)
#define T_START(i) ((_c[2 * (i)] - org_) / 100ull)
#define T_BUSY(i) ((_c[2 * (i) + 1] - _c[2 * (i)]) / 100ull)
#define T_MHZ10(i) (((_c[32 + 2 * (i) + 1] - _c[32 + 2 * (i)]) * 10ull) / (_c[2 * (i) + 1] - _c[2 * (i)]))
#define T_WALL(i) ((_c[2 * (i) + 2] - _c[2 * (i)]) / 100ull)
        unsigned long long v0 = PROBE_R0; if (v0 > 600ull) v0 = 600ull;
        const unsigned long long us = 100ull * v0;
        const unsigned long long r0 = __builtin_amdgcn_s_memrealtime();
        while (__builtin_amdgcn_s_memrealtime() - r0 < us * 100ull) __builtin_amdgcn_s_sleep(8);
    }
#endif
#ifdef STAMP_ID
    __syncthreads();
    if (F.bid == 0 && F.tid == 0) { volatile LAS unsigned long long* _a = (volatile LAS unsigned long long*)(F.lds + LDS_BYTES - 512 + 64); a.out[0] = (float)_a[1 + STAMP_ID] * 0.01f; }
#endif
}

extern "C" void kernel_launch(void* const* d_in, const int* in_sizes, int n_in, void* d_out, int out_size, void* d_ws, size_t ws_size, hipStream_t stream) {
    static int grid = 0;
    if (grid == 0) {
        if (n_in != 23 || out_size != MTOK * DMODEL || ws_size < WS_END) { fprintf(stderr, "kernel_launch: unexpected shapes: n_in %d out %d ws %zu (need >= %zu)\n", n_in, out_size, ws_size, (size_t)WS_END); grid = -1; return; }
        int dev = 0, cus = 0, per_cu = 0;
        if (hipGetDevice(&dev) != hipSuccess || hipDeviceGetAttribute(&cus, hipDeviceAttributeMultiprocessorCount, dev) != hipSuccess) { grid = -1; return; }
        if (hipFuncSetAttribute((const void*)mega_fwd, hipFuncAttributeMaxDynamicSharedMemorySize, LDS_BYTES) != hipSuccess) { fprintf(stderr, "kernel_launch: hipFuncSetAttribute failed\n"); grid = -1; return; }
        if (hipOccupancyMaxActiveBlocksPerMultiprocessor(&per_cu, (const void*)mega_fwd, NTHREADS, LDS_BYTES) != hipSuccess || per_cu < 1) { fprintf(stderr, "kernel_launch: occupancy query says %d blocks/CU\n", per_cu); grid = -1; return; }
        grid = cus;
        if (grid != 256) fprintf(stderr, "kernel_launch: note: %d CUs (built for 256)\n", grid);
    }
    if (grid < 0) return;
    if (hipMemsetAsync((char*)d_ws + WS_BAR, 0, 16384, stream) != hipSuccess) { fprintf(stderr, "kernel_launch: hipMemsetAsync failed\n"); return; }
    Args a{};
    for (int i = 0; i < 23; ++i) a.in[i] = (const float*)d_in[i];
    a.out = (float*)d_out; a.ws = (unsigned char*)d_ws;
    void* args[] = {&a};
    const hipError_t e = hipLaunchCooperativeKernel((const void*)mega_fwd, dim3(grid), dim3(NTHREADS), args, LDS_BYTES, stream);
    if (e != hipSuccess) fprintf(stderr, "kernel_launch: cooperative launch failed: %s (grid %d)\n", hipGetErrorString(e), grid);
}
```
